# Optimizing an MI355X kernel written in HIP

```python
import math
import jax
import jax.numpy as jnp
from jax import lax
import numpy as np

D_MODEL = 2048
BATCH = 4
SEQ = 2048
DEPTH = 2

GRID_W = 64
CTX_LEN = 256
D_FF = 4 * D_MODEL
HEAD_DIM = 64
ROPE_THETA = 10000.0
NORM_EPS = 1e-6
N_MOD = 6

RWKV_HEADS = 16
RWKV_N = 64
RWKV_W = RWKV_HEADS * RWKV_N
DECAY_RANK = 64
ICLR_RANK = 64
GATE_RANK = 64
RWKV_GN_EPS = 64e-5
RWKV_COLS = 3 * RWKV_W + DECAY_RANK + ICLR_RANK + GATE_RANK

SWA_Q_HEADS = 16
SWA_KV_HEADS = 4
SWA_GROUP = SWA_Q_HEADS // SWA_KV_HEADS
SWA_WINDOW = 128
SWA_BLOCK = 128
SWA_COLS = (SWA_Q_HEADS + 2 * SWA_KV_HEADS) * HEAD_DIM

AB_IN = RWKV_COLS + SWA_COLS
AB_OUT = RWKV_W + SWA_Q_HEADS * HEAD_DIM

DIFF_HEADS = 8
DIFF_QK = HEAD_DIM
DIFF_V = 2 * DIFF_QK
DIFF_QBLOCK = 128
DIFF_COLS = 2 * DIFF_HEADS * 2 * DIFF_QK + DIFF_HEADS * DIFF_V

HGRN_HEADS = 8
HGRN_DK = 128
HGRN_DV = 128
HGRN_CHUNK = 64
HGRN_KW = HGRN_HEADS * HGRN_DK
HGRN_VW = HGRN_HEADS * HGRN_DV
HGRN_COLS = 3 * HGRN_KW + 2 * HGRN_VW

CD_IN = DIFF_COLS + HGRN_COLS
CD_OUT = DIFF_HEADS * DIFF_V + HGRN_VW

kernel_name = "hybrid_rwkv7_swa_diffattn_hgrn2_dit"


def rms_norm(x, eps=NORM_EPS):
    xf = x.astype(jnp.float32)
    return (xf * lax.rsqrt(jnp.mean(xf * xf, axis=-1, keepdims=True) + eps)).astype(x.dtype)


def modulate(h, shift, scale):
    return rms_norm(h) * (1 + scale) + shift


def sq_relu_mlp(h, w1, w2):
    return jnp.square(jax.nn.relu(h @ w1)) @ w2


def axial_rope_tables(rows, cols, dim, dtype):
    quarter = dim // 4
    inv = ROPE_THETA ** (-jnp.arange(quarter, dtype=jnp.float32) / quarter)
    ang = jnp.concatenate([rows[:, None] * inv, cols[:, None] * inv], axis=-1)
    return jnp.cos(ang).astype(dtype), jnp.sin(ang).astype(dtype)


def apply_rope(x, cos, sin):
    half = x.shape[-1] // 2
    x1, x2 = x[..., :half], x[..., half:]
    return jnp.concatenate([x1 * cos - x2 * sin, x1 * sin + x2 * cos], axis=-1)


def centred_shift(u):
    zero = jnp.zeros_like(u[:, :1])
    prev = jnp.concatenate([zero, u[:, :-1]], axis=1)
    nxt = jnp.concatenate([u[:, 1:], zero], axis=1)
    return 0.5 * (prev + nxt)


def stack_dirs(t_fwd, t_bwd):
    return jnp.stack([t_fwd, jnp.flip(t_bwd, axis=1)])


def sink_softmax(logits, sink):
    m = jnp.maximum(jnp.max(logits, axis=-1, keepdims=True), sink)
    p = jnp.exp(logits - m)
    return p / (jnp.sum(p, axis=-1, keepdims=True) + jnp.exp(sink - m))


def rwkv_prepare(u, mu, w0, w_up, a0, a_up, g_up, k_k, k_a):
    u = u + mu * (centred_shift(u) - u)
    idx = [RWKV_W, 2 * RWKV_W, 3 * RWKV_W, 3 * RWKV_W + DECAY_RANK, 3 * RWKV_W + DECAY_RANK + ICLR_RANK]
    r, k, v, wd, ad, gd = jnp.split(u, idx, axis=-1)
    w_log = -jax.nn.softplus(-(w0[:, None, None, :] + jnp.einsum('btr,xrc->xbtc', jnp.tanh(wd), w_up))) - 0.5
    decay = jnp.exp(-jnp.exp(w_log))
    a = jax.nn.sigmoid(a0 + ad @ a_up)
    g = jax.nn.sigmoid(gd) @ g_up
    heads = lambda t: t.reshape(*t.shape[:-1], RWKV_HEADS, RWKV_N)
    kk = heads(k * k_k).astype(jnp.float32)
    kk = (kk / jnp.maximum(jnp.sqrt(jnp.sum(kk * kk, axis=-1, keepdims=True)), 1e-12)).astype(k.dtype)
    k = k * (1 + (a - 1) * k_a)
    return heads(r), heads(decay), heads(k), heads(v), heads(a), kk, g


def rwkv_scan(r, w, k, v, a, b, s0, emit):
    xs = tuple(jnp.moveaxis(t, 2, 0) for t in (r, w, k, v, a, b))

    def step(s, inp):
        rt, wt, kt, vt, at, bt = inp
        sa = jnp.einsum('...vk,...k->...v', s, at)
        s = s * wt[..., None, :] + sa[..., :, None] * bt[..., None, :] + vt[..., :, None] * kt[..., None, :]
        y = jnp.einsum('...vk,...k->...v', s, rt) if emit else None
        return s, y

    s, y = lax.scan(step, s0, xs)
    return s, (jnp.moveaxis(y, 0, 2) if emit else None)


def head_group_norm(y, w, b):
    yf = y.astype(jnp.float32)
    mu = jnp.mean(yf, axis=-1, keepdims=True)
    var = jnp.mean(jnp.square(yf - mu), axis=-1, keepdims=True)
    yn = ((yf - mu) * lax.rsqrt(var + RWKV_GN_EPS)).astype(y.dtype)
    return yn.reshape(*y.shape[:-2], -1) * w + b


def rwkv_branch(u, s0, emit, mu, w0, w_up, a0, a_up, g_up, k_k, k_a, r_k, ln_w, ln_b):
    r, decay, k, v, a, kk, g = rwkv_prepare(u, mu, w0, w_up, a0, a_up, g_up, k_k, k_a)
    s_fin, y2 = rwkv_scan(stack_dirs(r, r), stack_dirs(decay[0], decay[1]), stack_dirs(k, k),
                          stack_dirs(v, v), stack_dirs(-kk, -kk), stack_dirs(kk * a, kk * a), s0, emit)
    if not emit:
        return None, s_fin
    y = y2[0] + jnp.flip(y2[1], axis=1)
    bonus = (jnp.sum(r * k * r_k, axis=-1, keepdims=True) * v).reshape(*y.shape[:-2], RWKV_W)
    return (head_group_norm(y, ln_w, ln_b) + bonus) * g, s_fin


def swa_latent(q, k, v, kc, vc, sink):
    B, T = q.shape[:2]
    nb = T // SWA_BLOCK
    nw = 3 * SWA_BLOCK
    qb = q.reshape(B, nb, SWA_BLOCK, SWA_KV_HEADS, SWA_GROUP, HEAD_DIM)
    pad = ((0, 0), (SWA_BLOCK, SWA_BLOCK), (0, 0), (0, 0))

    def band(t):
        tb = jnp.pad(t, pad).reshape(B, nb + 2, SWA_BLOCK, SWA_KV_HEADS, HEAD_DIM)
        return jnp.concatenate([tb[:, :-2], tb[:, 1:-1], tb[:, 2:]], axis=2)

    kw, vw = band(k), band(v)
    s_win = jnp.einsum('bnqhgd,bnkhd->bhgnqk', qb, kw)
    s_ctx = jnp.einsum('bnqhgd,bchd->bhgnqc', qb, kc)
    logits = jnp.concatenate([s_win, s_ctx], axis=-1).astype(jnp.float32) * HEAD_DIM ** -0.5
    qpos = jnp.arange(nb)[:, None, None] * SWA_BLOCK + jnp.arange(SWA_BLOCK)[None, :, None]
    kpos = jnp.arange(nb)[:, None, None] * SWA_BLOCK - SWA_BLOCK + jnp.arange(nw)[None, None, :]
    valid_win = (jnp.abs(kpos - qpos) <= SWA_WINDOW) & (kpos >= 0) & (kpos < T)
    valid = jnp.concatenate([valid_win, jnp.ones((nb, SWA_BLOCK, kc.shape[1]), bool)], axis=-1)
    logits = jnp.where(valid, logits, -jnp.inf)
    sink_b = sink.astype(jnp.float32).reshape(1, SWA_KV_HEADS, SWA_GROUP, 1, 1, 1)
    p = sink_softmax(logits, sink_b).astype(v.dtype)
    o = (jnp.einsum('bhgnqk,bnkhd->bnqhgd', p[..., :nw], vw)
         + jnp.einsum('bhgnqc,bchd->bnqhgd', p[..., nw:], vc))
    return o.reshape(B, T, SWA_Q_HEADS * HEAD_DIM)


def swa_context(qc, kc, vc, sink):
    B, C = qc.shape[:2]
    q = qc.reshape(B, C, SWA_KV_HEADS, SWA_GROUP, HEAD_DIM)
    logits = jnp.einsum('bqhgd,bkhd->bhgqk', q, kc).astype(jnp.float32) * HEAD_DIM ** -0.5
    p = sink_softmax(logits, sink.astype(jnp.float32).reshape(1, SWA_KV_HEADS, SWA_GROUP, 1, 1)).astype(vc.dtype)
    return jnp.einsum('bhgqk,bkhd->bqhgd', p, vc).reshape(B, C, SWA_Q_HEADS * HEAD_DIM)


def ab_mixer(hx, hc, cos, sin, need_ctx, w_in, w_out, mu, w0, w_up, a0, a_up, g_up,
             k_k, k_a, r_k, ln_w, ln_b, sink):
    B = hx.shape[0]
    ux, uc = hx @ w_in, hc @ w_in
    rw = (mu, w0, w_up, a0, a_up, g_up, k_k, k_a, r_k, ln_w, ln_b)
    s0 = jnp.zeros((2, B, RWKV_HEADS, RWKV_N, RWKV_N), hx.dtype)
    yc_a, s_ctx = rwkv_branch(uc[..., :RWKV_COLS], s0, need_ctx, *rw)
    yx_a, _ = rwkv_branch(ux[..., :RWKV_COLS], s_ctx, True, *rw)

    def qkv(u):
        n = u.shape[1]
        q, k, v = jnp.split(u[..., RWKV_COLS:], [SWA_Q_HEADS * HEAD_DIM, (SWA_Q_HEADS + SWA_KV_HEADS) * HEAD_DIM], axis=-1)
        return (q.reshape(B, n, SWA_Q_HEADS, HEAD_DIM), k.reshape(B, n, SWA_KV_HEADS, HEAD_DIM),
                v.reshape(B, n, SWA_KV_HEADS, HEAD_DIM))

    qx, kx, vx = qkv(ux)
    qc, kc, vc = qkv(uc)
    cs, sn = cos[:, None, :], sin[:, None, :]
    yx_b = swa_latent(apply_rope(qx, cs, sn), apply_rope(kx, cs, sn), vx, kc, vc, sink)
    yx = jnp.concatenate([yx_a, yx_b], axis=-1) @ w_out
    if not need_ctx:
        return yx, None
    yc = jnp.concatenate([yc_a, swa_context(qc, kc, vc, sink)], axis=-1) @ w_out
    return yx, yc


def diff_lambda(lam, lam_init):
    lf = lam.astype(jnp.float32)
    return jnp.exp(jnp.sum(lf[0] * lf[1])) - jnp.exp(jnp.sum(lf[2] * lf[3])) + lam_init


def diff_attend(q, k_all, v_all, lmb):
    s = jnp.einsum('bhiqd,bhikd->bhiqk', q, k_all).astype(jnp.float32) * DIFF_QK ** -0.5
    p = jax.nn.softmax(s, axis=-1)
    a = p[:, :, 0] - lmb * p[:, :, 1]
    return jnp.einsum('bhqk,bhkv->bhqv', a.astype(v_all.dtype), v_all)


def diff_post(o, subln, lam_init):
    o = rms_norm(o, 1e-5) * subln * (1 - lam_init)
    B, H, T, dv = o.shape
    return jnp.transpose(o, (0, 2, 1, 3)).reshape(B, T, H * dv)


def hgrn_prepare(u, lb):
    B, T, _ = u.shape
    q, zf, zb, i, g = jnp.split(u, [HGRN_KW, 2 * HGRN_KW, 3 * HGRN_KW, 3 * HGRN_KW + HGRN_VW], axis=-1)
    z = jnp.stack([zf, zb])
    lbb = lb[:, None, None, :]
    logf = jnp.logaddexp(jnp.log(lbb), jnp.log1p(-lbb) + jax.nn.log_sigmoid(z))
    k = (1 - lbb) * jax.nn.sigmoid(-z)

    def heads(t, d):
        return jnp.transpose(t.reshape(2, B, T, HGRN_HEADS, d), (0, 1, 3, 2, 4))

    return (heads(stack_dirs(q, q), HGRN_DK), heads(stack_dirs(k[0], k[1]), HGRN_DK),
            heads(stack_dirs(i, i), HGRN_DV), heads(stack_dirs(logf[0], logf[1]), HGRN_DK), g)


def hgrn_chunk_scan(q, k, v, logf, s0, emit):
    T = q.shape[-2]
    nc = T // HGRN_CHUNK
    chunks = lambda t: jnp.moveaxis(t.reshape(*t.shape[:-2], nc, HGRN_CHUNK, t.shape[-1]), -3, 0)
    incl = jnp.tril(jnp.ones((HGRN_CHUNK, HGRN_CHUNK), bool))[:, :, None]

    def step(s, inp):
        qc, kc, vc, gc = inp
        b = jnp.cumsum(gc, axis=-2)
        b_last = b[..., -1:, :]
        s_new = (jnp.exp(b_last[..., 0, :])[..., None] * s
                 + jnp.einsum('...sk,...sv->...kv', kc * jnp.exp(b_last - b), vc))
        if not emit:
            return s_new, None
        o = jnp.einsum('...tk,...kv->...tv', qc * jnp.exp(b), s)
        dec = jnp.exp(jnp.where(incl, b[..., :, None, :] - b[..., None, :, :], -jnp.inf))
        att = jnp.einsum('...tk,...sk,...tsk->...ts', qc, kc, dec)
        return s_new, o + jnp.einsum('...ts,...sv->...tv', att, vc)

    s, o = lax.scan(step, s0, tuple(chunks(t) for t in (q, k, v, logf)))
    if not emit:
        return s, None
    o = jnp.moveaxis(o, 0, -3)
    return s, o.reshape(*o.shape[:-3], T, o.shape[-1])


def hgrn_branch(u, s0, emit, lb, gnorm):
    q, k, v, logf, g = hgrn_prepare(u, lb)
    s_fin, o = hgrn_chunk_scan(q, k, v, logf, s0, emit)
    if not emit:
        return None, s_fin
    o = rms_norm(o[0] + jnp.flip(o[1], axis=-2)) * gnorm
    B, H, T, dv = o.shape
    o = jnp.transpose(o, (0, 2, 1, 3)).reshape(B, T, H * dv)
    return o * jax.nn.silu(g), s_fin


def cd_mixer(hx, hc, cos, sin, need_ctx, lam_init, lb, w_in, w_out, lam, subln, gnorm):
    B, T, _ = hx.shape
    ux, uc = hx @ w_in, hc @ w_in
    qk_w = DIFF_HEADS * 2 * DIFF_QK

    def qkv(u):
        n = u.shape[1]
        q, k, v = jnp.split(u[..., :DIFF_COLS], [qk_w, 2 * qk_w], axis=-1)
        return (q.reshape(B, n, DIFF_HEADS, 2, DIFF_QK), k.reshape(B, n, DIFF_HEADS, 2, DIFF_QK),
                v.reshape(B, n, DIFF_HEADS, DIFF_V))

    to_h = lambda t: jnp.moveaxis(t, 1, -2)
    qx, kx, vx = qkv(ux)
    qc, kc, vc = qkv(uc)
    cs, sn = cos[:, None, None, :], sin[:, None, None, :]
    qx, kx = apply_rope(qx, cs, sn), apply_rope(kx, cs, sn)
    lmb = diff_lambda(lam, lam_init)
    k_all = jnp.concatenate([to_h(kx), to_h(kc)], axis=-2)
    v_all = jnp.concatenate([to_h(vx), to_h(vc)], axis=-2)
    nb = T // DIFF_QBLOCK
    qb = jnp.moveaxis(to_h(qx).reshape(B, DIFF_HEADS, 2, nb, DIFF_QBLOCK, DIFF_QK), 3, 0)
    ox = lax.map(lambda qi: diff_attend(qi, k_all, v_all, lmb), qb)
    ox = jnp.moveaxis(ox, 0, 2).reshape(B, DIFF_HEADS, T, DIFF_V)
    yx_c = diff_post(ox, subln, lam_init)

    s0 = jnp.zeros((2, B, HGRN_HEADS, HGRN_DK, HGRN_DV), hx.dtype)
    yc_d, s_ctx = hgrn_branch(uc[..., DIFF_COLS:], s0, need_ctx, lb, gnorm)
    yx_d, _ = hgrn_branch(ux[..., DIFF_COLS:], s_ctx, True, lb, gnorm)
    yx = jnp.concatenate([yx_c, yx_d], axis=-1) @ w_out
    if not need_ctx:
        return yx, None
    oc = diff_attend(to_h(qc), to_h(kc), to_h(vc), lmb)
    yc = jnp.concatenate([diff_post(oc, subln, lam_init), yc_d], axis=-1) @ w_out
    return yx, yc


def setup_inputs(seed: int = 0) -> dict:
    key = jax.random.key(seed)
    keys = jax.random.split(key, 32)
    n_ab = (DEPTH + 1) // 2
    n_cd = DEPTH // 2
    f32 = jnp.float32
    nrm = lambda i, shape, s: s * jax.random.normal(keys[i], shape, f32)
    uni = lambda i, shape, lo, hi: jax.random.uniform(keys[i], shape, f32, lo, hi)
    return {
        "x": nrm(0, (BATCH, SEQ, D_MODEL), 1.0),
        "c": nrm(1, (BATCH, D_MODEL), 1.0),
        "ctx": nrm(2, (BATCH, CTX_LEN, D_MODEL), 1.0),
        "c_ctx": nrm(3, (D_MODEL,), 1.0),
        "ada_w": nrm(4, (DEPTH, D_MODEL, N_MOD * D_MODEL), 0.3 * D_MODEL ** -0.5),
        "ada_b": nrm(5, (DEPTH, N_MOD * D_MODEL), 0.02),
        "mlp_w1": nrm(6, (DEPTH, D_MODEL, D_FF), D_MODEL ** -0.5),
        "mlp_w2": nrm(7, (DEPTH, D_FF, D_MODEL), D_FF ** -0.5),
        "final_norm": 1.0 + nrm(8, (D_MODEL,), 0.05),
        "ab_w_in": nrm(9, (n_ab, D_MODEL, AB_IN), D_MODEL ** -0.5),
        "ab_w_out": nrm(10, (n_ab, AB_OUT, D_MODEL), AB_OUT ** -0.5),
        "ab_mu": uni(11, (n_ab, RWKV_COLS), 0.0, 1.0),
        "ab_w0": uni(12, (n_ab, 2, RWKV_W), -6.0, 1.0),
        "ab_w_up": nrm(13, (n_ab, 2, DECAY_RANK, RWKV_W), 0.1),
        "ab_a0": nrm(14, (n_ab, RWKV_W), 0.5),
        "ab_a_up": nrm(15, (n_ab, ICLR_RANK, RWKV_W), 0.05),
        "ab_g_up": nrm(16, (n_ab, GATE_RANK, RWKV_W), GATE_RANK ** -0.5),
        "ab_k_k": 0.85 + nrm(17, (n_ab, RWKV_W), 0.05),
        "ab_k_a": 1.0 + nrm(18, (n_ab, RWKV_W), 0.05),
        "ab_r_k": nrm(19, (n_ab, RWKV_HEADS, RWKV_N), 0.1),
        "ab_ln_w": 1.0 + nrm(20, (n_ab, RWKV_W), 0.05),
        "ab_ln_b": nrm(21, (n_ab, RWKV_W), 0.02),
        "ab_sink": nrm(22, (n_ab, SWA_Q_HEADS), 0.5),
        "cd_w_in": nrm(23, (n_cd, D_MODEL, CD_IN), D_MODEL ** -0.5),
        "cd_w_out": nrm(24, (n_cd, CD_OUT, D_MODEL), CD_OUT ** -0.5),
        "cd_lam": nrm(25, (n_cd, 4, DIFF_QK), 0.1),
        "cd_subln": 1.0 + nrm(26, (n_cd, DIFF_V), 0.05),
        "cd_gnorm": 1.0 + nrm(27, (n_cd, HGRN_DV), 0.05),
        "hgrn_lb_logits": nrm(28, (DEPTH, 2, HGRN_KW), 0.5),
    }


def reference(x, c, ctx, c_ctx, ada_w, ada_b, mlp_w1, mlp_w2, final_norm,
              ab_w_in, ab_w_out, ab_mu, ab_w0, ab_w_up, ab_a0, ab_a_up, ab_g_up,
              ab_k_k, ab_k_a, ab_r_k, ab_ln_w, ab_ln_b, ab_sink,
              cd_w_in, cd_w_out, cd_lam, cd_subln, cd_gnorm, hgrn_lb_logits):
    T = x.shape[1]
    ROWS = T // GRID_W
    rows = jnp.repeat(jnp.arange(ROWS), GRID_W).astype(jnp.float32)
    cols = (jnp.arange(ROWS * GRID_W) % GRID_W).astype(jnp.float32)
    cos, sin = axial_rope_tables(rows, cols, HEAD_DIM, x.dtype)

    lb_table = jnp.cumsum(jax.nn.softmax(hgrn_lb_logits.astype(jnp.float32), axis=0), axis=0)
    lb_table = (lb_table - lb_table[0]).astype(x.dtype)

    sc, sc_ctx = jax.nn.silu(c), jax.nn.silu(c_ctx)
    for l in range(DEPTH):
        last = l == DEPTH - 1
        mx = jnp.split((sc @ ada_w[l] + ada_b[l])[:, None, :], N_MOD, axis=-1)
        mc = jnp.split(sc_ctx @ ada_w[l] + ada_b[l], N_MOD, axis=-1)
        hx = modulate(x, mx[0], mx[1])
        hc = modulate(ctx, mc[0], mc[1])
        j = l // 2
        if l % 2 == 0:
            yx, yc = ab_mixer(hx, hc, cos, sin, not last, ab_w_in[j], ab_w_out[j], ab_mu[j], ab_w0[j],
                              ab_w_up[j], ab_a0[j], ab_a_up[j], ab_g_up[j], ab_k_k[j], ab_k_a[j],
                              ab_r_k[j], ab_ln_w[j], ab_ln_b[j], ab_sink[j])
        else:
            lam_init = 0.8 - 0.6 * math.exp(-0.3 * l)
            yx, yc = cd_mixer(hx, hc, cos, sin, not last, lam_init, lb_table[l], cd_w_in[j], cd_w_out[j],
                              cd_lam[j], cd_subln[j], cd_gnorm[j])
        x = x + mx[2] * yx
        x = x + mx[5] * sq_relu_mlp(modulate(x, mx[3], mx[4]), mlp_w1[l], mlp_w2[l])
        if not last:
            ctx = ctx + mc[2] * yc
            ctx = ctx + mc[5] * sq_relu_mlp(modulate(ctx, mc[3], mc[4]), mlp_w1[l], mlp_w2[l])
    return rms_norm(x) * final_norm
```

```cpp
#include <hip/hip_runtime.h>
#include <hip/hip_cooperative_groups.h>
#include <cstdio>
#include <cstdint>
namespace cg = cooperative_groups;

#define LAS __attribute__((address_space(3)))
typedef unsigned short bf16_t;
typedef short bf16x8 __attribute__((ext_vector_type(8)));
typedef short bf16x4 __attribute__((ext_vector_type(4)));
typedef float f32x4 __attribute__((ext_vector_type(4)));
typedef float f32x2 __attribute__((ext_vector_type(2)));
typedef unsigned u32x4 __attribute__((ext_vector_type(4)));
typedef unsigned u32x2 __attribute__((ext_vector_type(2)));

constexpr int DM = 2048, NB = 4, TL = 2048, TC = 256, ML = NB * TL, MC = NB * TC, MT = ML + MC, FF = 8192;
constexpr int MODW = 6 * DM;
constexpr int ABINP = 4864;
constexpr int NBLK = 256, NTHR = 512;

constexpr size_t OFF_CTL = 0;
constexpr size_t OFF_MOD = 1048576;
constexpr size_t OFF_ROPE = 1572864;
constexpr size_t OFF_WT = 2097152;
constexpr size_t WT_ABIN = OFF_WT;
constexpr size_t WT_ABOUT = WT_ABIN + (size_t)ABINP * DM * 2;
constexpr size_t WT_W1_0 = WT_ABOUT + (size_t)DM * DM * 2;
constexpr size_t WT_W2_0 = WT_W1_0 + (size_t)FF * DM * 2;
constexpr size_t WT_CDIN = WT_W2_0 + (size_t)FF * DM * 2;
constexpr size_t WT_CDOUT = WT_CDIN + (size_t)FF * DM * 2;
constexpr size_t WT_W1_1 = WT_CDOUT + (size_t)DM * DM * 2;
constexpr size_t WT_W2_1 = WT_W1_1 + (size_t)FF * DM * 2;
constexpr size_t OFF_HN = WT_W2_1 + (size_t)FF * DM * 2;
constexpr size_t OFF_ARENA = OFF_HN + (size_t)MT * DM * 2;
constexpr size_t SZ_TOK1K_F32 = (size_t)MT * 1024 * 4;
constexpr size_t A_U0 = 0;
constexpr size_t A_PREP = A_U0 + (size_t)MT * ABINP * 4;
constexpr size_t A_G = A_PREP + 8 * SZ_TOK1K_F32;
constexpr size_t A_SCAL = A_G + (size_t)MT * 1024 * 2;
constexpr size_t A_SQ = A_SCAL + (size_t)MT * 16 * 16;
constexpr size_t A_SK = A_SQ + (size_t)MT * 1024 * 2;
constexpr size_t A_SV = A_SK + (size_t)MT * 256 * 2;
constexpr size_t A_L0END = A_SV + (size_t)MT * 256 * 2;
constexpr size_t A_YF = 0, A_YB = SZ_TOK1K_F32, A_YA = 2 * SZ_TOK1K_F32;
constexpr size_t A_X1 = A_PREP;
constexpr size_t A_HID = A_PREP + (size_t)MT * DM * 4;
constexpr size_t A_X2 = 0;
static_assert(A_YA + (size_t)MT * DM * 2 <= A_PREP, "ws map");
static_assert(A_HID + (size_t)MT * FF * 2 <= A_L0END, "ws map");
constexpr size_t A_U1 = A_X2 + (size_t)MT * DM * 4;
constexpr size_t A_QD = A_U1 + (size_t)MT * FF * 4;
constexpr size_t A_KD = A_QD + (size_t)ML * 1024 * 2;
constexpr size_t A_VD = A_KD + (size_t)MT * 1024 * 2;
constexpr size_t A_OF = A_VD + (size_t)MT * 1024 * 2;
constexpr size_t A_OB = A_OF + (size_t)ML * 1024 * 4;
constexpr size_t A_YC = A_OB + (size_t)ML * 1024 * 4;
constexpr size_t A_L1END = A_YC + (size_t)ML * DM * 2;
constexpr size_t A_X3 = A_U1;
constexpr size_t A_HID1 = A_U1 + (size_t)ML * DM * 4;
static_assert(A_HID1 + (size_t)ML * FF * 2 <= A_QD, "ws map");
constexpr size_t WS_TOTAL = OFF_ARENA + (A_L0END > A_L1END ? A_L0END : A_L1END);
static_assert(WS_TOTAL <= 805306368ull, "d_ws budget (4 x the largest tensor)");

constexpr int LDS_BYTES = 147456;

__device__ __forceinline__ unsigned f2bf(float f) { unsigned u = __builtin_bit_cast(unsigned, f); return (u + 0x7fffu + ((u >> 16) & 1u)) >> 16; }
__device__ __forceinline__ unsigned pk2(float lo, float hi) { return f2bf(lo) | (f2bf(hi) << 16); }
__device__ __forceinline__ float wave_sum(float v) {
#pragma unroll
    for (int o = 1; o < 64; o <<= 1) v += __shfl_xor(v, o);
    return v;
}
__device__ __forceinline__ float dppf(float x, const int ctrl_sel) {
    const int xi = __builtin_bit_cast(int, x); int r;
    if (ctrl_sel == 0) r = __builtin_amdgcn_update_dpp(xi, xi, 0xB1, 0xF, 0xF, true);
    else if (ctrl_sel == 1) r = __builtin_amdgcn_update_dpp(xi, xi, 0x4E, 0xF, 0xF, true);
    else if (ctrl_sel == 2) r = __builtin_amdgcn_update_dpp(xi, xi, 0x141, 0xF, 0xF, true);
    else r = __builtin_amdgcn_update_dpp(xi, xi, 0x140, 0xF, 0xF, true);
    return __builtin_bit_cast(float, r);
}
__device__ __forceinline__ float row16_sum(float x) { x += dppf(x, 0); x += dppf(x, 1); x += dppf(x, 2); x += dppf(x, 3); return x; }
__device__ __forceinline__ float row16_max(float x) { x = fmaxf(x, dppf(x, 0)); x = fmaxf(x, dppf(x, 1)); x = fmaxf(x, dppf(x, 2)); x = fmaxf(x, dppf(x, 3)); return x; }
__device__ __forceinline__ float sigmoidf_(float x) { return 1.f / (1.f + __expf(-x)); }

struct Args { const void* in[29]; float* out; unsigned char* ws; int ph_lo, ph_hi; };

namespace pg8 {
#define PG8_LAS __attribute__((address_space(3)))
typedef unsigned short bf16_t;
typedef short bf16x8 __attribute__((ext_vector_type(8)));
typedef float f32x4 __attribute__((ext_vector_type(4)));
typedef unsigned u32x4 __attribute__((ext_vector_type(4)));
constexpr int BM = 256, BK = 64, HALF = 128, HTB = HALF * BK * 2  , STAGE_BYTES = 8 * HTB, NXCD = 8, WGM = 8;

__host__ __device__ __forceinline__ int lds_byte(int r, int c) { const int st = (r >> 4) * 2 + (c >> 5), rr = r & 15, cc = c & 31, ob = rr * 64 + cc * 2; return st * 1024 + (ob ^ (((ob >> 9) & 1) << 5)); }
__host__ __device__ __forceinline__ void stage_rc(int b, int& R, int& C) { const int st = b / 1024, sb = b % 1024, swz = sb ^ (((sb >> 9) & 1) << 5); R = (st >> 1) * 16 + swz / 64; C = (st & 1) * 32 + (swz % 64) / 2; }
__host__ __device__ __forceinline__ int perm32(int rho) { const int n = rho >> 4, i = rho & 15; return 8 * (i >> 2) + 4 * n + (i & 3); }

struct Unit { int pm, pn; };
struct Gemm { const bf16_t* A; const bf16_t* Bt; int M, N, K; };

struct StaticOrder {
    int nM, nN, nwg, G, c;
    __host__ __device__ void init(int M, int N, int G_, int c_) { nM = M / BM; nN = N / BM; nwg = nM * nN; G = G_; c = c_; }
    __host__ __device__ bool next(int i, Unit& u) const {
        const long L = (long)i * G + c; if (L >= nwg) return false;
        int wgid = (int)L; { const int q = nwg / NXCD, r = nwg % NXCD, xcd = wgid % NXCD, off = wgid / NXCD; wgid = (xcd < r ? xcd * (q + 1) : r * (q + 1) + (xcd - r) * q) + off; }
        const int nig = WGM * nN, gid = wgid / nig, fm = gid * WGM, gsz = (nM - fm) < WGM ? (nM - fm) : WGM;
        u.pm = fm + ((wgid % nig) % gsz); u.pn = (wgid % nig) / gsz; return true;
    }
    __device__ __forceinline__ void a_ready(const Unit&) const {}
    __device__ __forceinline__ void done(const Unit&) const {}
};


struct EpiF32 {
    static constexpr bool PERM = false, AFTER_DRAIN = false;
    float* O; int ldc;
    __device__ __forceinline__ void operator()(const f32x4 (&acc)[2][2][4][2], const Unit& u, int wr, int wc, int fr, int fq) const {
        const int col0 = u.pn * BM + wc * 32 + 4 * fq;
#pragma unroll
        for (int ai = 0; ai < 2; ++ai)
#pragma unroll
            for (int m = 0; m < 4; ++m) { float* rowp = O + (size_t)(u.pm * BM + ai * HALF + wr * 64 + m * 16 + fr) * ldc + col0;
#pragma unroll
                for (int bj = 0; bj < 2; ++bj)
#pragma unroll
                    for (int n = 0; n < 2; ++n) *(f32x4*)(rowp + bj * HALF + n * 16) = acc[ai][bj][m][n]; }
    }
};
struct EpiResGate {
    static constexpr bool PERM = false, AFTER_DRAIN = false;
    const float* baseL; const float* baseC; float* out; const float* gate;
    __device__ __forceinline__ void operator()(const f32x4 (&acc)[2][2][4][2], const Unit& u, int wr, int wc, int fr, int fq) const {
        const int col0 = u.pn * BM + wc * 32 + 4 * fq;
        const int rowt = u.pm * BM;
        const int rg = rowt < 8192 ? (rowt >> 11) : 4;
        const float* gp = gate + (size_t)rg * 12288 + col0;
        f32x4 gv[2][2];
#pragma unroll
        for (int bj = 0; bj < 2; ++bj)
#pragma unroll
            for (int n = 0; n < 2; ++n) gv[bj][n] = *(const f32x4*)(gp + bj * HALF + n * 16);
#pragma unroll
        for (int ai = 0; ai < 2; ++ai)
#pragma unroll
            for (int m = 0; m < 4; ++m) { const int row = rowt + ai * HALF + wr * 64 + m * 16 + fr;
                const float* bp = (row < 8192 ? baseL + (size_t)row * 2048 : baseC + (size_t)(row - 8192) * 2048) + col0;
                float* op = out + (size_t)row * 2048 + col0;
#pragma unroll
                for (int bj = 0; bj < 2; ++bj)
#pragma unroll
                    for (int n = 0; n < 2; ++n) { const f32x4 b = *(const f32x4*)(bp + bj * HALF + n * 16); *(f32x4*)(op + bj * HALF + n * 16) = b + gv[bj][n] * acc[ai][bj][m][n]; } }
    }
};
struct EpiSqReluBf16 {
    static constexpr bool PERM = true, AFTER_DRAIN = false;
    bf16_t* O; int ldc;
    __device__ __forceinline__ unsigned pk(float lo, float hi) const { unsigned a = __builtin_bit_cast(unsigned, lo), b = __builtin_bit_cast(unsigned, hi);
        a = (a + 0x7fffu + ((a >> 16) & 1u)) >> 16; b = (b + 0x7fffu + ((b >> 16) & 1u)) >> 16; return a | (b << 16); }
    __device__ __forceinline__ void operator()(const f32x4 (&acc)[2][2][4][2], const Unit& u, int wr, int wc, int fr, int fq) const {
        const int col0 = u.pn * BM + wc * 32 + 8 * fq;
#pragma unroll
        for (int ai = 0; ai < 2; ++ai)
#pragma unroll
            for (int m = 0; m < 4; ++m) { bf16_t* rowp = O + (size_t)(u.pm * BM + ai * HALF + wr * 64 + m * 16 + fr) * ldc + col0;
#pragma unroll
                for (int bj = 0; bj < 2; ++bj) { f32x4 v0 = acc[ai][bj][m][0], v1 = acc[ai][bj][m][1];
#pragma unroll
                    for (int e = 0; e < 4; ++e) { const float a0 = fmaxf(v0[e], 0.f), a1 = fmaxf(v1[e], 0.f); v0[e] = a0 * a0; v1[e] = a1 * a1; }
                    u32x4 w; w.x = pk(v0[0], v0[1]); w.y = pk(v0[2], v0[3]); w.z = pk(v1[0], v1[1]); w.w = pk(v1[2], v1[3]);
                    *(u32x4*)(rowp + bj * HALF) = w; } }
    }
};

template <class Epi, class Sched, bool ALIGN_EPI = false, bool SP2 = false>
__device__ __forceinline__ void gemm_phase(PG8_LAS unsigned char* lds, const Gemm g, const Sched& S, const Epi& E) {
    const int tid = threadIdx.x, wid = __builtin_amdgcn_readfirstlane(tid >> 6), lane = tid & 63, wr = wid >> 2, wc = wid & 3, fr = lane & 15, fq = lane >> 4;
    const int K = g.K, nt = K / BK;
    unsigned voffA[2], voffB[2];
#pragma unroll
    for (int i = 0; i < 2; ++i) { int R, C; stage_rc(tid * 16 + i * 8192, R, C); const int Rb = Epi::PERM ? ((R & ~31) + perm32(R & 31)) : R;
        voffA[i] = (unsigned)(R * K + C) * 2u; voffB[i] = (unsigned)(Rb * K + C) * 2u; }
    const size_t kstep = (size_t)(BK * 2);
    const size_t hstep = (size_t)HALF * K * 2;
    const size_t tstep = 2 * hstep;
    const unsigned ldsw = (unsigned)wid * 1024u;
    const int aoff = lds_byte(wr * 64 + fr, fq * 8), boff = lds_byte(wc * 32 + fr, fq * 8);
#define PG8_SA(b, h) (((b) * 2 + (h)) * HTB)
#define PG8_SB(b, h) ((4 + (b) * 2 + (h)) * HTB)
#define PG8_STAGE(bufoff, gbase, voff) do { _Pragma("unroll") for (int _i = 0; _i < 2; ++_i) \
        __builtin_amdgcn_global_load_lds((const unsigned*)((const char*)(gbase) + (voff)[_i]), (PG8_LAS unsigned*)(lds + (bufoff) + ldsw + _i * 8192), 16, 0, 0); } while (0)
#define PG8_LDA(dst, b, h) do { _Pragma("unroll") for (int m = 0; m < 4; ++m) _Pragma("unroll") for (int k = 0; k < 2; ++k) dst[m][k] = *(const PG8_LAS bf16x8*)(lds + PG8_SA(b, h) + aoff + m * 2048 + k * 1024); } while (0)
#define PG8_LDB(dst, b, h) do { _Pragma("unroll") for (int n = 0; n < 2; ++n) _Pragma("unroll") for (int k = 0; k < 2; ++k) dst[n][k] = *(const PG8_LAS bf16x8*)(lds + PG8_SB(b, h) + boff + n * 2048 + k * 1024); } while (0)
#define PG8_MMA(ai, bj, At, Bt) do { __builtin_amdgcn_s_setprio(1); _Pragma("unroll") for (int m = 0; m < 4; ++m) _Pragma("unroll") for (int n = 0; n < 2; ++n) _Pragma("unroll") for (int k = 0; k < 2; ++k) \
        acc[ai][bj][m][n] = __builtin_amdgcn_mfma_f32_16x16x32_bf16(Bt[n][k], At[m][k], acc[ai][bj][m][n], 0, 0, 0); __builtin_amdgcn_s_setprio(0); } while (0)
#define PG8_WAIT_V(n) asm volatile("s_waitcnt vmcnt(" #n ")" ::: "memory")
#define PG8_WAIT_L(n) asm volatile("s_waitcnt lgkmcnt(" #n ")" ::: "memory")
#define PG8_BAR __builtin_amdgcn_s_barrier()
#define PG8_SCHED __builtin_amdgcn_sched_barrier(0)
    Unit cur, nxt; int ui = 0;
    if (!S.next(0, cur)) return;
    f32x4 acc[2][2][4][2];
#pragma unroll
    for (int a = 0; a < 2; ++a)
#pragma unroll
        for (int b = 0; b < 2; ++b)
#pragma unroll
            for (int m = 0; m < 4; ++m)
#pragma unroll
                for (int n = 0; n < 2; ++n) acc[a][b][m][n] = (f32x4){0.f, 0.f, 0.f, 0.f};
    bf16x8 At[4][2], B0[2][2], B1[2][2];
    const char* cA = (const char*)g.A + (size_t)cur.pm * tstep; const char* cB = (const char*)g.Bt + (size_t)cur.pn * tstep;
    S.a_ready(cur);
    if constexpr (SP2) {
        PG8_STAGE(PG8_SB(0, 0), cB, voffB); PG8_STAGE(PG8_SB(0, 1), cB + hstep, voffB); PG8_STAGE(PG8_SA(0, 0), cA, voffA); PG8_STAGE(PG8_SA(0, 1), cA + hstep, voffA);
        if (wr == 1) PG8_BAR;
        PG8_WAIT_V(2); PG8_BAR;
        PG8_STAGE(PG8_SB(1, 0), cB + kstep, voffB); PG8_STAGE(PG8_SA(1, 0), cA + kstep, voffA); PG8_STAGE(PG8_SB(1, 1), cB + hstep + kstep, voffB);
        PG8_WAIT_V(6); PG8_BAR;
    } else {
        PG8_STAGE(PG8_SB(0, 0), cB, voffB); PG8_STAGE(PG8_SA(0, 0), cA, voffA); PG8_STAGE(PG8_SB(0, 1), cB + hstep, voffB); PG8_STAGE(PG8_SA(0, 1), cA + hstep, voffA);
        if (wr == 1) PG8_BAR;
        PG8_WAIT_V(4); PG8_BAR;
        PG8_STAGE(PG8_SB(1, 0), cB + kstep, voffB); PG8_STAGE(PG8_SA(1, 0), cA + kstep, voffA); PG8_STAGE(PG8_SB(1, 1), cB + hstep + kstep, voffB);
        PG8_WAIT_V(6); PG8_BAR;
    }
    for (;;) {
        const bool has_next = S.next(ui + 1, nxt);
        const char* nA = has_next ? (const char*)g.A + (size_t)nxt.pm * tstep : cA; const char* nB = has_next ? (const char*)g.Bt + (size_t)nxt.pn * tstep : cB;
        for (int t = 0; t < nt; t += 2) {
            const bool last = (t == nt - 2);
            const char* a1 = cA + (size_t)(t + 1) * kstep;
            const char* a2 = last ? nA : cA + (size_t)(t + 2) * kstep; const char* b2 = last ? nB : cB + (size_t)(t + 2) * kstep;
            const char* a3 = a2 + kstep; const char* b3 = b2 + kstep;
            if (last && has_next) S.a_ready(nxt);
            if constexpr (SP2) {
            PG8_LDB(B0, 0, 0); PG8_LDB(B1, 0, 1); PG8_SCHED; PG8_LDA(At, 0, 0); PG8_STAGE(PG8_SA(1, 1), a1 + hstep, voffA);
            PG8_WAIT_V(8); PG8_WAIT_L(0); PG8_BAR; PG8_MMA(0, 0, At, B0); PG8_MMA(0, 1, At, B1); PG8_BAR; PG8_SCHED;
            PG8_LDA(At, 0, 1); PG8_STAGE(PG8_SB(0, 0), b2, voffB); PG8_STAGE(PG8_SB(0, 1), b2 + hstep, voffB); PG8_STAGE(PG8_SA(0, 0), a2, voffA);
            PG8_WAIT_V(8); PG8_WAIT_L(0); PG8_BAR; PG8_MMA(1, 0, At, B0); PG8_MMA(1, 1, At, B1); PG8_BAR; PG8_SCHED;
            PG8_LDB(B0, 1, 0); PG8_LDB(B1, 1, 1); PG8_SCHED; PG8_LDA(At, 1, 0); PG8_STAGE(PG8_SA(0, 1), a2 + hstep, voffA);
            PG8_WAIT_V(8); PG8_WAIT_L(0); PG8_BAR; PG8_MMA(0, 0, At, B0); PG8_MMA(0, 1, At, B1); PG8_BAR; PG8_SCHED;
            PG8_LDA(At, 1, 1); PG8_STAGE(PG8_SB(1, 0), b3, voffB); PG8_STAGE(PG8_SB(1, 1), b3 + hstep, voffB); PG8_STAGE(PG8_SA(1, 0), a3, voffA);
            PG8_WAIT_V(8); PG8_WAIT_L(0); PG8_BAR; PG8_MMA(1, 0, At, B0); PG8_MMA(1, 1, At, B1); PG8_BAR; PG8_SCHED;
            } else {
            PG8_LDB(B0, 0, 0); PG8_SCHED; PG8_LDA(At, 0, 0); PG8_STAGE(PG8_SA(1, 1), a1 + hstep, voffA);
            PG8_WAIT_L(8); PG8_BAR; PG8_WAIT_L(0); PG8_MMA(0, 0, At, B0); PG8_BAR; PG8_SCHED;
            PG8_LDB(B1, 0, 1); PG8_STAGE(PG8_SB(0, 0), b2, voffB);
            PG8_BAR; PG8_WAIT_L(0); PG8_MMA(0, 1, At, B1); PG8_BAR;
            PG8_LDA(At, 0, 1); PG8_STAGE(PG8_SA(0, 0), a2, voffA);
            PG8_BAR; PG8_WAIT_L(0); PG8_MMA(1, 0, At, B0); PG8_BAR; PG8_SCHED;
            PG8_STAGE(PG8_SB(0, 1), b2 + hstep, voffB);
            PG8_WAIT_V(6); PG8_BAR; PG8_MMA(1, 1, At, B1); PG8_BAR;
            PG8_LDB(B0, 1, 0); PG8_SCHED; PG8_LDA(At, 1, 0); PG8_STAGE(PG8_SA(0, 1), a2 + hstep, voffA);
            PG8_WAIT_L(8); PG8_BAR; PG8_WAIT_L(0); PG8_MMA(0, 0, At, B0); PG8_BAR; PG8_SCHED;
            PG8_LDB(B1, 1, 1); PG8_STAGE(PG8_SB(1, 0), b3, voffB);
            PG8_BAR; PG8_WAIT_L(0); PG8_MMA(0, 1, At, B1); PG8_BAR;
            PG8_LDA(At, 1, 1); PG8_STAGE(PG8_SA(1, 0), a3, voffA);
            PG8_BAR; PG8_WAIT_L(0); PG8_MMA(1, 0, At, B0); PG8_BAR; PG8_SCHED;
            PG8_STAGE(PG8_SB(1, 1), b3 + hstep, voffB);
            PG8_WAIT_V(6); PG8_BAR; PG8_MMA(1, 1, At, B1); PG8_BAR;
            }
        }
        if constexpr (ALIGN_EPI) { if (wr == 0) PG8_BAR; }
        if constexpr (!Epi::AFTER_DRAIN) { E(acc, cur, wr, wc, fr, fq); S.done(cur); }
        if (!has_next) break;
#pragma unroll
        for (int a = 0; a < 2; ++a)
#pragma unroll
            for (int b = 0; b < 2; ++b)
#pragma unroll
                for (int m = 0; m < 4; ++m)
#pragma unroll
                    for (int n = 0; n < 2; ++n) acc[a][b][m][n] = (f32x4){0.f, 0.f, 0.f, 0.f};
        cur = nxt; cA = nA; cB = nB; ++ui;
        if constexpr (ALIGN_EPI) { if (wr == 1) PG8_BAR; }
    }
    PG8_WAIT_V(0);
    if constexpr (!ALIGN_EPI) { if (wr == 0) PG8_BAR; }
    PG8_BAR;
    if constexpr (Epi::AFTER_DRAIN) { E.fused(acc, cur, wr, wc, fr, fq, lds, wid, lane); S.done(cur); }
#undef PG8_SA
#undef PG8_SB
#undef PG8_STAGE
#undef PG8_LDA
#undef PG8_LDB
#undef PG8_MMA
#undef PG8_WAIT_V
#undef PG8_WAIT_L
#undef PG8_BAR
#undef PG8_SCHED
}
}

#define WS_F32(off) ((float*)(a.ws + (off)))
#define WS_BF(off) ((bf16_t*)(a.ws + (off)))
#define AR_F32(off) ((float*)(a.ws + OFF_ARENA + (off)))
#define AR_BF(off) ((bf16_t*)(a.ws + OFF_ARENA + (off)))

__device__ __forceinline__ void p0_transpose_item(const float* W, int K, int N, bf16_t* WT, LAS float* scr, int item, int lane) {
    const int nblk = N / 32, kb = item / nblk, nb = item % nblk, k0 = 64 * kb, n0 = 32 * nb;
#pragma unroll 8
    for (int i = 0; i < 32; ++i) { const int kk = 2 * i + (lane >> 5); scr[kk * 33 + (lane & 31)] = W[(size_t)(k0 + kk) * N + n0 + (lane & 31)]; }
    asm volatile("s_waitcnt lgkmcnt(0)" ::: "memory");
    const int c = lane & 7;
#pragma unroll
    for (int j = 0; j < 4; ++j) { const int n = (lane >> 3) + 8 * j; const LAS float* s = scr + (8 * c) * 33 + n;
        u32x4 o; o.x = pk2(s[0 * 33], s[1 * 33]); o.y = pk2(s[2 * 33], s[3 * 33]); o.z = pk2(s[4 * 33], s[5 * 33]); o.w = pk2(s[6 * 33], s[7 * 33]);
        *(u32x4*)(WT + (size_t)(n0 + n) * K + k0 + 8 * c) = o; }
    asm volatile("s_waitcnt lgkmcnt(0)" ::: "memory");
}

__device__ __forceinline__ void ph_prologue(const Args& a, LAS unsigned char* L) {
    const int tid = threadIdx.x, lane = tid & 63, wave = tid >> 6, bid = blockIdx.x, nblk = gridDim.x;
    float* mod = WS_F32(OFF_MOD);
    for (int it = bid; it < 192; it += nblk) {
        const int l = it / 96, n0 = (it % 96) * 128;
        LAS float* sl = (LAS float*)L;
        LAS float* part = sl + 5 * 2048;
        const float* cin = (const float*)a.in[1]; const float* cctx = (const float*)a.in[3];
        for (int i = tid; i < 5 * 2048; i += NTHR) { const int r = i >> 11, k = i & 2047; const float x = r < 4 ? cin[r * 2048 + k] : cctx[k]; sl[i] = x / (1.f + expf(-x)); }
        __syncthreads();
        const float* W = (const float*)a.in[4] + (size_t)l * 2048 * 12288 + n0 + 2 * lane;
        float acc0[5], acc1[5];
#pragma unroll
        for (int r = 0; r < 5; ++r) { acc0[r] = 0.f; acc1[r] = 0.f; }
        const int kb = wave * 256;
#pragma unroll 8
        for (int k = 0; k < 256; ++k) { const f32x2 wv = *(const f32x2*)(W + (size_t)(kb + k) * 12288);
#pragma unroll
            for (int r = 0; r < 5; ++r) { const float s = sl[r * 2048 + kb + k]; acc0[r] += s * wv.x; acc1[r] += s * wv.y; } }
#pragma unroll
        for (int r = 0; r < 5; ++r) { part[(wave * 5 + r) * 128 + 2 * lane] = acc0[r]; part[(wave * 5 + r) * 128 + 2 * lane + 1] = acc1[r]; }
        __syncthreads();
        const float* ab = (const float*)a.in[5] + (size_t)l * 12288 + n0;
        for (int i = tid; i < 640; i += NTHR) { const int r = i >> 7, c = i & 127; float s = 0.f;
#pragma unroll
            for (int w = 0; w < 8; ++w) s += part[(w * 5 + r) * 128 + c];
            mod[(size_t)(l * 5 + r) * 12288 + n0 + c] = s + ab[c]; }
        __syncthreads();
    }
    if (bid == nblk - 1) {
        f32x2* tab = (f32x2*)(a.ws + OFF_ROPE);
        for (int i = tid; i < 1024; i += NTHR) { const int pos = i >> 4, f = i & 15; const float inv = powf(10000.f, -(float)f * 0.0625f); const float ang = (float)pos * inv;
            f32x2 cs; cs.x = cosf(ang); cs.y = sinf(ang); tab[i] = cs; }
    }
    { u32x4* z = (u32x4*)(a.ws + WT_ABIN + (size_t)4800 * DM * 2); const u32x4 zero = {0u, 0u, 0u, 0u};
      for (int i = bid * NTHR + tid; i < 64 * DM * 2 / 16; i += nblk * NTHR) z[i] = zero; }
    LAS float* scr = (LAS float*)(L + wave * 16384);
    const int gw = bid * 8 + wave, NGW = nblk * 8;
    constexpr int I0 = 32 * 150, I1 = 32 * 64, I2 = 32 * 256, I3 = 128 * 64;
    constexpr int NITEMS = I0 + I1 + I2 + I3 + I2 + I1 + I2 + I3;
    for (int it = gw; it < NITEMS; it += NGW) {
        int r = it;
        if (r < I0) { p0_transpose_item((const float*)a.in[9], 2048, 4800, WS_BF(WT_ABIN), scr, r, lane); continue; } r -= I0;
        if (r < I1) { p0_transpose_item((const float*)a.in[10], 2048, 2048, WS_BF(WT_ABOUT), scr, r, lane); continue; } r -= I1;
        if (r < I2) { p0_transpose_item((const float*)a.in[6], 2048, 8192, WS_BF(WT_W1_0), scr, r, lane); continue; } r -= I2;
        if (r < I3) { p0_transpose_item((const float*)a.in[7], 8192, 2048, WS_BF(WT_W2_0), scr, r, lane); continue; } r -= I3;
        if (r < I2) { p0_transpose_item((const float*)a.in[23], 2048, 8192, WS_BF(WT_CDIN), scr, r, lane); continue; } r -= I2;
        if (r < I1) { p0_transpose_item((const float*)a.in[24], 2048, 2048, WS_BF(WT_CDOUT), scr, r, lane); continue; } r -= I1;
        if (r < I2) { p0_transpose_item((const float*)a.in[6] + (size_t)2048 * 8192, 2048, 8192, WS_BF(WT_W1_1), scr, r, lane); continue; } r -= I2;
        p0_transpose_item((const float*)a.in[7] + (size_t)8192 * 2048, 8192, 2048, WS_BF(WT_W2_1), scr, r, lane);
    }
}

__device__ __forceinline__ void ph_modulate(const float* srcL, const float* srcC, int nrows, const float* modl, int ish, int isc, bf16_t* HN) {
    const int tid = threadIdx.x, lane = tid & 63, wave = tid >> 6, gw = blockIdx.x * 8 + wave, NGW = gridDim.x * 8;
    for (int m = gw; m < nrows; m += NGW) {
        const float* xr = (m < 8192 ? srcL + (size_t)m * 2048 : srcC + (size_t)(m - 8192) * 2048) + 4 * lane;
        const int rg = m < 8192 ? (m >> 11) : 4;
        const float* sh = modl + (size_t)rg * 12288 + ish * 2048 + 4 * lane; const float* sc = modl + (size_t)rg * 12288 + isc * 2048 + 4 * lane;
        f32x4 v[8]; float ss = 0.f;
#pragma unroll
        for (int j = 0; j < 8; ++j) { v[j] = *(const f32x4*)(xr + 256 * j); ss += (v[j].x * v[j].x + v[j].y * v[j].y) + (v[j].z * v[j].z + v[j].w * v[j].w); }
        const float rstd = rsqrtf(wave_sum(ss) * (1.f / 2048.f) + 1e-6f);
        bf16_t* op = HN + (size_t)m * 2048 + 4 * lane;
#pragma unroll
        for (int j = 0; j < 8; ++j) { const f32x4 s4 = *(const f32x4*)(sc + 256 * j), h4 = *(const f32x4*)(sh + 256 * j);
            const f32x4 o = v[j] * rstd * (s4 + 1.f) + h4; u32x2 w; w.x = pk2(o.x, o.y); w.y = pk2(o.z, o.w); *(u32x2*)(op + 256 * j) = w; }
    }
}

__device__ __forceinline__ void ph_final(const Args& a) {
    const int tid = threadIdx.x, lane = tid & 63, wave = tid >> 6, gw = blockIdx.x * 8 + wave, NGW = gridDim.x * 8;
    const float* fn = (const float*)a.in[8] + 4 * lane;
    for (int m = gw; m < ML; m += NGW) {
        float* xr = a.out + (size_t)m * 2048 + 4 * lane;
        f32x4 v[8]; float ss = 0.f;
#pragma unroll
        for (int j = 0; j < 8; ++j) { v[j] = *(const f32x4*)(xr + 256 * j); ss += (v[j].x * v[j].x + v[j].y * v[j].y) + (v[j].z * v[j].z + v[j].w * v[j].w); }
        const float rstd = rsqrtf(wave_sum(ss) * (1.f / 2048.f) + 1e-6f);
#pragma unroll
        for (int j = 0; j < 8; ++j) { const f32x4 w4 = *(const f32x4*)(fn + 256 * j); *(f32x4*)(xr + 256 * j) = v[j] * rstd * w4; }
    }
}

__device__ __forceinline__ float shifted(const float* U, int m, int col, int seq_lo, int seq_hi, float mu) {
    const float uc = U[(size_t)m * ABINP + col];
    const float up = m > seq_lo ? U[(size_t)(m - 1) * ABINP + col] : 0.f;
    const float un = m + 1 < seq_hi ? U[(size_t)(m + 1) * ABINP + col] : 0.f;
    return uc + mu * (0.5f * (up + un) - uc);
}
__device__ __forceinline__ void ph_rwkv_prep(const Args& a, LAS unsigned char* L) {
    const int tid = threadIdx.x, lane = tid & 63, wave = tid >> 6, bid = blockIdx.x, nblk = gridDim.x;
    const float* U = AR_F32(A_U0);
    const float* mu = (const float*)a.in[11];
    const float* w0 = (const float*)a.in[12]; const float* w_up = (const float*)a.in[13]; const float* a0 = (const float*)a.in[14];
    const float* a_up = (const float*)a.in[15]; const float* g_up = (const float*)a.in[16]; const float* k_k = (const float*)a.in[17];
    const float* k_a = (const float*)a.in[18]; const float* r_k = (const float*)a.in[19];
    float* PWF = AR_F32(A_PREP); float* PWB = PWF + (size_t)MT * 1024; float* PWRF = PWB + (size_t)MT * 1024; float* PWRB = PWRF + (size_t)MT * 1024;
    float* PA = PWRB + (size_t)MT * 1024; float* PB = PA + (size_t)MT * 1024; float* PK = PB + (size_t)MT * 1024; float* PV = PK + (size_t)MT * 1024;
    bf16_t* PG = AR_BF(A_G); float* SCAL = AR_F32(A_SCAL);
    LAS float* lowr = (LAS float*)L;
    LAS float* res = lowr + 32 * 192;
    const int slab = bid & 7, q = tid >> 7, cl = tid & 127, c = slab * 128 + cl;
    const float* wsrc = q == 0 ? w_up : (q == 1 ? w_up + 64 * 1024 : (q == 2 ? a_up : g_up));
    float wreg[64];
#pragma unroll
    for (int j = 0; j < 64; ++j) wreg[j] = wsrc[j * 1024 + c];
    const float mu_r = mu[c], mu_k = mu[1024 + c], mu_v = mu[2048 + c];
    const float w0f = w0[c], w0b = w0[1024 + c], a0c = a0[c], kkc = k_k[c], kac = k_a[c], rkc = r_k[c];
    const int iv = q < 2 ? 0 : q - 1;
    for (int tile = bid >> 3; tile < MT / 32; tile += (nblk >> 3)) {
        const int m0 = tile * 32;
        const int seq_lo = m0 < 8192 ? (m0 & ~2047) : 8192 + ((m0 - 8192) & ~255);
        const int seq_hi = m0 < 8192 ? seq_lo + 2048 : seq_lo + 256;
        for (int idx = tid; idx < 32 * 192; idx += NTHR) { const int tt = idx / 192, j = idx - tt * 192;
            const float us = shifted(U, m0 + tt, 3072 + j, seq_lo, seq_hi, mu[3072 + j]);
            lowr[idx] = j < 64 ? tanhf(us) : (j < 128 ? us : 1.f / (1.f + expf(-us))); }
        __syncthreads();
        for (int tt = 0; tt < 32; ++tt) { float acc = 0.f; const LAS float* xv = lowr + tt * 192 + iv * 64;
#pragma unroll
            for (int j = 0; j < 64; j += 4) { const f32x4 x = *(const LAS f32x4*)(xv + j); acc += x.x * wreg[j]; acc += x.y * wreg[j + 1]; acc += x.z * wreg[j + 2]; acc += x.w * wreg[j + 3]; }
            res[(q * 32 + tt) * 128 + cl] = acc; }
        __syncthreads();
        const int h = c >> 6;
        for (int i = 0; i < 8; ++i) { const int tt = (tid >> 7) + 4 * i, m = m0 + tt;
            const float r = shifted(U, m, c, seq_lo, seq_hi, mu_r), k = shifted(U, m, 1024 + c, seq_lo, seq_hi, mu_k), v = shifted(U, m, 2048 + c, seq_lo, seq_hi, mu_v);
            const float pwf = w0f + res[(0 * 32 + tt) * 128 + cl], pwb = w0b + res[(1 * 32 + tt) * 128 + cl];
            const float decf = expf(-0.6065306597126334f / (1.f + expf(-pwf))), decb = expf(-0.6065306597126334f / (1.f + expf(-pwb)));
            const float alr = 1.f / (1.f + expf(-(a0c + res[(2 * 32 + tt) * 128 + cl])));
            const float g = res[(3 * 32 + tt) * 128 + cl];
            const float kkr = k * kkc; const float ssq = wave_sum(kkr * kkr); const float kk = kkr / fmaxf(sqrtf(ssq), 1e-12f);
            const float kp = k * (1.f + (alr - 1.f) * kac), ap = -kk, bp = kk * alr;
            const float br = wave_sum(bp * r), kr = wave_sum(kp * r), rkr = wave_sum(r * kp * rkc);
            const size_t o = (size_t)m * 1024 + c;
            PWF[o] = decf; PWB[o] = decb; PWRF[o] = decf * r; PWRB[o] = decb * r; PA[o] = ap; PB[o] = bp; PK[o] = kp; PV[o] = v; PG[o] = (bf16_t)f2bf(g);
            if (lane == 0) { f32x4 s4; s4.x = br; s4.y = kr; s4.z = rkr; s4.w = 0.f; *(f32x4*)(SCAL + ((size_t)m * 16 + h) * 4) = s4; } }
        __syncthreads();
    }
    const f32x2* tab = (const f32x2*)(a.ws + OFF_ROPE);
    bf16_t* SQ = AR_BF(A_SQ); bf16_t* SK = AR_BF(A_SK); bf16_t* SV = AR_BF(A_SV);
    const int gw = bid * 8 + wave, NGW = nblk * 8;
    for (int m = gw; m < MT; m += NGW) {
        const float* ur = U + (size_t)m * ABINP; const bool lat = m < 8192; const int t = m & 2047, prow = t >> 6, pcol = t & 63;
#pragma unroll
        for (int i = 0; i < 10; ++i) { const int p = lane + 64 * i, hd = p >> 5, ii = p & 31;
            const int base = hd < 16 ? 3264 + hd * 64 : 4288 + (hd - 16) * 64;
            const float x1 = ur[base + ii], x2 = ur[base + 32 + ii]; float o1 = x1, o2 = x2;
            if (lat) { const f32x2 cs = tab[(ii < 16 ? prow : pcol) * 16 + (ii & 15)]; o1 = x1 * cs.x - x2 * cs.y; o2 = x1 * cs.y + x2 * cs.x; }
            bf16_t* dst = hd < 16 ? SQ + (size_t)m * 1024 + hd * 64 : SK + (size_t)m * 256 + (hd - 16) * 64;
            dst[ii] = (bf16_t)f2bf(o1); dst[32 + ii] = (bf16_t)f2bf(o2); }
        const f32x4 vv = *(const f32x4*)(ur + 4544 + 4 * lane); u32x2 w; w.x = pk2(vv.x, vv.y); w.y = pk2(vv.z, vv.w); *(u32x2*)(SV + (size_t)m * 256 + 4 * lane) = w;
    }
}

__device__ __forceinline__ int scan_row(int gs, int d, int b) {
    if (gs < 256) { const int t = d ? 255 - gs : gs; return 8192 + b * 256 + t; }
    const int t2 = gs - 256; const int t = d ? 2047 - t2 : t2; return b * 2048 + t;
}
__device__ __forceinline__ void rwkv_scan_chain(const Args& a, LAS unsigned char* L, int chain) {
    const int tid = threadIdx.x, lane = tid & 63, wave = tid >> 6;
    const int d = chain >> 6, b = (chain >> 4) & 3, h = chain & 15;
    const float* P0 = AR_F32(A_PREP);
    const float* src0 = P0 + (size_t)(d ? 1 : 0) * MT * 1024;
    const float* src1 = P0 + (size_t)(d ? 3 : 2) * MT * 1024;
    const float* src2 = P0 + (size_t)4 * MT * 1024;
    const float* src3 = P0 + (size_t)5 * MT * 1024;
    const float* src4 = P0 + (size_t)6 * MT * 1024;
    const float* src5 = P0 + (size_t)7 * MT * 1024;
    const float* SCAL = AR_F32(A_SCAL);
    float* Y = AR_F32(d ? A_YB : A_YF);
    const int kg = lane & 15, rp = lane >> 4, r0 = 8 * wave + 2 * rp, k0 = 4 * kg;
    const int step_l = tid >> 4, piece = tid & 15;
    constexpr int BUF = 12416;
    LAS float* B0 = (LAS float*)L;
    f32x4 pre0, pre1, pre2, pre3, pre4, pre5, psc;
#define SCAN_LOAD(ci) do { const int m_ = scan_row((ci) * 32 + step_l, d, b); const size_t off_ = (size_t)m_ * 1024 + h * 64 + piece * 4; \
        pre0 = *(const f32x4*)(src0 + off_); pre1 = *(const f32x4*)(src1 + off_); pre2 = *(const f32x4*)(src2 + off_); pre3 = *(const f32x4*)(src3 + off_); \
        pre4 = *(const f32x4*)(src4 + off_); pre5 = *(const f32x4*)(src5 + off_); \
        if (tid < 32) { const int m2_ = scan_row((ci) * 32 + tid, d, b); psc = *(const f32x4*)(SCAL + ((size_t)m2_ * 16 + h) * 4); } } while (0)
#define SCAN_STORE(bi) do { LAS float* Bf_ = B0 + (bi) * BUF; const int o_ = step_l * 64 + piece * 4; \
        *(LAS f32x4*)(Bf_ + 0 * 2048 + o_) = pre0; *(LAS f32x4*)(Bf_ + 1 * 2048 + o_) = pre1; *(LAS f32x4*)(Bf_ + 2 * 2048 + o_) = pre2; *(LAS f32x4*)(Bf_ + 3 * 2048 + o_) = pre3; \
        *(LAS f32x4*)(Bf_ + 4 * 2048 + o_) = pre4; *(LAS f32x4*)(Bf_ + 5 * 2048 + o_) = pre5; if (tid < 32) *(LAS f32x4*)(Bf_ + 12288 + tid * 4) = psc; } while (0)
    SCAN_LOAD(0); SCAN_STORE(0); __syncthreads();
    f32x4 s0 = {0.f, 0.f, 0.f, 0.f}, s1 = {0.f, 0.f, 0.f, 0.f};
    for (int c = 0; c < 72; ++c) {
        if (c + 1 < 72) SCAN_LOAD(c + 1);
        const LAS float* Bf = B0 + (c & 1) * BUF;
        for (int s = 0; s < 32; ++s) {
            const f32x4 wv = *(const LAS f32x4*)(Bf + 0 * 2048 + s * 64 + k0), wrv = *(const LAS f32x4*)(Bf + 1 * 2048 + s * 64 + k0);
            const f32x4 av = *(const LAS f32x4*)(Bf + 2 * 2048 + s * 64 + k0), bv = *(const LAS f32x4*)(Bf + 3 * 2048 + s * 64 + k0), kv = *(const LAS f32x4*)(Bf + 4 * 2048 + s * 64 + k0);
            const f32x2 vv = *(const LAS f32x2*)(Bf + 5 * 2048 + s * 64 + r0); const f32x2 sc = *(const LAS f32x2*)(Bf + 12288 + s * 4);
            float sa0 = (s0.x * av.x + s0.y * av.y) + (s0.z * av.z + s0.w * av.w), sa1 = (s1.x * av.x + s1.y * av.y) + (s1.z * av.z + s1.w * av.w);
            float z0 = (s0.x * wrv.x + s0.y * wrv.y) + (s0.z * wrv.z + s0.w * wrv.w), z1 = (s1.x * wrv.x + s1.y * wrv.y) + (s1.z * wrv.z + s1.w * wrv.w);
            sa0 = row16_sum(sa0); sa1 = row16_sum(sa1); z0 = row16_sum(z0); z1 = row16_sum(z1);
            const float y0 = z0 + sa0 * sc.x + vv.x * sc.y, y1 = z1 + sa1 * sc.x + vv.y * sc.y;
            s0 = s0 * wv + (bv * sa0 + kv * vv.x); s1 = s1 * wv + (bv * sa1 + kv * vv.y);
            if (kg == 0) { const int m = scan_row(c * 32 + s, d, b); f32x2 yy; yy.x = y0; yy.y = y1; *(f32x2*)(Y + (size_t)m * 1024 + h * 64 + r0) = yy; }
        }
        if (c + 1 < 72) SCAN_STORE((c + 1) & 1);
        __syncthreads();
    }
#undef SCAN_LOAD
#undef SCAN_STORE
}

__device__ __forceinline__ void ph_rwkv_post(const Args& a) {
    const int tid = threadIdx.x, lane = tid & 63;
    const float* YF = AR_F32(A_YF); const float* YB = AR_F32(A_YB); const float* PV = AR_F32(A_PREP) + (size_t)7 * MT * 1024;
    const bf16_t* PG = AR_BF(A_G); const float* SCAL = AR_F32(A_SCAL); bf16_t* YA = AR_BF(A_YA);
    const float* lnw = (const float*)a.in[20]; const float* lnb = (const float*)a.in[21];
    for (int task = blockIdx.x; task < MT * 2; task += gridDim.x) {
        const int m = task >> 1, c = (task & 1) * 512 + tid, h = c >> 6;
        const size_t o = (size_t)m * 1024 + c;
        const float y = YF[o] + YB[o];
        const float mean = wave_sum(y) * (1.f / 64.f); const float dlt = y - mean; const float var = wave_sum(dlt * dlt) * (1.f / 64.f);
        const float yn = dlt * rsqrtf(var + 64e-5f);
        const float rkr = SCAL[((size_t)m * 16 + h) * 4 + 2];
        const float g = __uint_as_float((unsigned)PG[o] << 16);
        const float outv = (yn * lnw[c] + lnb[c] + rkr * PV[o]) * g;
        YA[(size_t)m * 2048 + c] = (bf16_t)f2bf(outv);
    }
}

struct AttnSeg { const bf16_t* K; const bf16_t* V; int n; };
template <int DV, int NSUB>
__device__ __forceinline__ void attn_unit(LAS unsigned char* L, const bf16_t* Q, int q_stride, AttnSeg sg0, AttnSeg sg1, int k_stride, int v_stride,
                                          bool masked, int qpos0, int kpos0, bool has_sink, float sink, float lmb, const float* subln, float post_scale,
                                          bf16_t* O, int o_stride) {
    const int tid = threadIdx.x, lane = tid & 63, wave = tid >> 6, fr = lane & 15, g = lane >> 4;
    constexpr int KROW = 72;
    LAS bf16_t* Ks = (LAS bf16_t*)L;
    LAS bf16_t* Vt = Ks + NSUB * 64 * KROW;
    LAS bf16_t* Pw = Vt + DV * KROW + wave * (NSUB * 16 * KROW);
    bf16x8 qf[NSUB][2];
#pragma unroll
    for (int s = 0; s < NSUB; ++s)
#pragma unroll
        for (int ks = 0; ks < 2; ++ks) qf[s][ks] = *(const bf16x8*)(Q + (size_t)(wave * 16 + fr) * q_stride + s * 64 + ks * 32 + g * 8);
    f32x4 o[NSUB][DV / 16];
    float mrow[NSUB][4], lrow[NSUB][4];
#pragma unroll
    for (int s = 0; s < NSUB; ++s) {
#pragma unroll
        for (int dt = 0; dt < DV / 16; ++dt) o[s][dt] = (f32x4){0.f, 0.f, 0.f, 0.f};
#pragma unroll
        for (int r = 0; r < 4; ++r) { mrow[s][r] = has_sink ? sink : -INFINITY; lrow[s][r] = has_sink ? 1.f : 0.f; }
    }
    const int nt0 = sg0.n >> 6, ntiles = nt0 + (sg1.n >> 6);
    const int srow = tid >> 3, spc = tid & 7;
    for (int t = 0; t < ntiles; ++t) {
        const bool in0 = t < nt0; const int j0 = in0 ? t * 64 : (t - nt0) * 64;
        const bf16_t* Kp = (in0 ? sg0.K : sg1.K) + (size_t)(j0 + srow) * k_stride + spc * 8;
        const bf16_t* Vp = (in0 ? sg0.V : sg1.V) + (size_t)(j0 + srow) * v_stride + spc * 8;
        u32x4 kreg[NSUB]; u32x4 vreg[DV / 64];
#pragma unroll
        for (int s = 0; s < NSUB; ++s) kreg[s] = *(const u32x4*)(Kp + s * 64);
#pragma unroll
        for (int p = 0; p < DV / 64; ++p) vreg[p] = *(const u32x4*)(Vp + p * 64);
        __syncthreads();
#pragma unroll
        for (int s = 0; s < NSUB; ++s) *(LAS u32x4*)(Ks + (s * 64 + srow) * KROW + spc * 8) = kreg[s];
#pragma unroll
        for (int p = 0; p < DV / 64; ++p) {
            const unsigned w4[4] = {vreg[p].x, vreg[p].y, vreg[p].z, vreg[p].w};
#pragma unroll
            for (int e = 0; e < 8; ++e) Vt[(p * 64 + spc * 8 + e) * KROW + srow] = (bf16_t)((w4[e >> 1] >> ((e & 1) * 16)) & 0xffffu);
        }
        __syncthreads();
#pragma unroll
        for (int s = 0; s < NSUB; ++s) {
            f32x4 sc[4];
#pragma unroll
            for (int nt = 0; nt < 4; ++nt) { sc[nt] = (f32x4){0.f, 0.f, 0.f, 0.f};
#pragma unroll
                for (int ks = 0; ks < 2; ++ks) { const bf16x8 kf = *(const LAS bf16x8*)(Ks + (s * 64 + nt * 16 + fr) * KROW + ks * 32 + g * 8);
                    sc[nt] = __builtin_amdgcn_mfma_f32_16x16x32_bf16(qf[s][ks], kf, sc[nt], 0, 0, 0); } }
            float mx[4];
#pragma unroll
            for (int r = 0; r < 4; ++r) mx[r] = -INFINITY;
#pragma unroll
            for (int nt = 0; nt < 4; ++nt)
#pragma unroll
                for (int r = 0; r < 4; ++r) { float x = sc[nt][r] * 0.125f;
                    if (masked && in0) { const int kp = kpos0 + j0 + nt * 16 + fr, qp = qpos0 + wave * 16 + 4 * g + r; const int df = kp - qp; if (df > 128 || df < -128) x = -INFINITY; }
                    sc[nt][r] = x; mx[r] = fmaxf(mx[r], x); }
            float alpha[4];
#pragma unroll
            for (int r = 0; r < 4; ++r) { const float mt = row16_max(mx[r]); const float mn = fmaxf(mrow[s][r], mt);
                alpha[r] = (mn == -INFINITY) ? 1.f : __expf(mrow[s][r] - mn); mrow[s][r] = mn; }
            float rs[4] = {0.f, 0.f, 0.f, 0.f};
#pragma unroll
            for (int nt = 0; nt < 4; ++nt)
#pragma unroll
                for (int r = 0; r < 4; ++r) { const float p = (mrow[s][r] == -INFINITY) ? 0.f : __expf(sc[nt][r] - mrow[s][r]); rs[r] += p;
                    Pw[(s * 16 + 4 * g + r) * KROW + nt * 16 + fr] = (bf16_t)f2bf(p); }
#pragma unroll
            for (int r = 0; r < 4; ++r) { lrow[s][r] = lrow[s][r] * alpha[r] + row16_sum(rs[r]); }
#pragma unroll
            for (int dt = 0; dt < DV / 16; ++dt)
#pragma unroll
                for (int r = 0; r < 4; ++r) o[s][dt][r] *= alpha[r];
        }
#pragma unroll
        for (int s = 0; s < NSUB; ++s)
#pragma unroll
            for (int ks = 0; ks < 2; ++ks) { const bf16x8 pf = *(const LAS bf16x8*)(Pw + (s * 16 + fr) * KROW + ks * 32 + g * 8);
#pragma unroll
                for (int dt = 0; dt < DV / 16; ++dt) { const bf16x8 vf = *(const LAS bf16x8*)(Vt + (dt * 16 + fr) * KROW + ks * 32 + g * 8);
                    o[s][dt] = __builtin_amdgcn_mfma_f32_16x16x32_bf16(pf, vf, o[s][dt], 0, 0, 0); } }
    }
    if (NSUB == 1) {
#pragma unroll
        for (int r = 0; r < 4; ++r) { const float inv = 1.f / lrow[0][r]; bf16_t* op = O + (size_t)(wave * 16 + 4 * g + r) * o_stride + fr;
#pragma unroll
            for (int dt = 0; dt < DV / 16; ++dt) op[dt * 16] = (bf16_t)f2bf(o[0][dt][r] * inv); }
    } else {
#pragma unroll
        for (int r = 0; r < 4; ++r) { const float i0 = 1.f / lrow[0][r], i1 = lmb / lrow[NSUB - 1][r]; float val[DV / 16]; float ss = 0.f;
#pragma unroll
            for (int dt = 0; dt < DV / 16; ++dt) { val[dt] = o[0][dt][r] * i0 - o[NSUB - 1][dt][r] * i1; ss += val[dt] * val[dt]; }
            ss = row16_sum(ss); const float rstd = rsqrtf(ss * (1.f / DV) + 1e-5f) * post_scale;
            bf16_t* op = O + (size_t)(wave * 16 + 4 * g + r) * o_stride + fr;
#pragma unroll
            for (int dt = 0; dt < DV / 16; ++dt) op[dt * 16] = (bf16_t)f2bf(val[dt] * rstd * subln[dt * 16 + fr]); }
    }
    __syncthreads();
}

__device__ __forceinline__ void ph_mix0(const Args& a, LAS unsigned char* L) {
    const int bid = blockIdx.x;
    if (bid < 128) { rwkv_scan_chain(a, L, bid); return; }
    const bf16_t* SQ = AR_BF(A_SQ); const bf16_t* SK = AR_BF(A_SK); const bf16_t* SV = AR_BF(A_SV); bf16_t* YA = AR_BF(A_YA);
    const float* sinkp = (const float*)a.in[22];
    for (int u = bid - 128; u < 1152; u += 128) {
        AttnSeg s0, s1; int qrow0, qh, qpos0 = 0, kpos0 = 0; bool masked;
        if (u < 1024) { const int b = u >> 8, qb = u & 15; qh = (u >> 4) & 15; const int kvh = qh >> 2;
            const int ks = qb * 128 - 128 < 0 ? 0 : qb * 128 - 128, ke = qb * 128 + 256 > 2048 ? 2048 : qb * 128 + 256;
            qrow0 = b * 2048 + qb * 128;
            s0.K = SK + (size_t)(b * 2048 + ks) * 256 + kvh * 64; s0.V = SV + (size_t)(b * 2048 + ks) * 256 + kvh * 64; s0.n = ke - ks;
            s1.K = SK + (size_t)(8192 + b * 256) * 256 + kvh * 64; s1.V = SV + (size_t)(8192 + b * 256) * 256 + kvh * 64; s1.n = 256;
            masked = true; qpos0 = qb * 128; kpos0 = ks;
        } else { const int uu = u - 1024, b = uu >> 5, half = uu & 1; qh = (uu >> 1) & 15; const int kvh = qh >> 2;
            qrow0 = 8192 + b * 256 + half * 128;
            s0.K = SK + (size_t)(8192 + b * 256) * 256 + kvh * 64; s0.V = SV + (size_t)(8192 + b * 256) * 256 + kvh * 64; s0.n = 256;
            s1.K = s0.K; s1.V = s0.V; s1.n = 0; masked = false;
        }
        attn_unit<64, 1>(L, SQ + (size_t)qrow0 * 1024 + qh * 64, 1024, s0, s1, 256, 256, masked, qpos0, kpos0, true, sinkp[qh], 0.f, nullptr, 1.f,
                         YA + (size_t)qrow0 * 2048 + 1024 + qh * 64, 2048);
    }
}

__device__ __forceinline__ void ph_diff_prep(const Args& a) {
    const int tid = threadIdx.x, lane = tid & 63, wave = tid >> 6, gw = blockIdx.x * 8 + wave, NGW = gridDim.x * 8;
    const float* U = AR_F32(A_U1); const f32x2* tab = (const f32x2*)(a.ws + OFF_ROPE);
    bf16_t* QD = AR_BF(A_QD); bf16_t* KD = AR_BF(A_KD); bf16_t* VD = AR_BF(A_VD);
    for (int m = gw; m < MT; m += NGW) {
        const float* ur = U + (size_t)m * 8192; const bool lat = m < 8192; const int t = m & 2047, prow = t >> 6, pcol = t & 63;
#pragma unroll
        for (int i = 0; i < 16; ++i) { const int p = lane + 64 * i;
            const int isk = p >> 9, hs = (p >> 5) & 15, ii = p & 31;
            if (!isk && !lat) continue;
            const int base = isk * 1024 + hs * 64;
            const float x1 = ur[base + ii], x2 = ur[base + 32 + ii]; float o1 = x1, o2 = x2;
            if (lat) { const f32x2 cs = tab[(ii < 16 ? prow : pcol) * 16 + (ii & 15)]; o1 = x1 * cs.x - x2 * cs.y; o2 = x1 * cs.y + x2 * cs.x; }
            bf16_t* dst = (isk ? KD : QD) + (size_t)m * 1024 + hs * 64;
            dst[ii] = (bf16_t)f2bf(o1); dst[32 + ii] = (bf16_t)f2bf(o2); }
#pragma unroll
        for (int i = 0; i < 4; ++i) { const f32x4 vv = *(const f32x4*)(ur + 2048 + 256 * i + 4 * lane); u32x2 w; w.x = pk2(vv.x, vv.y); w.y = pk2(vv.z, vv.w);
            *(u32x2*)(VD + (size_t)m * 1024 + 256 * i + 4 * lane) = w; }
    }
}

__device__ __forceinline__ int hgrn_row(int gs, int d, int b) { return scan_row(gs, d, b); }
__device__ __forceinline__ void hgrn_chain(const Args& a, LAS unsigned char* L, int chain) {
    const int tid = threadIdx.x, lane = tid & 63, wave = tid >> 6, fr = lane & 15, g = lane >> 4;
    const int d = chain >> 5, b = (chain >> 3) & 3, h = chain & 7;
    const float* U = AR_F32(A_U1);
    const float* lbl = (const float*)a.in[28];
    float* OUT = AR_F32(d ? A_OB : A_OF);
    constexpr int QROW = 136;
    LAS bf16_t* Qt = (LAS bf16_t*)L; LAS bf16_t* Kt = Qt + 16 * QROW; LAS bf16_t* KtT = Kt + 16 * QROW; LAS bf16_t* VT = KtT + 128 * 16; LAS float* eL = (LAS float*)(VT + 128 * 16);
    const int qcol = 3072 + h * 128, zcol = 3072 + 1024 * (1 + d) + h * 128, icol = 3072 + 3072 + h * 128;
    float lbk = 0.f;
    if (tid < 128) { const float l0 = lbl[d * 1024 + h * 128 + tid], l1 = lbl[2048 + d * 1024 + h * 128 + tid]; const float mxl = fmaxf(l0, l1);
        const float e0 = expf(l0 - mxl), e1 = expf(l1 - mxl); lbk = e1 / (e0 + e1); }
    f32x4 sacc[8];
#pragma unroll
    for (int mt = 0; mt < 8; ++mt) sacc[mt] = (f32x4){0.f, 0.f, 0.f, 0.f};
    const bf16x8 zero8 = {0, 0, 0, 0, 0, 0, 0, 0};
    for (int c = 0; c < 144; ++c) {
        if (tid < 128) { float bcum = 0.f;
            for (int s = 0; s < 16; ++s) { const int m = hgrn_row(c * 16 + s, d, b); const float z = U[(size_t)m * 8192 + zcol + tid], qv = U[(size_t)m * 8192 + qcol + tid];
                const float e = expf(-fabsf(z)); const float sp = 1.f / (1.f + e), sn = e * sp; const float sig = z >= 0.f ? sp : sn, sigm = z >= 0.f ? sn : sp;
                const float f = lbk + (1.f - lbk) * sig; const float kg = (1.f - lbk) * sigm;
                bcum += logf(f);
                Qt[s * QROW + tid] = (bf16_t)f2bf(qv * expf(bcum));
                const float kt = kg * expf(-fmaxf(bcum, -80.f));
                const bf16_t kb = (bf16_t)f2bf(kt); Kt[s * QROW + tid] = kb; KtT[tid * 16 + s] = kb; }
            eL[tid] = expf(bcum);
        } else { for (int idx = tid - 128; idx < 2048; idx += 384) { const int s = idx >> 7, v = idx & 127; const int m = hgrn_row(c * 16 + s, d, b);
                VT[v * 16 + s] = (bf16_t)f2bf(U[(size_t)m * 8192 + icol + v]); } }
        __syncthreads();
        f32x4 att = {0.f, 0.f, 0.f, 0.f};
#pragma unroll
        for (int ks = 0; ks < 4; ++ks) { const bf16x8 af = *(const LAS bf16x8*)(Kt + fr * QROW + ks * 32 + g * 8), bfv = *(const LAS bf16x8*)(Qt + fr * QROW + ks * 32 + g * 8);
            att = __builtin_amdgcn_mfma_f32_16x16x32_bf16(af, bfv, att, 0, 0, 0); }
#pragma unroll
        for (int r = 0; r < 4; ++r) if (4 * g + r > fr) att[r] = 0.f;
        f32x4 oacc = {0.f, 0.f, 0.f, 0.f};
#pragma unroll
        for (int ks = 0; ks < 4; ++ks) {
            const f32x4 sA = sacc[2 * ks], sB = sacc[2 * ks + 1];
            u32x4 aw; aw.x = pk2(sA[0], sA[1]); aw.y = pk2(sA[2], sA[3]); aw.z = pk2(sB[0], sB[1]); aw.w = pk2(sB[2], sB[3]);
            const u32x2 q0 = *(const LAS u32x2*)(Qt + fr * QROW + ks * 32 + 4 * g), q1 = *(const LAS u32x2*)(Qt + fr * QROW + ks * 32 + 16 + 4 * g);
            u32x4 bw; bw.x = q0.x; bw.y = q0.y; bw.z = q1.x; bw.w = q1.y;
            oacc = __builtin_amdgcn_mfma_f32_16x16x32_bf16(__builtin_bit_cast(bf16x8, aw), __builtin_bit_cast(bf16x8, bw), oacc, 0, 0, 0);
        }
        { const u32x2 v4 = *(const LAS u32x2*)(VT + (wave * 16 + fr) * 16 + 4 * g);
          u32x4 aw; aw.x = v4.x; aw.y = v4.y; aw.z = 0u; aw.w = 0u;
          u32x4 bw; bw.x = pk2(att[0], att[1]); bw.y = pk2(att[2], att[3]); bw.z = 0u; bw.w = 0u;
          oacc = __builtin_amdgcn_mfma_f32_16x16x32_bf16(__builtin_bit_cast(bf16x8, aw), __builtin_bit_cast(bf16x8, bw), oacc, 0, 0, 0); }
        if (c >= 16) { const int m = hgrn_row(c * 16 + fr, d, b); *(f32x4*)(OUT + (size_t)m * 1024 + h * 128 + wave * 16 + 4 * g) = oacc; }
        { const bf16x8 vb = g < 2 ? *(const LAS bf16x8*)(VT + (wave * 16 + fr) * 16 + 8 * g) : zero8;
#pragma unroll
          for (int mt = 0; mt < 8; ++mt) { const bf16x8 ka = g < 2 ? *(const LAS bf16x8*)(KtT + (mt * 16 + fr) * 16 + 8 * g) : zero8;
              sacc[mt] = __builtin_amdgcn_mfma_f32_16x16x32_bf16(ka, vb, sacc[mt], 0, 0, 0);
              const f32x4 ev = *(const LAS f32x4*)(eL + mt * 16 + 4 * g); sacc[mt] = sacc[mt] * ev; } }
        __syncthreads();
    }
}

__device__ __forceinline__ void ph_mix1(const Args& a, LAS unsigned char* L) {
    const int bid = blockIdx.x;
    if (bid < 64) { hgrn_chain(a, L, bid); return; }
    const bf16_t* QD = AR_BF(A_QD); const bf16_t* KD = AR_BF(A_KD); const bf16_t* VD = AR_BF(A_VD); bf16_t* YC = AR_BF(A_YC);
    const float* lam = (const float*)a.in[25]; const float* subln = (const float*)a.in[26];
    float d01 = 0.f, d23 = 0.f;
    for (int j = 0; j < 64; ++j) { d01 += lam[j] * lam[64 + j]; d23 += lam[128 + j] * lam[192 + j]; }
    const float lam_init = 0.8f - 0.6f * expf(-0.3f);
    const float lmb = expf(d01) - expf(d23) + lam_init;
    for (int u = bid - 64; u < 512; u += 192) {
        const int b = u >> 7, h = (u >> 4) & 7, qb = u & 15; const int qrow0 = b * 2048 + qb * 128;
        AttnSeg s0, s1;
        s0.K = KD + (size_t)(b * 2048) * 1024 + h * 128; s0.V = VD + (size_t)(b * 2048) * 1024 + h * 128; s0.n = 2048;
        s1.K = KD + (size_t)(8192 + b * 256) * 1024 + h * 128; s1.V = VD + (size_t)(8192 + b * 256) * 1024 + h * 128; s1.n = 256;
        attn_unit<128, 2>(L, QD + (size_t)qrow0 * 1024 + h * 128, 1024, s0, s1, 1024, 1024, false, 0, 0, false, 0.f, lmb, subln, 1.f - lam_init,
                          YC + (size_t)qrow0 * 2048 + h * 128, 2048);
    }
}

__device__ __forceinline__ void ph_hgrn_post(const Args& a) {
    const int tid = threadIdx.x, lane = tid & 63, wave = tid >> 6, gw = blockIdx.x * 8 + wave, NGW = gridDim.x * 8;
    const float* OF = AR_F32(A_OF); const float* OB = AR_F32(A_OB); const float* U = AR_F32(A_U1); const float* gn = (const float*)a.in[27]; bf16_t* YC = AR_BF(A_YC);
    for (int task = gw; task < ML * 8; task += NGW) {
        const int m = task >> 3, h = task & 7; const size_t o = (size_t)m * 1024 + h * 128 + 2 * lane;
        const f32x2 x0 = *(const f32x2*)(OF + o), x1 = *(const f32x2*)(OB + o); const float y0 = x0.x + x1.x, y1 = x0.y + x1.y;
        const float rstd = rsqrtf(wave_sum(y0 * y0 + y1 * y1) * (1.f / 128.f) + 1e-6f);
        const f32x2 gg = *(const f32x2*)(U + (size_t)m * 8192 + 3072 + 4096 + h * 128 + 2 * lane);
        const float s0 = gg.x / (1.f + __expf(-gg.x)), s1 = gg.y / (1.f + __expf(-gg.y));
        const float r0 = y0 * rstd * gn[2 * lane] * s0, r1 = y1 * rstd * gn[2 * lane + 1] * s1;
        *(unsigned*)(YC + (size_t)m * 2048 + 1024 + h * 128 + 2 * lane) = pk2(r0, r1);
    }
}
#define MK_SINGLE 0

#ifndef MK_SINGLE
#define MK_SINGLE 0
#endif
constexpr int NPHASE = 20;

__global__ void __launch_bounds__(NTHR, 2) mk_fwd(Args a) {
    extern __shared__ __attribute__((aligned(16))) unsigned char lds_raw[];
    LAS unsigned char* L = (LAS unsigned char*)lds_raw;
    const float* mod0 = WS_F32(OFF_MOD); const float* mod1 = mod0 + 5 * 12288;
    const int G = gridDim.x, bx = blockIdx.x;
#if MK_SINGLE
    cg::grid_group grid = cg::this_grid();
#define SEAM(k) do { if (a.ph_lo <= (k) && (k) + 1 < a.ph_hi) grid.sync(); } while (0)
#else
#define SEAM(k) do { } while (0)
#endif
#define IN(k) (a.ph_lo <= (k) && (k) < a.ph_hi)
    typedef pg8::StaticOrder SO;
    if (IN(0)) { ph_prologue(a, L); SEAM(0); }
    if (IN(1)) { ph_modulate((const float*)a.in[0], (const float*)a.in[2], MT, mod0, 0, 1, WS_BF(OFF_HN)); SEAM(1); }
    if (IN(2)) { pg8::Gemm g{WS_BF(OFF_HN), WS_BF(WT_ABIN), MT, ABINP, DM}; SO S; S.init(MT, ABINP, G, bx); pg8::EpiF32 E{AR_F32(A_U0), ABINP};
        pg8::gemm_phase<pg8::EpiF32, SO, true, true>(L, g, S, E); SEAM(2); }
    if (IN(3)) { ph_rwkv_prep(a, L); SEAM(3); }
    if (IN(4)) { ph_mix0(a, L); SEAM(4); }
    if (IN(5)) { ph_rwkv_post(a); SEAM(5); }
    if (IN(6)) { pg8::Gemm g{AR_BF(A_YA), WS_BF(WT_ABOUT), MT, DM, DM}; SO S; S.init(MT, DM, G, bx);
        pg8::EpiResGate E{(const float*)a.in[0], (const float*)a.in[2], AR_F32(A_X1), mod0 + 2 * 2048};
        pg8::gemm_phase<pg8::EpiResGate, SO, true, true>(L, g, S, E); SEAM(6); }
    if (IN(7)) { ph_modulate(AR_F32(A_X1), AR_F32(A_X1) + (size_t)ML * DM, MT, mod0, 3, 4, WS_BF(OFF_HN)); SEAM(7); }
    if (IN(8)) { pg8::Gemm g{WS_BF(OFF_HN), WS_BF(WT_W1_0), MT, FF, DM}; SO S; S.init(MT, FF, G, bx); pg8::EpiSqReluBf16 E{AR_BF(A_HID), FF};
        pg8::gemm_phase<pg8::EpiSqReluBf16, SO, true, true>(L, g, S, E); SEAM(8); }
    if (IN(9)) { pg8::Gemm g{AR_BF(A_HID), WS_BF(WT_W2_0), MT, DM, FF}; SO S; S.init(MT, DM, G, bx);
        pg8::EpiResGate E{AR_F32(A_X1), AR_F32(A_X1) + (size_t)ML * DM, AR_F32(A_X2), mod0 + 5 * 2048};
        pg8::gemm_phase<pg8::EpiResGate, SO, true, true>(L, g, S, E); SEAM(9); }
    if (IN(10)) { ph_modulate(AR_F32(A_X2), AR_F32(A_X2) + (size_t)ML * DM, MT, mod1, 0, 1, WS_BF(OFF_HN)); SEAM(10); }
    if (IN(11)) { pg8::Gemm g{WS_BF(OFF_HN), WS_BF(WT_CDIN), MT, FF, DM}; SO S; S.init(MT, FF, G, bx); pg8::EpiF32 E{AR_F32(A_U1), FF};
        pg8::gemm_phase<pg8::EpiF32, SO, true, true>(L, g, S, E); SEAM(11); }
    if (IN(12)) { ph_diff_prep(a); SEAM(12); }
    if (IN(13)) { ph_mix1(a, L); SEAM(13); }
    if (IN(14)) { ph_hgrn_post(a); SEAM(14); }
    if (IN(15)) { pg8::Gemm g{AR_BF(A_YC), WS_BF(WT_CDOUT), ML, DM, DM}; SO S; S.init(ML, DM, G, bx);
        pg8::EpiResGate E{AR_F32(A_X2), AR_F32(A_X2) + (size_t)ML * DM, AR_F32(A_X3), mod1 + 2 * 2048};
        pg8::gemm_phase<pg8::EpiResGate, SO, true, true>(L, g, S, E); SEAM(15); }
    if (IN(16)) { ph_modulate(AR_F32(A_X3), AR_F32(A_X3), ML, mod1, 3, 4, WS_BF(OFF_HN)); SEAM(16); }
    if (IN(17)) { pg8::Gemm g{WS_BF(OFF_HN), WS_BF(WT_W1_1), ML, FF, DM}; SO S; S.init(ML, FF, G, bx); pg8::EpiSqReluBf16 E{AR_BF(A_HID1), FF};
        pg8::gemm_phase<pg8::EpiSqReluBf16, SO, true, true>(L, g, S, E); SEAM(17); }
    if (IN(18)) { pg8::Gemm g{AR_BF(A_HID1), WS_BF(WT_W2_1), ML, DM, FF}; SO S; S.init(ML, DM, G, bx);
        pg8::EpiResGate E{AR_F32(A_X3), AR_F32(A_X3), a.out, mod1 + 5 * 2048};
        pg8::gemm_phase<pg8::EpiResGate, SO, true, true>(L, g, S, E); SEAM(18); }
    if (IN(19)) { ph_final(a); }
#undef IN
#undef SEAM
}

extern "C" void kernel_launch(void* const* d_in, const int* in_sizes, int n_in, void* d_out, int out_size, void* d_ws, size_t ws_size, hipStream_t stream) {
    static int grid = 0;
    if (grid == 0) {
        if (n_in != 29 || out_size != ML * DM || ws_size < WS_TOTAL) { fprintf(stderr, "kernel_launch: unexpected shapes (n_in %d, out %d, ws %zu < %zu)\n", n_in, out_size, ws_size, (size_t)WS_TOTAL); grid = -1; return; }
        int dev = 0, cus = 0, per_cu = 0;
        if (hipGetDevice(&dev) != hipSuccess || hipDeviceGetAttribute(&cus, hipDeviceAttributeMultiprocessorCount, dev) != hipSuccess) { grid = -1; return; }
        if (hipFuncSetAttribute((const void*)mk_fwd, hipFuncAttributeMaxDynamicSharedMemorySize, LDS_BYTES) != hipSuccess) { fprintf(stderr, "kernel_launch: hipFuncSetAttribute failed\n"); grid = -1; return; }
        if (hipOccupancyMaxActiveBlocksPerMultiprocessor(&per_cu, (const void*)mk_fwd, NTHR, LDS_BYTES) != hipSuccess || per_cu < 1) { fprintf(stderr, "kernel_launch: occupancy query says %d\n", per_cu); grid = -1; (void)hipGetLastError(); return; }
        grid = cus;
        if (grid != NBLK) { fprintf(stderr, "kernel_launch: built for %d CUs, device has %d\n", NBLK, cus); grid = -1; return; }
    }
    if (grid < 0) return;
    Args a{};
    for (int i = 0; i < 29; ++i) a.in[i] = d_in[i];
    a.out = (float*)d_out; a.ws = (unsigned char*)d_ws;
#if MK_SINGLE
    a.ph_lo = 0; a.ph_hi = NPHASE;
    void* args[] = {&a};
    hipError_t e = hipLaunchCooperativeKernel((const void*)mk_fwd, dim3(grid), dim3(NTHR), args, LDS_BYTES, stream);
    if (e != hipSuccess) fprintf(stderr, "kernel_launch: cooperative launch failed: %s\n", hipGetErrorString(e));
#else
    for (int p = 0; p < NPHASE; ++p) { a.ph_lo = p; a.ph_hi = p + 1; hipLaunchKernelGGL(mk_fwd, dim3(grid), dim3(NTHR), LDS_BYTES, stream, a); }
#endif
}
```

```cpp
#include <hip/hip_runtime.h>
#include <hip/hip_cooperative_groups.h>
#include <cstdio>
#include <cstdint>
namespace cg = cooperative_groups;

#define LAS __attribute__((address_space(3)))
typedef unsigned short bf16_t;
typedef short bf16x8 __attribute__((ext_vector_type(8)));
typedef short bf16x4 __attribute__((ext_vector_type(4)));
typedef float f32x4 __attribute__((ext_vector_type(4)));
typedef float f32x2 __attribute__((ext_vector_type(2)));
typedef unsigned u32x4 __attribute__((ext_vector_type(4)));
typedef unsigned u32x2 __attribute__((ext_vector_type(2)));

constexpr int DM = 2048, NB = 4, TL = 2048, TC = 256, ML = NB * TL, MC = NB * TC, MT = ML + MC, FF = 8192;
constexpr int MODW = 6 * DM;
constexpr int ABINP = 4864;
constexpr int NBLK = 256, NTHR = 512;

constexpr size_t OFF_CTL = 0;
constexpr size_t OFF_MOD = 1048576;
constexpr size_t OFF_ROPE = 1572864;
constexpr size_t OFF_WT = 2097152;
constexpr size_t WT_ABIN = OFF_WT;
constexpr size_t WT_ABOUT = WT_ABIN + (size_t)ABINP * DM * 2;
constexpr size_t WT_W1_0 = WT_ABOUT + (size_t)DM * DM * 2;
constexpr size_t WT_W2_0 = WT_W1_0 + (size_t)FF * DM * 2;
constexpr size_t WT_CDIN = WT_W2_0 + (size_t)FF * DM * 2;
constexpr size_t WT_CDOUT = WT_CDIN + (size_t)FF * DM * 2;
constexpr size_t WT_W1_1 = WT_CDOUT + (size_t)DM * DM * 2;
constexpr size_t WT_W2_1 = WT_W1_1 + (size_t)FF * DM * 2;
constexpr size_t OFF_HN = WT_W2_1 + (size_t)FF * DM * 2;
constexpr size_t OFF_ARENA = OFF_HN + (size_t)MT * DM * 2;
constexpr size_t SZ_TOK1K_F32 = (size_t)MT * 1024 * 4;
constexpr size_t A_U0 = 0;
constexpr size_t A_PREP = A_U0 + (size_t)MT * ABINP * 4;
constexpr size_t A_G = A_PREP + 8 * SZ_TOK1K_F32;
constexpr size_t A_SCAL = A_G + (size_t)MT * 1024 * 2;
constexpr size_t A_SQ = A_SCAL + (size_t)MT * 16 * 16;
constexpr size_t A_SK = A_SQ + (size_t)MT * 1024 * 2;
constexpr size_t A_SV = A_SK + (size_t)MT * 256 * 2;
constexpr size_t A_L0END = A_SV + (size_t)MT * 256 * 2;
constexpr size_t A_YF = 0, A_YB = SZ_TOK1K_F32, A_YA = 2 * SZ_TOK1K_F32;
constexpr size_t A_X1 = A_PREP;
constexpr size_t A_HID = A_PREP + (size_t)MT * DM * 4;
constexpr size_t A_X2 = 0;
static_assert(A_YA + (size_t)MT * DM * 2 <= A_PREP, "ws map");
static_assert(A_HID + (size_t)MT * FF * 2 <= A_L0END, "ws map");
constexpr size_t A_U1 = A_X2 + (size_t)MT * DM * 4;
constexpr size_t A_QD = A_U1 + (size_t)MT * FF * 4;
constexpr size_t A_KD = A_QD + (size_t)ML * 1024 * 2;
constexpr size_t A_VD = A_KD + (size_t)MT * 1024 * 2;
constexpr size_t A_OF = A_VD + (size_t)MT * 1024 * 2;
constexpr size_t A_OB = A_OF + (size_t)ML * 1024 * 4;
constexpr size_t A_YC = A_OB + (size_t)ML * 1024 * 4;
constexpr size_t A_L1END = A_YC + (size_t)ML * DM * 2;
constexpr size_t A_X3 = A_U1;
constexpr size_t A_HID1 = A_U1 + (size_t)ML * DM * 4;
static_assert(A_HID1 + (size_t)ML * FF * 2 <= A_QD, "ws map");
constexpr size_t WS_TOTAL = OFF_ARENA + (A_L0END > A_L1END ? A_L0END : A_L1END);
static_assert(WS_TOTAL <= 805306368ull, "d_ws budget (4 x the largest tensor)");

constexpr int LDS_BYTES = 147456;

__device__ __forceinline__ unsigned f2bf(float f) { unsigned u = __builtin_bit_cast(unsigned, f); return (u + 0x7fffu + ((u >> 16) & 1u)) >> 16; }
__device__ __forceinline__ unsigned pk2(float lo, float hi) { return f2bf(lo) | (f2bf(hi) << 16); }
__device__ __forceinline__ float wave_sum(float v) {
#pragma unroll
    for (int o = 1; o < 64; o <<= 1) v += __shfl_xor(v, o);
    return v;
}
__device__ __forceinline__ float dppf(float x, const int ctrl_sel) {
    const int xi = __builtin_bit_cast(int, x); int r;
    if (ctrl_sel == 0) r = __builtin_amdgcn_update_dpp(xi, xi, 0xB1, 0xF, 0xF, true);
    else if (ctrl_sel == 1) r = __builtin_amdgcn_update_dpp(xi, xi, 0x4E, 0xF, 0xF, true);
    else if (ctrl_sel == 2) r = __builtin_amdgcn_update_dpp(xi, xi, 0x141, 0xF, 0xF, true);
    else r = __builtin_amdgcn_update_dpp(xi, xi, 0x140, 0xF, 0xF, true);
    return __builtin_bit_cast(float, r);
}
__device__ __forceinline__ float row16_sum(float x) { x += dppf(x, 0); x += dppf(x, 1); x += dppf(x, 2); x += dppf(x, 3); return x; }
__device__ __forceinline__ float row16_max(float x) { x = fmaxf(x, dppf(x, 0)); x = fmaxf(x, dppf(x, 1)); x = fmaxf(x, dppf(x, 2)); x = fmaxf(x, dppf(x, 3)); return x; }
__device__ __forceinline__ float sigmoidf_(float x) { return 1.f / (1.f + __expf(-x)); }

struct Args { const void* in[29]; float* out; unsigned char* ws; int ph_lo, ph_hi; };

namespace pg8 {
#define PG8_LAS __attribute__((address_space(3)))
typedef unsigned short bf16_t;
typedef short bf16x8 __attribute__((ext_vector_type(8)));
typedef float f32x4 __attribute__((ext_vector_type(4)));
typedef unsigned u32x4 __attribute__((ext_vector_type(4)));
constexpr int BM = 256, BK = 64, HALF = 128, HTB = HALF * BK * 2  , STAGE_BYTES = 8 * HTB, NXCD = 8, WGM = 8;

__host__ __device__ __forceinline__ int lds_byte(int r, int c) { const int st = (r >> 4) * 2 + (c >> 5), rr = r & 15, cc = c & 31, ob = rr * 64 + cc * 2; return st * 1024 + (ob ^ (((ob >> 9) & 1) << 5)); }
__host__ __device__ __forceinline__ void stage_rc(int b, int& R, int& C) { const int st = b / 1024, sb = b % 1024, swz = sb ^ (((sb >> 9) & 1) << 5); R = (st >> 1) * 16 + swz / 64; C = (st & 1) * 32 + (swz % 64) / 2; }
__host__ __device__ __forceinline__ int perm32(int rho) { const int n = rho >> 4, i = rho & 15; return 8 * (i >> 2) + 4 * n + (i & 3); }

struct Unit { int pm, pn; };
struct Gemm { const bf16_t* A; const bf16_t* Bt; int M, N, K; };

struct StaticOrder {
    int nM, nN, nwg, G, c;
    __host__ __device__ void init(int M, int N, int G_, int c_) { nM = M / BM; nN = N / BM; nwg = nM * nN; G = G_; c = c_; }
    __host__ __device__ bool next(int i, Unit& u) const {
        const long L = (long)i * G + c; if (L >= nwg) return false;
        int wgid = (int)L; { const int q = nwg / NXCD, r = nwg % NXCD, xcd = wgid % NXCD, off = wgid / NXCD; wgid = (xcd < r ? xcd * (q + 1) : r * (q + 1) + (xcd - r) * q) + off; }
        const int nig = WGM * nN, gid = wgid / nig, fm = gid * WGM, gsz = (nM - fm) < WGM ? (nM - fm) : WGM;
        u.pm = fm + ((wgid % nig) % gsz); u.pn = (wgid % nig) / gsz; return true;
    }
    __device__ __forceinline__ void a_ready(const Unit&) const {}
    __device__ __forceinline__ void done(const Unit&) const {}
};


struct EpiF32 {
    static constexpr bool PERM = false, AFTER_DRAIN = false;
    float* O; int ldc;
    __device__ __forceinline__ void operator()(const f32x4 (&acc)[2][2][4][2], const Unit& u, int wr, int wc, int fr, int fq) const {
        const int col0 = u.pn * BM + wc * 32 + 4 * fq;
#pragma unroll
        for (int ai = 0; ai < 2; ++ai)
#pragma unroll
            for (int m = 0; m < 4; ++m) { float* rowp = O + (size_t)(u.pm * BM + ai * HALF + wr * 64 + m * 16 + fr) * ldc + col0;
#pragma unroll
                for (int bj = 0; bj < 2; ++bj)
#pragma unroll
                    for (int n = 0; n < 2; ++n) *(f32x4*)(rowp + bj * HALF + n * 16) = acc[ai][bj][m][n]; }
    }
};
struct EpiResGate {
    static constexpr bool PERM = false, AFTER_DRAIN = false;
    const float* baseL; const float* baseC; float* out; const float* gate;
    __device__ __forceinline__ void operator()(const f32x4 (&acc)[2][2][4][2], const Unit& u, int wr, int wc, int fr, int fq) const {
        const int col0 = u.pn * BM + wc * 32 + 4 * fq;
        const int rowt = u.pm * BM;
        const int rg = rowt < 8192 ? (rowt >> 11) : 4;
        const float* gp = gate + (size_t)rg * 12288 + col0;
        f32x4 gv[2][2];
#pragma unroll
        for (int bj = 0; bj < 2; ++bj)
#pragma unroll
            for (int n = 0; n < 2; ++n) gv[bj][n] = *(const f32x4*)(gp + bj * HALF + n * 16);
#pragma unroll
        for (int ai = 0; ai < 2; ++ai)
#pragma unroll
            for (int m = 0; m < 4; ++m) { const int row = rowt + ai * HALF + wr * 64 + m * 16 + fr;
                const float* bp = (row < 8192 ? baseL + (size_t)row * 2048 : baseC + (size_t)(row - 8192) * 2048) + col0;
                float* op = out + (size_t)row * 2048 + col0;
#pragma unroll
                for (int bj = 0; bj < 2; ++bj)
#pragma unroll
                    for (int n = 0; n < 2; ++n) { const f32x4 b = *(const f32x4*)(bp + bj * HALF + n * 16); *(f32x4*)(op + bj * HALF + n * 16) = b + gv[bj][n] * acc[ai][bj][m][n]; } }
    }
};
struct EpiSqReluBf16 {
    static constexpr bool PERM = true, AFTER_DRAIN = false;
    bf16_t* O; int ldc;
    __device__ __forceinline__ unsigned pk(float lo, float hi) const { unsigned a = __builtin_bit_cast(unsigned, lo), b = __builtin_bit_cast(unsigned, hi);
        a = (a + 0x7fffu + ((a >> 16) & 1u)) >> 16; b = (b + 0x7fffu + ((b >> 16) & 1u)) >> 16; return a | (b << 16); }
    __device__ __forceinline__ void operator()(const f32x4 (&acc)[2][2][4][2], const Unit& u, int wr, int wc, int fr, int fq) const {
        const int col0 = u.pn * BM + wc * 32 + 8 * fq;
#pragma unroll
        for (int ai = 0; ai < 2; ++ai)
#pragma unroll
            for (int m = 0; m < 4; ++m) { bf16_t* rowp = O + (size_t)(u.pm * BM + ai * HALF + wr * 64 + m * 16 + fr) * ldc + col0;
#pragma unroll
                for (int bj = 0; bj < 2; ++bj) { f32x4 v0 = acc[ai][bj][m][0], v1 = acc[ai][bj][m][1];
#pragma unroll
                    for (int e = 0; e < 4; ++e) { const float a0 = fmaxf(v0[e], 0.f), a1 = fmaxf(v1[e], 0.f); v0[e] = a0 * a0; v1[e] = a1 * a1; }
                    u32x4 w; w.x = pk(v0[0], v0[1]); w.y = pk(v0[2], v0[3]); w.z = pk(v1[0], v1[1]); w.w = pk(v1[2], v1[3]);
                    *(u32x4*)(rowp + bj * HALF) = w; } }
    }
};

template <class Epi, class Sched, bool ALIGN_EPI = false, bool SP2 = false>
__device__ __forceinline__ void gemm_phase(PG8_LAS unsigned char* lds, const Gemm g, const Sched& S, const Epi& E) {
    const int tid = threadIdx.x, wid = __builtin_amdgcn_readfirstlane(tid >> 6), lane = tid & 63, wr = wid >> 2, wc = wid & 3, fr = lane & 15, fq = lane >> 4;
    const int K = g.K, nt = K / BK;
    unsigned voffA[2], voffB[2];
#pragma unroll
    for (int i = 0; i < 2; ++i) { int R, C; stage_rc(tid * 16 + i * 8192, R, C); const int Rb = Epi::PERM ? ((R & ~31) + perm32(R & 31)) : R;
        voffA[i] = (unsigned)(R * K + C) * 2u; voffB[i] = (unsigned)(Rb * K + C) * 2u; }
    const size_t kstep = (size_t)(BK * 2);
    const size_t hstep = (size_t)HALF * K * 2;
    const size_t tstep = 2 * hstep;
    const unsigned ldsw = (unsigned)wid * 1024u;
    const int aoff = lds_byte(wr * 64 + fr, fq * 8), boff = lds_byte(wc * 32 + fr, fq * 8);
#define PG8_SA(b, h) (((b) * 2 + (h)) * HTB)
#define PG8_SB(b, h) ((4 + (b) * 2 + (h)) * HTB)
#define PG8_STAGE(bufoff, gbase, voff) do { _Pragma("unroll") for (int _i = 0; _i < 2; ++_i) \
        __builtin_amdgcn_global_load_lds((const unsigned*)((const char*)(gbase) + (voff)[_i]), (PG8_LAS unsigned*)(lds + (bufoff) + ldsw + _i * 8192), 16, 0, 0); } while (0)
#define PG8_LDA(dst, b, h) do { _Pragma("unroll") for (int m = 0; m < 4; ++m) _Pragma("unroll") for (int k = 0; k < 2; ++k) dst[m][k] = *(const PG8_LAS bf16x8*)(lds + PG8_SA(b, h) + aoff + m * 2048 + k * 1024); } while (0)
#define PG8_LDB(dst, b, h) do { _Pragma("unroll") for (int n = 0; n < 2; ++n) _Pragma("unroll") for (int k = 0; k < 2; ++k) dst[n][k] = *(const PG8_LAS bf16x8*)(lds + PG8_SB(b, h) + boff + n * 2048 + k * 1024); } while (0)
#define PG8_MMA(ai, bj, At, Bt) do { __builtin_amdgcn_s_setprio(1); _Pragma("unroll") for (int m = 0; m < 4; ++m) _Pragma("unroll") for (int n = 0; n < 2; ++n) _Pragma("unroll") for (int k = 0; k < 2; ++k) \
        acc[ai][bj][m][n] = __builtin_amdgcn_mfma_f32_16x16x32_bf16(Bt[n][k], At[m][k], acc[ai][bj][m][n], 0, 0, 0); __builtin_amdgcn_s_setprio(0); } while (0)
#define PG8_WAIT_V(n) asm volatile("s_waitcnt vmcnt(" #n ")" ::: "memory")
#define PG8_WAIT_L(n) asm volatile("s_waitcnt lgkmcnt(" #n ")" ::: "memory")
#define PG8_BAR __builtin_amdgcn_s_barrier()
#define PG8_SCHED __builtin_amdgcn_sched_barrier(0)
    Unit cur, nxt; int ui = 0;
    if (!S.next(0, cur)) return;
    f32x4 acc[2][2][4][2];
#pragma unroll
    for (int a = 0; a < 2; ++a)
#pragma unroll
        for (int b = 0; b < 2; ++b)
#pragma unroll
            for (int m = 0; m < 4; ++m)
#pragma unroll
                for (int n = 0; n < 2; ++n) acc[a][b][m][n] = (f32x4){0.f, 0.f, 0.f, 0.f};
    bf16x8 At[4][2], B0[2][2], B1[2][2];
    const char* cA = (const char*)g.A + (size_t)cur.pm * tstep; const char* cB = (const char*)g.Bt + (size_t)cur.pn * tstep;
    S.a_ready(cur);
    if constexpr (SP2) {
        PG8_STAGE(PG8_SB(0, 0), cB, voffB); PG8_STAGE(PG8_SB(0, 1), cB + hstep, voffB); PG8_STAGE(PG8_SA(0, 0), cA, voffA); PG8_STAGE(PG8_SA(0, 1), cA + hstep, voffA);
        if (wr == 1) PG8_BAR;
        PG8_WAIT_V(2); PG8_BAR;
        PG8_STAGE(PG8_SB(1, 0), cB + kstep, voffB); PG8_STAGE(PG8_SA(1, 0), cA + kstep, voffA); PG8_STAGE(PG8_SB(1, 1), cB + hstep + kstep, voffB);
        PG8_WAIT_V(6); PG8_BAR;
    } else {
        PG8_STAGE(PG8_SB(0, 0), cB, voffB); PG8_STAGE(PG8_SA(0, 0), cA, voffA); PG8_STAGE(PG8_SB(0, 1), cB + hstep, voffB); PG8_STAGE(PG8_SA(0, 1), cA + hstep, voffA);
        if (wr == 1) PG8_BAR;
        PG8_WAIT_V(4); PG8_BAR;
        PG8_STAGE(PG8_SB(1, 0), cB + kstep, voffB); PG8_STAGE(PG8_SA(1, 0), cA + kstep, voffA); PG8_STAGE(PG8_SB(1, 1), cB + hstep + kstep, voffB);
        PG8_WAIT_V(6); PG8_BAR;
    }
    for (;;) {
        const bool has_next = S.next(ui + 1, nxt);
        const char* nA = has_next ? (const char*)g.A + (size_t)nxt.pm * tstep : cA; const char* nB = has_next ? (const char*)g.Bt + (size_t)nxt.pn * tstep : cB;
        for (int t = 0; t < nt; t += 2) {
            const bool last = (t == nt - 2);
            const char* a1 = cA + (size_t)(t + 1) * kstep;
            const char* a2 = last ? nA : cA + (size_t)(t + 2) * kstep; const char* b2 = last ? nB : cB + (size_t)(t + 2) * kstep;
            const char* a3 = a2 + kstep; const char* b3 = b2 + kstep;
            if (last && has_next) S.a_ready(nxt);
            if constexpr (SP2) {
            PG8_LDB(B0, 0, 0); PG8_LDB(B1, 0, 1); PG8_SCHED; PG8_LDA(At, 0, 0); PG8_STAGE(PG8_SA(1, 1), a1 + hstep, voffA);
            PG8_WAIT_V(8); PG8_WAIT_L(0); PG8_BAR; PG8_MMA(0, 0, At, B0); PG8_MMA(0, 1, At, B1); PG8_BAR; PG8_SCHED;
            PG8_LDA(At, 0, 1); PG8_STAGE(PG8_SB(0, 0), b2, voffB); PG8_STAGE(PG8_SB(0, 1), b2 + hstep, voffB); PG8_STAGE(PG8_SA(0, 0), a2, voffA);
            PG8_WAIT_V(8); PG8_WAIT_L(0); PG8_BAR; PG8_MMA(1, 0, At, B0); PG8_MMA(1, 1, At, B1); PG8_BAR; PG8_SCHED;
            PG8_LDB(B0, 1, 0); PG8_LDB(B1, 1, 1); PG8_SCHED; PG8_LDA(At, 1, 0); PG8_STAGE(PG8_SA(0, 1), a2 + hstep, voffA);
            PG8_WAIT_V(8); PG8_WAIT_L(0); PG8_BAR; PG8_MMA(0, 0, At, B0); PG8_MMA(0, 1, At, B1); PG8_BAR; PG8_SCHED;
            PG8_LDA(At, 1, 1); PG8_STAGE(PG8_SB(1, 0), b3, voffB); PG8_STAGE(PG8_SB(1, 1), b3 + hstep, voffB); PG8_STAGE(PG8_SA(1, 0), a3, voffA);
            PG8_WAIT_V(8); PG8_WAIT_L(0); PG8_BAR; PG8_MMA(1, 0, At, B0); PG8_MMA(1, 1, At, B1); PG8_BAR; PG8_SCHED;
            } else {
            PG8_LDB(B0, 0, 0); PG8_SCHED; PG8_LDA(At, 0, 0); PG8_STAGE(PG8_SA(1, 1), a1 + hstep, voffA);
            PG8_WAIT_L(8); PG8_BAR; PG8_WAIT_L(0); PG8_MMA(0, 0, At, B0); PG8_BAR; PG8_SCHED;
            PG8_LDB(B1, 0, 1); PG8_STAGE(PG8_SB(0, 0), b2, voffB);
            PG8_BAR; PG8_WAIT_L(0); PG8_MMA(0, 1, At, B1); PG8_BAR;
            PG8_LDA(At, 0, 1); PG8_STAGE(PG8_SA(0, 0), a2, voffA);
            PG8_BAR; PG8_WAIT_L(0); PG8_MMA(1, 0, At, B0); PG8_BAR; PG8_SCHED;
            PG8_STAGE(PG8_SB(0, 1), b2 + hstep, voffB);
            PG8_WAIT_V(6); PG8_BAR; PG8_MMA(1, 1, At, B1); PG8_BAR;
            PG8_LDB(B0, 1, 0); PG8_SCHED; PG8_LDA(At, 1, 0); PG8_STAGE(PG8_SA(0, 1), a2 + hstep, voffA);
            PG8_WAIT_L(8); PG8_BAR; PG8_WAIT_L(0); PG8_MMA(0, 0, At, B0); PG8_BAR; PG8_SCHED;
            PG8_LDB(B1, 1, 1); PG8_STAGE(PG8_SB(1, 0), b3, voffB);
            PG8_BAR; PG8_WAIT_L(0); PG8_MMA(0, 1, At, B1); PG8_BAR;
            PG8_LDA(At, 1, 1); PG8_STAGE(PG8_SA(1, 0), a3, voffA);
            PG8_BAR; PG8_WAIT_L(0); PG8_MMA(1, 0, At, B0); PG8_BAR; PG8_SCHED;
            PG8_STAGE(PG8_SB(1, 1), b3 + hstep, voffB);
            PG8_WAIT_V(6); PG8_BAR; PG8_MMA(1, 1, At, B1); PG8_BAR;
            }
        }
        if constexpr (ALIGN_EPI) { if (wr == 0) PG8_BAR; }
        if constexpr (!Epi::AFTER_DRAIN) { E(acc, cur, wr, wc, fr, fq); S.done(cur); }
        if (!has_next) break;
#pragma unroll
        for (int a = 0; a < 2; ++a)
#pragma unroll
            for (int b = 0; b < 2; ++b)
#pragma unroll
                for (int m = 0; m < 4; ++m)
#pragma unroll
                    for (int n = 0; n < 2; ++n) acc[a][b][m][n] = (f32x4){0.f, 0.f, 0.f, 0.f};
        cur = nxt; cA = nA; cB = nB; ++ui;
        if constexpr (ALIGN_EPI) { if (wr == 1) PG8_BAR; }
    }
    PG8_WAIT_V(0);
    if constexpr (!ALIGN_EPI) { if (wr == 0) PG8_BAR; }
    PG8_BAR;
    if constexpr (Epi::AFTER_DRAIN) { E.fused(acc, cur, wr, wc, fr, fq, lds, wid, lane); S.done(cur); }
#undef PG8_SA
#undef PG8_SB
#undef PG8_STAGE
#undef PG8_LDA
#undef PG8_LDB
#undef PG8_MMA
#undef PG8_WAIT_V
#undef PG8_WAIT_L
#undef PG8_BAR
#undef PG8_SCHED
}
}

#define WS_F32(off) ((float*)(a.ws + (off)))
#define WS_BF(off) ((bf16_t*)(a.ws + (off)))
#define AR_F32(off) ((float*)(a.ws + OFF_ARENA + (off)))
#define AR_BF(off) ((bf16_t*)(a.ws + OFF_ARENA + (off)))

__device__ __forceinline__ void p0_transpose_item(const float* W, int K, int N, bf16_t* WT, LAS float* scr, int item, int lane) {
    const int nblk = N / 32, kb = item / nblk, nb = item % nblk, k0 = 64 * kb, n0 = 32 * nb;
#pragma unroll 8
    for (int i = 0; i < 32; ++i) { const int kk = 2 * i + (lane >> 5); scr[kk * 33 + (lane & 31)] = W[(size_t)(k0 + kk) * N + n0 + (lane & 31)]; }
    asm volatile("s_waitcnt lgkmcnt(0)" ::: "memory");
    const int c = lane & 7;
#pragma unroll
    for (int j = 0; j < 4; ++j) { const int n = (lane >> 3) + 8 * j; const LAS float* s = scr + (8 * c) * 33 + n;
        u32x4 o; o.x = pk2(s[0 * 33], s[1 * 33]); o.y = pk2(s[2 * 33], s[3 * 33]); o.z = pk2(s[4 * 33], s[5 * 33]); o.w = pk2(s[6 * 33], s[7 * 33]);
        *(u32x4*)(WT + (size_t)(n0 + n) * K + k0 + 8 * c) = o; }
    asm volatile("s_waitcnt lgkmcnt(0)" ::: "memory");
}

__device__ __forceinline__ void ph_prologue(const Args& a, LAS unsigned char* L) {
    const int tid = threadIdx.x, lane = tid & 63, wave = tid >> 6, bid = blockIdx.x, nblk = gridDim.x;
    float* mod = WS_F32(OFF_MOD);
    for (int it = bid; it < 192; it += nblk) {
        const int l = it / 96, n0 = (it % 96) * 128;
        LAS float* sl = (LAS float*)L;
        LAS float* part = sl + 5 * 2048;
        const float* cin = (const float*)a.in[1]; const float* cctx = (const float*)a.in[3];
        for (int i = tid; i < 5 * 2048; i += NTHR) { const int r = i >> 11, k = i & 2047; const float x = r < 4 ? cin[r * 2048 + k] : cctx[k]; sl[i] = x / (1.f + expf(-x)); }
        __syncthreads();
        const float* W = (const float*)a.in[4] + (size_t)l * 2048 * 12288 + n0 + 2 * lane;
        float acc0[5], acc1[5];
#pragma unroll
        for (int r = 0; r < 5; ++r) { acc0[r] = 0.f; acc1[r] = 0.f; }
        const int kb = wave * 256;
#pragma unroll 8
        for (int k = 0; k < 256; ++k) { const f32x2 wv = *(const f32x2*)(W + (size_t)(kb + k) * 12288);
#pragma unroll
            for (int r = 0; r < 5; ++r) { const float s = sl[r * 2048 + kb + k]; acc0[r] += s * wv.x; acc1[r] += s * wv.y; } }
#pragma unroll
        for (int r = 0; r < 5; ++r) { part[(wave * 5 + r) * 128 + 2 * lane] = acc0[r]; part[(wave * 5 + r) * 128 + 2 * lane + 1] = acc1[r]; }
        __syncthreads();
        const float* ab = (const float*)a.in[5] + (size_t)l * 12288 + n0;
        for (int i = tid; i < 640; i += NTHR) { const int r = i >> 7, c = i & 127; float s = 0.f;
#pragma unroll
            for (int w = 0; w < 8; ++w) s += part[(w * 5 + r) * 128 + c];
            mod[(size_t)(l * 5 + r) * 12288 + n0 + c] = s + ab[c]; }
        __syncthreads();
    }
    if (bid == nblk - 1) {
        f32x2* tab = (f32x2*)(a.ws + OFF_ROPE);
        for (int i = tid; i < 1024; i += NTHR) { const int pos = i >> 4, f = i & 15; const float inv = powf(10000.f, -(float)f * 0.0625f); const float ang = (float)pos * inv;
            f32x2 cs; cs.x = cosf(ang); cs.y = sinf(ang); tab[i] = cs; }
    }
    { u32x4* z = (u32x4*)(a.ws + WT_ABIN + (size_t)4800 * DM * 2); const u32x4 zero = {0u, 0u, 0u, 0u};
      for (int i = bid * NTHR + tid; i < 64 * DM * 2 / 16; i += nblk * NTHR) z[i] = zero; }
    LAS float* scr = (LAS float*)(L + wave * 16384);
    const int gw = bid * 8 + wave, NGW = nblk * 8;
    constexpr int I0 = 32 * 150, I1 = 32 * 64, I2 = 32 * 256, I3 = 128 * 64;
    constexpr int NITEMS = I0 + I1 + I2 + I3 + I2 + I1 + I2 + I3;
    for (int it = gw; it < NITEMS; it += NGW) {
        int r = it;
        if (r < I0) { p0_transpose_item((const float*)a.in[9], 2048, 4800, WS_BF(WT_ABIN), scr, r, lane); continue; } r -= I0;
        if (r < I1) { p0_transpose_item((const float*)a.in[10], 2048, 2048, WS_BF(WT_ABOUT), scr, r, lane); continue; } r -= I1;
        if (r < I2) { p0_transpose_item((const float*)a.in[6], 2048, 8192, WS_BF(WT_W1_0), scr, r, lane); continue; } r -= I2;
        if (r < I3) { p0_transpose_item((const float*)a.in[7], 8192, 2048, WS_BF(WT_W2_0), scr, r, lane); continue; } r -= I3;
        if (r < I2) { p0_transpose_item((const float*)a.in[23], 2048, 8192, WS_BF(WT_CDIN), scr, r, lane); continue; } r -= I2;
        if (r < I1) { p0_transpose_item((const float*)a.in[24], 2048, 2048, WS_BF(WT_CDOUT), scr, r, lane); continue; } r -= I1;
        if (r < I2) { p0_transpose_item((const float*)a.in[6] + (size_t)2048 * 8192, 2048, 8192, WS_BF(WT_W1_1), scr, r, lane); continue; } r -= I2;
        p0_transpose_item((const float*)a.in[7] + (size_t)8192 * 2048, 8192, 2048, WS_BF(WT_W2_1), scr, r, lane);
    }
}

__device__ __forceinline__ void ph_modulate(const float* srcL, const float* srcC, int nrows, const float* modl, int ish, int isc, bf16_t* HN) {
    const int tid = threadIdx.x, lane = tid & 63, wave = tid >> 6, gw = blockIdx.x * 8 + wave, NGW = gridDim.x * 8;
    for (int m = gw; m < nrows; m += NGW) {
        const float* xr = (m < 8192 ? srcL + (size_t)m * 2048 : srcC + (size_t)(m - 8192) * 2048) + 4 * lane;
        const int rg = m < 8192 ? (m >> 11) : 4;
        const float* sh = modl + (size_t)rg * 12288 + ish * 2048 + 4 * lane; const float* sc = modl + (size_t)rg * 12288 + isc * 2048 + 4 * lane;
        f32x4 v[8]; float ss = 0.f;
#pragma unroll
        for (int j = 0; j < 8; ++j) { v[j] = *(const f32x4*)(xr + 256 * j); ss += (v[j].x * v[j].x + v[j].y * v[j].y) + (v[j].z * v[j].z + v[j].w * v[j].w); }
        const float rstd = rsqrtf(wave_sum(ss) * (1.f / 2048.f) + 1e-6f);
        bf16_t* op = HN + (size_t)m * 2048 + 4 * lane;
#pragma unroll
        for (int j = 0; j < 8; ++j) { const f32x4 s4 = *(const f32x4*)(sc + 256 * j), h4 = *(const f32x4*)(sh + 256 * j);
            const f32x4 o = v[j] * rstd * (s4 + 1.f) + h4; u32x2 w; w.x = pk2(o.x, o.y); w.y = pk2(o.z, o.w); *(u32x2*)(op + 256 * j) = w; }
    }
}

__device__ __forceinline__ void ph_final(const Args& a) {
    const int tid = threadIdx.x, lane = tid & 63, wave = tid >> 6, gw = blockIdx.x * 8 + wave, NGW = gridDim.x * 8;
    const float* fn = (const float*)a.in[8] + 4 * lane;
    for (int m = gw; m < ML; m += NGW) {
        float* xr = a.out + (size_t)m * 2048 + 4 * lane;
        f32x4 v[8]; float ss = 0.f;
#pragma unroll
        for (int j = 0; j < 8; ++j) { v[j] = *(const f32x4*)(xr + 256 * j); ss += (v[j].x * v[j].x + v[j].y * v[j].y) + (v[j].z * v[j].z + v[j].w * v[j].w); }
        const float rstd = rsqrtf(wave_sum(ss) * (1.f / 2048.f) + 1e-6f);
#pragma unroll
        for (int j = 0; j < 8; ++j) { const f32x4 w4 = *(const f32x4*)(fn + 256 * j); *(f32x4*)(xr + 256 * j) = v[j] * rstd * w4; }
    }
}

__device__ __forceinline__ float shifted(const float* U, int m, int col, int seq_lo, int seq_hi, float mu) {
    const float uc = U[(size_t)m * ABINP + col];
    const float up = m > seq_lo ? U[(size_t)(m - 1) * ABINP + col] : 0.f;
    const float un = m + 1 < seq_hi ? U[(size_t)(m + 1) * ABINP + col] : 0.f;
    return uc + mu * (0.5f * (up + un) - uc);
}
__device__ __forceinline__ void ph_rwkv_prep(const Args& a, LAS unsigned char* L) {
    const int tid = threadIdx.x, lane = tid & 63, wave = tid >> 6, bid = blockIdx.x, nblk = gridDim.x;
    const float* U = AR_F32(A_U0);
    const float* mu = (const float*)a.in[11];
    const float* w0 = (const float*)a.in[12]; const float* w_up = (const float*)a.in[13]; const float* a0 = (const float*)a.in[14];
    const float* a_up = (const float*)a.in[15]; const float* g_up = (const float*)a.in[16]; const float* k_k = (const float*)a.in[17];
    const float* k_a = (const float*)a.in[18]; const float* r_k = (const float*)a.in[19];
    float* PWF = AR_F32(A_PREP); float* PWB = PWF + (size_t)MT * 1024; float* PWRF = PWB + (size_t)MT * 1024; float* PWRB = PWRF + (size_t)MT * 1024;
    float* PA = PWRB + (size_t)MT * 1024; float* PB = PA + (size_t)MT * 1024; float* PK = PB + (size_t)MT * 1024; float* PV = PK + (size_t)MT * 1024;
    bf16_t* PG = AR_BF(A_G); float* SCAL = AR_F32(A_SCAL);
    LAS float* lowr = (LAS float*)L;
    LAS float* res = lowr + 32 * 192;
    const int slab = bid & 7, q = tid >> 7, cl = tid & 127, c = slab * 128 + cl;
    const float* wsrc = q == 0 ? w_up : (q == 1 ? w_up + 64 * 1024 : (q == 2 ? a_up : g_up));
    float wreg[64];
#pragma unroll
    for (int j = 0; j < 64; ++j) wreg[j] = wsrc[j * 1024 + c];
    const float mu_r = mu[c], mu_k = mu[1024 + c], mu_v = mu[2048 + c];
    const float w0f = w0[c], w0b = w0[1024 + c], a0c = a0[c], kkc = k_k[c], kac = k_a[c], rkc = r_k[c];
    const int iv = q < 2 ? 0 : q - 1;
    for (int tile = bid >> 3; tile < MT / 32; tile += (nblk >> 3)) {
        const int m0 = tile * 32;
        const int seq_lo = m0 < 8192 ? (m0 & ~2047) : 8192 + ((m0 - 8192) & ~255);
        const int seq_hi = m0 < 8192 ? seq_lo + 2048 : seq_lo + 256;
        for (int idx = tid; idx < 32 * 192; idx += NTHR) { const int tt = idx / 192, j = idx - tt * 192;
            const float us = shifted(U, m0 + tt, 3072 + j, seq_lo, seq_hi, mu[3072 + j]);
            lowr[idx] = j < 64 ? tanhf(us) : (j < 128 ? us : 1.f / (1.f + expf(-us))); }
        __syncthreads();
        for (int tt = 0; tt < 32; ++tt) { float acc = 0.f; const LAS float* xv = lowr + tt * 192 + iv * 64;
#pragma unroll
            for (int j = 0; j < 64; j += 4) { const f32x4 x = *(const LAS f32x4*)(xv + j); acc += x.x * wreg[j]; acc += x.y * wreg[j + 1]; acc += x.z * wreg[j + 2]; acc += x.w * wreg[j + 3]; }
            res[(q * 32 + tt) * 128 + cl] = acc; }
        __syncthreads();
        const int h = c >> 6;
        for (int i = 0; i < 8; ++i) { const int tt = (tid >> 7) + 4 * i, m = m0 + tt;
            const float r = shifted(U, m, c, seq_lo, seq_hi, mu_r), k = shifted(U, m, 1024 + c, seq_lo, seq_hi, mu_k), v = shifted(U, m, 2048 + c, seq_lo, seq_hi, mu_v);
            const float pwf = w0f + res[(0 * 32 + tt) * 128 + cl], pwb = w0b + res[(1 * 32 + tt) * 128 + cl];
            const float decf = expf(-0.6065306597126334f / (1.f + expf(-pwf))), decb = expf(-0.6065306597126334f / (1.f + expf(-pwb)));
            const float alr = 1.f / (1.f + expf(-(a0c + res[(2 * 32 + tt) * 128 + cl])));
            const float g = res[(3 * 32 + tt) * 128 + cl];
            const float kkr = k * kkc; const float ssq = wave_sum(kkr * kkr); const float kk = kkr / fmaxf(sqrtf(ssq), 1e-12f);
            const float kp = k * (1.f + (alr - 1.f) * kac), ap = -kk, bp = kk * alr;
            const float br = wave_sum(bp * r), kr = wave_sum(kp * r), rkr = wave_sum(r * kp * rkc);
            const size_t o = (size_t)m * 1024 + c;
            PWF[o] = decf; PWB[o] = decb; PWRF[o] = decf * r; PWRB[o] = decb * r; PA[o] = ap; PB[o] = bp; PK[o] = kp; PV[o] = v; PG[o] = (bf16_t)f2bf(g);
            if (lane == 0) { f32x4 s4; s4.x = br; s4.y = kr; s4.z = rkr; s4.w = 0.f; *(f32x4*)(SCAL + ((size_t)m * 16 + h) * 4) = s4; } }
        __syncthreads();
    }
    const f32x2* tab = (const f32x2*)(a.ws + OFF_ROPE);
    bf16_t* SQ = AR_BF(A_SQ); bf16_t* SK = AR_BF(A_SK); bf16_t* SV = AR_BF(A_SV);
    const int gw = bid * 8 + wave, NGW = nblk * 8;
    for (int m = gw; m < MT; m += NGW) {
        const float* ur = U + (size_t)m * ABINP; const bool lat = m < 8192; const int t = m & 2047, prow = t >> 6, pcol = t & 63;
#pragma unroll
        for (int i = 0; i < 10; ++i) { const int p = lane + 64 * i, hd = p >> 5, ii = p & 31;
            const int base = hd < 16 ? 3264 + hd * 64 : 4288 + (hd - 16) * 64;
            const float x1 = ur[base + ii], x2 = ur[base + 32 + ii]; float o1 = x1, o2 = x2;
            if (lat) { const f32x2 cs = tab[(ii < 16 ? prow : pcol) * 16 + (ii & 15)]; o1 = x1 * cs.x - x2 * cs.y; o2 = x1 * cs.y + x2 * cs.x; }
            bf16_t* dst = hd < 16 ? SQ + (size_t)m * 1024 + hd * 64 : SK + (size_t)m * 256 + (hd - 16) * 64;
            dst[ii] = (bf16_t)f2bf(o1); dst[32 + ii] = (bf16_t)f2bf(o2); }
        const f32x4 vv = *(const f32x4*)(ur + 4544 + 4 * lane); u32x2 w; w.x = pk2(vv.x, vv.y); w.y = pk2(vv.z, vv.w); *(u32x2*)(SV + (size_t)m * 256 + 4 * lane) = w;
    }
}

__device__ __forceinline__ int scan_row(int gs, int d, int b) {
    if (gs < 256) { const int t = d ? 255 - gs : gs; return 8192 + b * 256 + t; }
    const int t2 = gs - 256; const int t = d ? 2047 - t2 : t2; return b * 2048 + t;
}
__device__ __forceinline__ void rwkv_scan_chain(const Args& a, LAS unsigned char* L, int chain) {
    const int tid = threadIdx.x, lane = tid & 63, wave = tid >> 6;
    const int d = chain >> 6, b = (chain >> 4) & 3, h = chain & 15;
    const float* P0 = AR_F32(A_PREP);
    const float* src0 = P0 + (size_t)(d ? 1 : 0) * MT * 1024;
    const float* src1 = P0 + (size_t)(d ? 3 : 2) * MT * 1024;
    const float* src2 = P0 + (size_t)4 * MT * 1024;
    const float* src3 = P0 + (size_t)5 * MT * 1024;
    const float* src4 = P0 + (size_t)6 * MT * 1024;
    const float* src5 = P0 + (size_t)7 * MT * 1024;
    const float* SCAL = AR_F32(A_SCAL);
    float* Y = AR_F32(d ? A_YB : A_YF);
    const int kg = lane & 15, rp = lane >> 4, r0 = 8 * wave + 2 * rp, k0 = 4 * kg;
    const int step_l = tid >> 4, piece = tid & 15;
    constexpr int BUF = 12416;
    LAS float* B0 = (LAS float*)L;
    f32x4 pre0, pre1, pre2, pre3, pre4, pre5, psc;
#define SCAN_LOAD(ci) do { const int m_ = scan_row((ci) * 32 + step_l, d, b); const size_t off_ = (size_t)m_ * 1024 + h * 64 + piece * 4; \
        pre0 = *(const f32x4*)(src0 + off_); pre1 = *(const f32x4*)(src1 + off_); pre2 = *(const f32x4*)(src2 + off_); pre3 = *(const f32x4*)(src3 + off_); \
        pre4 = *(const f32x4*)(src4 + off_); pre5 = *(const f32x4*)(src5 + off_); \
        if (tid < 32) { const int m2_ = scan_row((ci) * 32 + tid, d, b); psc = *(const f32x4*)(SCAL + ((size_t)m2_ * 16 + h) * 4); } } while (0)
#define SCAN_STORE(bi) do { LAS float* Bf_ = B0 + (bi) * BUF; const int o_ = step_l * 64 + piece * 4; \
        *(LAS f32x4*)(Bf_ + 0 * 2048 + o_) = pre0; *(LAS f32x4*)(Bf_ + 1 * 2048 + o_) = pre1; *(LAS f32x4*)(Bf_ + 2 * 2048 + o_) = pre2; *(LAS f32x4*)(Bf_ + 3 * 2048 + o_) = pre3; \
        *(LAS f32x4*)(Bf_ + 4 * 2048 + o_) = pre4; *(LAS f32x4*)(Bf_ + 5 * 2048 + o_) = pre5; if (tid < 32) *(LAS f32x4*)(Bf_ + 12288 + tid * 4) = psc; } while (0)
    SCAN_LOAD(0); SCAN_STORE(0); __syncthreads();
    f32x4 s0 = {0.f, 0.f, 0.f, 0.f}, s1 = {0.f, 0.f, 0.f, 0.f};
    for (int c = 0; c < 72; ++c) {
        if (c + 1 < 72) SCAN_LOAD(c + 1);
        const LAS float* Bf = B0 + (c & 1) * BUF;
        for (int s = 0; s < 32; ++s) {
            const f32x4 wv = *(const LAS f32x4*)(Bf + 0 * 2048 + s * 64 + k0), wrv = *(const LAS f32x4*)(Bf + 1 * 2048 + s * 64 + k0);
            const f32x4 av = *(const LAS f32x4*)(Bf + 2 * 2048 + s * 64 + k0), bv = *(const LAS f32x4*)(Bf + 3 * 2048 + s * 64 + k0), kv = *(const LAS f32x4*)(Bf + 4 * 2048 + s * 64 + k0);
            const f32x2 vv = *(const LAS f32x2*)(Bf + 5 * 2048 + s * 64 + r0); const f32x2 sc = *(const LAS f32x2*)(Bf + 12288 + s * 4);
            float sa0 = (s0.x * av.x + s0.y * av.y) + (s0.z * av.z + s0.w * av.w), sa1 = (s1.x * av.x + s1.y * av.y) + (s1.z * av.z + s1.w * av.w);
            float z0 = (s0.x * wrv.x + s0.y * wrv.y) + (s0.z * wrv.z + s0.w * wrv.w), z1 = (s1.x * wrv.x + s1.y * wrv.y) + (s1.z * wrv.z + s1.w * wrv.w);
            sa0 = row16_sum(sa0); sa1 = row16_sum(sa1); z0 = row16_sum(z0); z1 = row16_sum(z1);
            const float y0 = z0 + sa0 * sc.x + vv.x * sc.y, y1 = z1 + sa1 * sc.x + vv.y * sc.y;
            s0 = s0 * wv + (bv * sa0 + kv * vv.x); s1 = s1 * wv + (bv * sa1 + kv * vv.y);
            if (kg == 0) { const int m = scan_row(c * 32 + s, d, b); f32x2 yy; yy.x = y0; yy.y = y1; *(f32x2*)(Y + (size_t)m * 1024 + h * 64 + r0) = yy; }
        }
        if (c + 1 < 72) SCAN_STORE((c + 1) & 1);
        __syncthreads();
    }
#undef SCAN_LOAD
#undef SCAN_STORE
}

__device__ __forceinline__ void ph_rwkv_post(const Args& a) {
    const int tid = threadIdx.x, lane = tid & 63;
    const float* YF = AR_F32(A_YF); const float* YB = AR_F32(A_YB); const float* PV = AR_F32(A_PREP) + (size_t)7 * MT * 1024;
    const bf16_t* PG = AR_BF(A_G); const float* SCAL = AR_F32(A_SCAL); bf16_t* YA = AR_BF(A_YA);
    const float* lnw = (const float*)a.in[20]; const float* lnb = (const float*)a.in[21];
    for (int task = blockIdx.x; task < MT * 2; task += gridDim.x) {
        const int m = task >> 1, c = (task & 1) * 512 + tid, h = c >> 6;
        const size_t o = (size_t)m * 1024 + c;
        const float y = YF[o] + YB[o];
        const float mean = wave_sum(y) * (1.f / 64.f); const float dlt = y - mean; const float var = wave_sum(dlt * dlt) * (1.f / 64.f);
        const float yn = dlt * rsqrtf(var + 64e-5f);
        const float rkr = SCAL[((size_t)m * 16 + h) * 4 + 2];
        const float g = __uint_as_float((unsigned)PG[o] << 16);
        const float outv = (yn * lnw[c] + lnb[c] + rkr * PV[o]) * g;
        YA[(size_t)m * 2048 + c] = (bf16_t)f2bf(outv);
    }
}

struct AttnSeg { const bf16_t* K; const bf16_t* V; int n; };
template <int DV, int NSUB>
__device__ __forceinline__ void attn_unit(LAS unsigned char* L, const bf16_t* Q, int q_stride, AttnSeg sg0, AttnSeg sg1, int k_stride, int v_stride,
                                          bool masked, int qpos0, int kpos0, bool has_sink, float sink, float lmb, const float* subln, float post_scale,
                                          bf16_t* O, int o_stride) {
    const int tid = threadIdx.x, lane = tid & 63, wave = tid >> 6, fr = lane & 15, g = lane >> 4;
    constexpr int KROW = 72;
    LAS bf16_t* Ks = (LAS bf16_t*)L;
    LAS bf16_t* Vt = Ks + NSUB * 64 * KROW;
    LAS bf16_t* Pw = Vt + DV * KROW + wave * (NSUB * 16 * KROW);
    bf16x8 qf[NSUB][2];
#pragma unroll
    for (int s = 0; s < NSUB; ++s)
#pragma unroll
        for (int ks = 0; ks < 2; ++ks) qf[s][ks] = *(const bf16x8*)(Q + (size_t)(wave * 16 + fr) * q_stride + s * 64 + ks * 32 + g * 8);
    f32x4 o[NSUB][DV / 16];
    float mrow[NSUB][4], lrow[NSUB][4];
#pragma unroll
    for (int s = 0; s < NSUB; ++s) {
#pragma unroll
        for (int dt = 0; dt < DV / 16; ++dt) o[s][dt] = (f32x4){0.f, 0.f, 0.f, 0.f};
#pragma unroll
        for (int r = 0; r < 4; ++r) { mrow[s][r] = has_sink ? sink : -INFINITY; lrow[s][r] = has_sink ? 1.f : 0.f; }
    }
    const int nt0 = sg0.n >> 6, ntiles = nt0 + (sg1.n >> 6);
    const int srow = tid >> 3, spc = tid & 7;
    for (int t = 0; t < ntiles; ++t) {
        const bool in0 = t < nt0; const int j0 = in0 ? t * 64 : (t - nt0) * 64;
        const bf16_t* Kp = (in0 ? sg0.K : sg1.K) + (size_t)(j0 + srow) * k_stride + spc * 8;
        const bf16_t* Vp = (in0 ? sg0.V : sg1.V) + (size_t)(j0 + srow) * v_stride + spc * 8;
        u32x4 kreg[NSUB]; u32x4 vreg[DV / 64];
#pragma unroll
        for (int s = 0; s < NSUB; ++s) kreg[s] = *(const u32x4*)(Kp + s * 64);
#pragma unroll
        for (int p = 0; p < DV / 64; ++p) vreg[p] = *(const u32x4*)(Vp + p * 64);
        __syncthreads();
#pragma unroll
        for (int s = 0; s < NSUB; ++s) *(LAS u32x4*)(Ks + (s * 64 + srow) * KROW + spc * 8) = kreg[s];
#pragma unroll
        for (int p = 0; p < DV / 64; ++p) {
            const unsigned w4[4] = {vreg[p].x, vreg[p].y, vreg[p].z, vreg[p].w};
#pragma unroll
            for (int e = 0; e < 8; ++e) Vt[(p * 64 + spc * 8 + e) * KROW + srow] = (bf16_t)((w4[e >> 1] >> ((e & 1) * 16)) & 0xffffu);
        }
        __syncthreads();
#pragma unroll
        for (int s = 0; s < NSUB; ++s) {
            f32x4 sc[4];
#pragma unroll
            for (int nt = 0; nt < 4; ++nt) { sc[nt] = (f32x4){0.f, 0.f, 0.f, 0.f};
#pragma unroll
                for (int ks = 0; ks < 2; ++ks) { const bf16x8 kf = *(const LAS bf16x8*)(Ks + (s * 64 + nt * 16 + fr) * KROW + ks * 32 + g * 8);
                    sc[nt] = __builtin_amdgcn_mfma_f32_16x16x32_bf16(qf[s][ks], kf, sc[nt], 0, 0, 0); } }
            float mx[4];
#pragma unroll
            for (int r = 0; r < 4; ++r) mx[r] = -INFINITY;
#pragma unroll
            for (int nt = 0; nt < 4; ++nt)
#pragma unroll
                for (int r = 0; r < 4; ++r) { float x = sc[nt][r] * 0.125f;
                    if (masked && in0) { const int kp = kpos0 + j0 + nt * 16 + fr, qp = qpos0 + wave * 16 + 4 * g + r; const int df = kp - qp; if (df > 128 || df < -128) x = -INFINITY; }
                    sc[nt][r] = x; mx[r] = fmaxf(mx[r], x); }
            float alpha[4];
#pragma unroll
            for (int r = 0; r < 4; ++r) { const float mt = row16_max(mx[r]); const float mn = fmaxf(mrow[s][r], mt);
                alpha[r] = (mn == -INFINITY) ? 1.f : __expf(mrow[s][r] - mn); mrow[s][r] = mn; }
            float rs[4] = {0.f, 0.f, 0.f, 0.f};
#pragma unroll
            for (int nt = 0; nt < 4; ++nt)
#pragma unroll
                for (int r = 0; r < 4; ++r) { const float p = (mrow[s][r] == -INFINITY) ? 0.f : __expf(sc[nt][r] - mrow[s][r]); rs[r] += p;
                    Pw[(s * 16 + 4 * g + r) * KROW + nt * 16 + fr] = (bf16_t)f2bf(p); }
#pragma unroll
            for (int r = 0; r < 4; ++r) { lrow[s][r] = lrow[s][r] * alpha[r] + row16_sum(rs[r]); }
#pragma unroll
            for (int dt = 0; dt < DV / 16; ++dt)
#pragma unroll
                for (int r = 0; r < 4; ++r) o[s][dt][r] *= alpha[r];
        }
#pragma unroll
        for (int s = 0; s < NSUB; ++s)
#pragma unroll
            for (int ks = 0; ks < 2; ++ks) { const bf16x8 pf = *(const LAS bf16x8*)(Pw + (s * 16 + fr) * KROW + ks * 32 + g * 8);
#pragma unroll
                for (int dt = 0; dt < DV / 16; ++dt) { const bf16x8 vf = *(const LAS bf16x8*)(Vt + (dt * 16 + fr) * KROW + ks * 32 + g * 8);
                    o[s][dt] = __builtin_amdgcn_mfma_f32_16x16x32_bf16(pf, vf, o[s][dt], 0, 0, 0); } }
    }
    if (NSUB == 1) {
#pragma unroll
        for (int r = 0; r < 4; ++r) { const float inv = 1.f / lrow[0][r]; bf16_t* op = O + (size_t)(wave * 16 + 4 * g + r) * o_stride + fr;
#pragma unroll
            for (int dt = 0; dt < DV / 16; ++dt) op[dt * 16] = (bf16_t)f2bf(o[0][dt][r] * inv); }
    } else {
#pragma unroll
        for (int r = 0; r < 4; ++r) { const float i0 = 1.f / lrow[0][r], i1 = lmb / lrow[NSUB - 1][r]; float val[DV / 16]; float ss = 0.f;
#pragma unroll
            for (int dt = 0; dt < DV / 16; ++dt) { val[dt] = o[0][dt][r] * i0 - o[NSUB - 1][dt][r] * i1; ss += val[dt] * val[dt]; }
            ss = row16_sum(ss); const float rstd = rsqrtf(ss * (1.f / DV) + 1e-5f) * post_scale;
            bf16_t* op = O + (size_t)(wave * 16 + 4 * g + r) * o_stride + fr;
#pragma unroll
            for (int dt = 0; dt < DV / 16; ++dt) op[dt * 16] = (bf16_t)f2bf(val[dt] * rstd * subln[dt * 16 + fr]); }
    }
    __syncthreads();
}

__device__ __forceinline__ void ph_mix0(const Args& a, LAS unsigned char* L) {
    const int bid = blockIdx.x;
    if (bid < 128) { rwkv_scan_chain(a, L, bid); return; }
    const bf16_t* SQ = AR_BF(A_SQ); const bf16_t* SK = AR_BF(A_SK); const bf16_t* SV = AR_BF(A_SV); bf16_t* YA = AR_BF(A_YA);
    const float* sinkp = (const float*)a.in[22];
    for (int u = bid - 128; u < 1152; u += 128) {
        AttnSeg s0, s1; int qrow0, qh, qpos0 = 0, kpos0 = 0; bool masked;
        if (u < 1024) { const int b = u >> 8, qb = u & 15; qh = (u >> 4) & 15; const int kvh = qh >> 2;
            const int ks = qb * 128 - 128 < 0 ? 0 : qb * 128 - 128, ke = qb * 128 + 256 > 2048 ? 2048 : qb * 128 + 256;
            qrow0 = b * 2048 + qb * 128;
            s0.K = SK + (size_t)(b * 2048 + ks) * 256 + kvh * 64; s0.V = SV + (size_t)(b * 2048 + ks) * 256 + kvh * 64; s0.n = ke - ks;
            s1.K = SK + (size_t)(8192 + b * 256) * 256 + kvh * 64; s1.V = SV + (size_t)(8192 + b * 256) * 256 + kvh * 64; s1.n = 256;
            masked = true; qpos0 = qb * 128; kpos0 = ks;
        } else { const int uu = u - 1024, b = uu >> 5, half = uu & 1; qh = (uu >> 1) & 15; const int kvh = qh >> 2;
            qrow0 = 8192 + b * 256 + half * 128;
            s0.K = SK + (size_t)(8192 + b * 256) * 256 + kvh * 64; s0.V = SV + (size_t)(8192 + b * 256) * 256 + kvh * 64; s0.n = 256;
            s1.K = s0.K; s1.V = s0.V; s1.n = 0; masked = false;
        }
        attn_unit<64, 1>(L, SQ + (size_t)qrow0 * 1024 + qh * 64, 1024, s0, s1, 256, 256, masked, qpos0, kpos0, true, sinkp[qh], 0.f, nullptr, 1.f,
                         YA + (size_t)qrow0 * 2048 + 1024 + qh * 64, 2048);
    }
}

__device__ __forceinline__ void ph_diff_prep(const Args& a) {
    const int tid = threadIdx.x, lane = tid & 63, wave = tid >> 6, gw = blockIdx.x * 8 + wave, NGW = gridDim.x * 8;
    const float* U = AR_F32(A_U1); const f32x2* tab = (const f32x2*)(a.ws + OFF_ROPE);
    bf16_t* QD = AR_BF(A_QD); bf16_t* KD = AR_BF(A_KD); bf16_t* VD = AR_BF(A_VD);
    for (int m = gw; m < MT; m += NGW) {
        const float* ur = U + (size_t)m * 8192; const bool lat = m < 8192; const int t = m & 2047, prow = t >> 6, pcol = t & 63;
#pragma unroll
        for (int i = 0; i < 16; ++i) { const int p = lane + 64 * i;
            const int isk = p >> 9, hs = (p >> 5) & 15, ii = p & 31;
            if (!isk && !lat) continue;
            const int base = isk * 1024 + hs * 64;
            const float x1 = ur[base + ii], x2 = ur[base + 32 + ii]; float o1 = x1, o2 = x2;
            if (lat) { const f32x2 cs = tab[(ii < 16 ? prow : pcol) * 16 + (ii & 15)]; o1 = x1 * cs.x - x2 * cs.y; o2 = x1 * cs.y + x2 * cs.x; }
            bf16_t* dst = (isk ? KD : QD) + (size_t)m * 1024 + hs * 64;
            dst[ii] = (bf16_t)f2bf(o1); dst[32 + ii] = (bf16_t)f2bf(o2); }
#pragma unroll
        for (int i = 0; i < 4; ++i) { const f32x4 vv = *(const f32x4*)(ur + 2048 + 256 * i + 4 * lane); u32x2 w; w.x = pk2(vv.x, vv.y); w.y = pk2(vv.z, vv.w);
            *(u32x2*)(VD + (size_t)m * 1024 + 256 * i + 4 * lane) = w; }
    }
}

__device__ __forceinline__ int hgrn_row(int gs, int d, int b) { return scan_row(gs, d, b); }
__device__ __forceinline__ void hgrn_chain(const Args& a, LAS unsigned char* L, int chain) {
    const int tid = threadIdx.x, lane = tid & 63, wave = tid >> 6, fr = lane & 15, g = lane >> 4;
    const int d = chain >> 5, b = (chain >> 3) & 3, h = chain & 7;
    const float* U = AR_F32(A_U1);
    const float* lbl = (const float*)a.in[28];
    float* OUT = AR_F32(d ? A_OB : A_OF);
    constexpr int QROW = 136;
    LAS bf16_t* Qt = (LAS bf16_t*)L; LAS bf16_t* Kt = Qt + 16 * QROW; LAS bf16_t* KtT = Kt + 16 * QROW; LAS bf16_t* VT = KtT + 128 * 16; LAS float* eL = (LAS float*)(VT + 128 * 16);
    const int qcol = 3072 + h * 128, zcol = 3072 + 1024 * (1 + d) + h * 128, icol = 3072 + 3072 + h * 128;
    float lbk = 0.f;
    if (tid < 128) { const float l0 = lbl[d * 1024 + h * 128 + tid], l1 = lbl[2048 + d * 1024 + h * 128 + tid]; const float mxl = fmaxf(l0, l1);
        const float e0 = expf(l0 - mxl), e1 = expf(l1 - mxl); lbk = e1 / (e0 + e1); }
    f32x4 sacc[8];
#pragma unroll
    for (int mt = 0; mt < 8; ++mt) sacc[mt] = (f32x4){0.f, 0.f, 0.f, 0.f};
    const bf16x8 zero8 = {0, 0, 0, 0, 0, 0, 0, 0};
    for (int c = 0; c < 144; ++c) {
        if (tid < 128) { float bcum = 0.f;
            for (int s = 0; s < 16; ++s) { const int m = hgrn_row(c * 16 + s, d, b); const float z = U[(size_t)m * 8192 + zcol + tid], qv = U[(size_t)m * 8192 + qcol + tid];
                const float e = expf(-fabsf(z)); const float sp = 1.f / (1.f + e), sn = e * sp; const float sig = z >= 0.f ? sp : sn, sigm = z >= 0.f ? sn : sp;
                const float f = lbk + (1.f - lbk) * sig; const float kg = (1.f - lbk) * sigm;
                bcum += logf(f);
                Qt[s * QROW + tid] = (bf16_t)f2bf(qv * expf(bcum));
                const float kt = kg * expf(-fmaxf(bcum, -80.f));
                const bf16_t kb = (bf16_t)f2bf(kt); Kt[s * QROW + tid] = kb; KtT[tid * 16 + s] = kb; }
            eL[tid] = expf(bcum);
        } else { for (int idx = tid - 128; idx < 2048; idx += 384) { const int s = idx >> 7, v = idx & 127; const int m = hgrn_row(c * 16 + s, d, b);
                VT[v * 16 + s] = (bf16_t)f2bf(U[(size_t)m * 8192 + icol + v]); } }
        __syncthreads();
        f32x4 att = {0.f, 0.f, 0.f, 0.f};
#pragma unroll
        for (int ks = 0; ks < 4; ++ks) { const bf16x8 af = *(const LAS bf16x8*)(Kt + fr * QROW + ks * 32 + g * 8), bfv = *(const LAS bf16x8*)(Qt + fr * QROW + ks * 32 + g * 8);
            att = __builtin_amdgcn_mfma_f32_16x16x32_bf16(af, bfv, att, 0, 0, 0); }
#pragma unroll
        for (int r = 0; r < 4; ++r) if (4 * g + r > fr) att[r] = 0.f;
        f32x4 oacc = {0.f, 0.f, 0.f, 0.f};
#pragma unroll
        for (int ks = 0; ks < 4; ++ks) {
            const f32x4 sA = sacc[2 * ks], sB = sacc[2 * ks + 1];
            u32x4 aw; aw.x = pk2(sA[0], sA[1]); aw.y = pk2(sA[2], sA[3]); aw.z = pk2(sB[0], sB[1]); aw.w = pk2(sB[2], sB[3]);
            const u32x2 q0 = *(const LAS u32x2*)(Qt + fr * QROW + ks * 32 + 4 * g), q1 = *(const LAS u32x2*)(Qt + fr * QROW + ks * 32 + 16 + 4 * g);
            u32x4 bw; bw.x = q0.x; bw.y = q0.y; bw.z = q1.x; bw.w = q1.y;
            oacc = __builtin_amdgcn_mfma_f32_16x16x32_bf16(__builtin_bit_cast(bf16x8, aw), __builtin_bit_cast(bf16x8, bw), oacc, 0, 0, 0);
        }
        { const u32x2 v4 = *(const LAS u32x2*)(VT + (wave * 16 + fr) * 16 + 4 * g);
          u32x4 aw; aw.x = v4.x; aw.y = v4.y; aw.z = 0u; aw.w = 0u;
          u32x4 bw; bw.x = pk2(att[0], att[1]); bw.y = pk2(att[2], att[3]); bw.z = 0u; bw.w = 0u;
          oacc = __builtin_amdgcn_mfma_f32_16x16x32_bf16(__builtin_bit_cast(bf16x8, aw), __builtin_bit_cast(bf16x8, bw), oacc, 0, 0, 0); }
        if (c >= 16) { const int m = hgrn_row(c * 16 + fr, d, b); *(f32x4*)(OUT + (size_t)m * 1024 + h * 128 + wave * 16 + 4 * g) = oacc; }
        { const bf16x8 vb = g < 2 ? *(const LAS bf16x8*)(VT + (wave * 16 + fr) * 16 + 8 * g) : zero8;
#pragma unroll
          for (int mt = 0; mt < 8; ++mt) { const bf16x8 ka = g < 2 ? *(const LAS bf16x8*)(KtT + (mt * 16 + fr) * 16 + 8 * g) : zero8;
              sacc[mt] = __builtin_amdgcn_mfma_f32_16x16x32_bf16(ka, vb, sacc[mt], 0, 0, 0);
              const f32x4 ev = *(const LAS f32x4*)(eL + mt * 16 + 4 * g); sacc[mt] = sacc[mt] * ev; } }
        __syncthreads();
    }
}

__device__ __forceinline__ void ph_mix1(const Args& a, LAS unsigned char* L) {
    const int bid = blockIdx.x;
    if (bid < 64) { hgrn_chain(a, L, bid); return; }
    const bf16_t* QD = AR_BF(A_QD); const bf16_t* KD = AR_BF(A_KD); const bf16_t* VD = AR_BF(A_VD); bf16_t* YC = AR_BF(A_YC);
    const float* lam = (const float*)a.in[25]; const float* subln = (const float*)a.in[26];
    float d01 = 0.f, d23 = 0.f;
    for (int j = 0; j < 64; ++j) { d01 += lam[j] * lam[64 + j]; d23 += lam[128 + j] * lam[192 + j]; }
    const float lam_init = 0.8f - 0.6f * expf(-0.3f);
    const float lmb = expf(d01) - expf(d23) + lam_init;
    for (int u = bid - 64; u < 512; u += 192) {
        const int b = u >> 7, h = (u >> 4) & 7, qb = u & 15; const int qrow0 = b * 2048 + qb * 128;
        AttnSeg s0, s1;
        s0.K = KD + (size_t)(b * 2048) * 1024 + h * 128; s0.V = VD + (size_t)(b * 2048) * 1024 + h * 128; s0.n = 2048;
        s1.K = KD + (size_t)(8192 + b * 256) * 1024 + h * 128; s1.V = VD + (size_t)(8192 + b * 256) * 1024 + h * 128; s1.n = 256;
        attn_unit<128, 2>(L, QD + (size_t)qrow0 * 1024 + h * 128, 1024, s0, s1, 1024, 1024, false, 0, 0, false, 0.f, lmb, subln, 1.f - lam_init,
                          YC + (size_t)qrow0 * 2048 + h * 128, 2048);
    }
}

__device__ __forceinline__ void ph_hgrn_post(const Args& a) {
    const int tid = threadIdx.x, lane = tid & 63, wave = tid >> 6, gw = blockIdx.x * 8 + wave, NGW = gridDim.x * 8;
    const float* OF = AR_F32(A_OF); const float* OB = AR_F32(A_OB); const float* U = AR_F32(A_U1); const float* gn = (const float*)a.in[27]; bf16_t* YC = AR_BF(A_YC);
    for (int task = gw; task < ML * 8; task += NGW) {
        const int m = task >> 3, h = task & 7; const size_t o = (size_t)m * 1024 + h * 128 + 2 * lane;
        const f32x2 x0 = *(const f32x2*)(OF + o), x1 = *(const f32x2*)(OB + o); const float y0 = x0.x + x1.x, y1 = x0.y + x1.y;
        const float rstd = rsqrtf(wave_sum(y0 * y0 + y1 * y1) * (1.f / 128.f) + 1e-6f);
        const f32x2 gg = *(const f32x2*)(U + (size_t)m * 8192 + 3072 + 4096 + h * 128 + 2 * lane);
        const float s0 = gg.x / (1.f + __expf(-gg.x)), s1 = gg.y / (1.f + __expf(-gg.y));
        const float r0 = y0 * rstd * gn[2 * lane] * s0, r1 = y1 * rstd * gn[2 * lane + 1] * s1;
        *(unsigned*)(YC + (size_t)m * 2048 + 1024 + h * 128 + 2 * lane) = pk2(r0, r1);
    }
}
#define MK_SINGLE 1

#ifndef MK_SINGLE
#define MK_SINGLE 0
#endif
constexpr int NPHASE = 20;

__global__ void __launch_bounds__(NTHR, 2) mk_fwd(Args a) {
    extern __shared__ __attribute__((aligned(16))) unsigned char lds_raw[];
    LAS unsigned char* L = (LAS unsigned char*)lds_raw;
    const float* mod0 = WS_F32(OFF_MOD); const float* mod1 = mod0 + 5 * 12288;
    const int G = gridDim.x, bx = blockIdx.x;
#if MK_SINGLE
    cg::grid_group grid = cg::this_grid();
#define SEAM(k) do { if (a.ph_lo <= (k) && (k) + 1 < a.ph_hi) grid.sync(); } while (0)
#else
#define SEAM(k) do { } while (0)
#endif
#define IN(k) (a.ph_lo <= (k) && (k) < a.ph_hi)
    typedef pg8::StaticOrder SO;
    if (IN(0)) { ph_prologue(a, L); SEAM(0); }
    if (IN(1)) { ph_modulate((const float*)a.in[0], (const float*)a.in[2], MT, mod0, 0, 1, WS_BF(OFF_HN)); SEAM(1); }
    if (IN(2)) { pg8::Gemm g{WS_BF(OFF_HN), WS_BF(WT_ABIN), MT, ABINP, DM}; SO S; S.init(MT, ABINP, G, bx); pg8::EpiF32 E{AR_F32(A_U0), ABINP};
        pg8::gemm_phase<pg8::EpiF32, SO, true, true>(L, g, S, E); SEAM(2); }
    if (IN(3)) { ph_rwkv_prep(a, L); SEAM(3); }
    if (IN(4)) { ph_mix0(a, L); SEAM(4); }
    if (IN(5)) { ph_rwkv_post(a); SEAM(5); }
    if (IN(6)) { pg8::Gemm g{AR_BF(A_YA), WS_BF(WT_ABOUT), MT, DM, DM}; SO S; S.init(MT, DM, G, bx);
        pg8::EpiResGate E{(const float*)a.in[0], (const float*)a.in[2], AR_F32(A_X1), mod0 + 2 * 2048};
        pg8::gemm_phase<pg8::EpiResGate, SO, true, true>(L, g, S, E); SEAM(6); }
    if (IN(7)) { ph_modulate(AR_F32(A_X1), AR_F32(A_X1) + (size_t)ML * DM, MT, mod0, 3, 4, WS_BF(OFF_HN)); SEAM(7); }
    if (IN(8)) { pg8::Gemm g{WS_BF(OFF_HN), WS_BF(WT_W1_0), MT, FF, DM}; SO S; S.init(MT, FF, G, bx); pg8::EpiSqReluBf16 E{AR_BF(A_HID), FF};
        pg8::gemm_phase<pg8::EpiSqReluBf16, SO, true, true>(L, g, S, E); SEAM(8); }
    if (IN(9)) { pg8::Gemm g{AR_BF(A_HID), WS_BF(WT_W2_0), MT, DM, FF}; SO S; S.init(MT, DM, G, bx);
        pg8::EpiResGate E{AR_F32(A_X1), AR_F32(A_X1) + (size_t)ML * DM, AR_F32(A_X2), mod0 + 5 * 2048};
        pg8::gemm_phase<pg8::EpiResGate, SO, true, true>(L, g, S, E); SEAM(9); }
    if (IN(10)) { ph_modulate(AR_F32(A_X2), AR_F32(A_X2) + (size_t)ML * DM, MT, mod1, 0, 1, WS_BF(OFF_HN)); SEAM(10); }
    if (IN(11)) { pg8::Gemm g{WS_BF(OFF_HN), WS_BF(WT_CDIN), MT, FF, DM}; SO S; S.init(MT, FF, G, bx); pg8::EpiF32 E{AR_F32(A_U1), FF};
        pg8::gemm_phase<pg8::EpiF32, SO, true, true>(L, g, S, E); SEAM(11); }
    if (IN(12)) { ph_diff_prep(a); SEAM(12); }
    if (IN(13)) { ph_mix1(a, L); SEAM(13); }
    if (IN(14)) { ph_hgrn_post(a); SEAM(14); }
    if (IN(15)) { pg8::Gemm g{AR_BF(A_YC), WS_BF(WT_CDOUT), ML, DM, DM}; SO S; S.init(ML, DM, G, bx);
        pg8::EpiResGate E{AR_F32(A_X2), AR_F32(A_X2) + (size_t)ML * DM, AR_F32(A_X3), mod1 + 2 * 2048};
        pg8::gemm_phase<pg8::EpiResGate, SO, true, true>(L, g, S, E); SEAM(15); }
    if (IN(16)) { ph_modulate(AR_F32(A_X3), AR_F32(A_X3), ML, mod1, 3, 4, WS_BF(OFF_HN)); SEAM(16); }
    if (IN(17)) { pg8::Gemm g{WS_BF(OFF_HN), WS_BF(WT_W1_1), ML, FF, DM}; SO S; S.init(ML, FF, G, bx); pg8::EpiSqReluBf16 E{AR_BF(A_HID1), FF};
        pg8::gemm_phase<pg8::EpiSqReluBf16, SO, true, true>(L, g, S, E); SEAM(17); }
    if (IN(18)) { pg8::Gemm g{AR_BF(A_HID1), WS_BF(WT_W2_1), ML, DM, FF}; SO S; S.init(ML, DM, G, bx);
        pg8::EpiResGate E{AR_F32(A_X3), AR_F32(A_X3), a.out, mod1 + 5 * 2048};
        pg8::gemm_phase<pg8::EpiResGate, SO, true, true>(L, g, S, E); SEAM(18); }
    if (IN(19)) { ph_final(a); }
#undef IN
#undef SEAM
}

extern "C" void kernel_launch(void* const* d_in, const int* in_sizes, int n_in, void* d_out, int out_size, void* d_ws, size_t ws_size, hipStream_t stream) {
    static int grid = 0;
    if (grid == 0) {
        if (n_in != 29 || out_size != ML * DM || ws_size < WS_TOTAL) { fprintf(stderr, "kernel_launch: unexpected shapes (n_in %d, out %d, ws %zu < %zu)\n", n_in, out_size, ws_size, (size_t)WS_TOTAL); grid = -1; return; }
        int dev = 0, cus = 0, per_cu = 0;
        if (hipGetDevice(&dev) != hipSuccess || hipDeviceGetAttribute(&cus, hipDeviceAttributeMultiprocessorCount, dev) != hipSuccess) { grid = -1; return; }
        if (hipFuncSetAttribute((const void*)mk_fwd, hipFuncAttributeMaxDynamicSharedMemorySize, LDS_BYTES) != hipSuccess) { fprintf(stderr, "kernel_launch: hipFuncSetAttribute failed\n"); grid = -1; return; }
        if (hipOccupancyMaxActiveBlocksPerMultiprocessor(&per_cu, (const void*)mk_fwd, NTHR, LDS_BYTES) != hipSuccess || per_cu < 1) { fprintf(stderr, "kernel_launch: occupancy query says %d\n", per_cu); grid = -1; (void)hipGetLastError(); return; }
        grid = cus;
        if (grid != NBLK) { fprintf(stderr, "kernel_launch: built for %d CUs, device has %d\n", NBLK, cus); grid = -1; return; }
    }
    if (grid < 0) return;
    Args a{};
    for (int i = 0; i < 29; ++i) a.in[i] = d_in[i];
    a.out = (float*)d_out; a.ws = (unsigned char*)d_ws;
#if MK_SINGLE
    a.ph_lo = 0; a.ph_hi = NPHASE;
    void* args[] = {&a};
    hipError_t e = hipLaunchCooperativeKernel((const void*)mk_fwd, dim3(grid), dim3(NTHR), args, LDS_BYTES, stream);
    if (e != hipSuccess) fprintf(stderr, "kernel_launch: cooperative launch failed: %s\n", hipGetErrorString(e));
#else
    for (int p = 0; p < NPHASE; ++p) { a.ph_lo = p; a.ph_hi = p + 1; hipLaunchKernelGGL(mk_fwd, dim3(grid), dim3(NTHR), LDS_BYTES, stream, a); }
#endif
}
```

```cpp
#define MK_SINGLE 1
#include <hip/hip_runtime.h>
#include <hip/hip_cooperative_groups.h>
#include <cstdio>
#include <cstdint>
namespace cg = cooperative_groups;

#define LAS __attribute__((address_space(3)))
typedef unsigned short bf16_t;
typedef short bf16x8 __attribute__((ext_vector_type(8)));
typedef short bf16x4 __attribute__((ext_vector_type(4)));
typedef float f32x4 __attribute__((ext_vector_type(4)));
typedef float f32x2 __attribute__((ext_vector_type(2)));
typedef unsigned u32x4 __attribute__((ext_vector_type(4)));
typedef unsigned u32x2 __attribute__((ext_vector_type(2)));

constexpr int DM = 2048, NB = 4, TL = 2048, TC = 256, ML = NB * TL, MC = NB * TC, MT = ML + MC, FF = 8192;
constexpr int MODW = 6 * DM;
constexpr int ABINP = 4864;
constexpr int NBLK = 256, NTHR = 512;

constexpr size_t OFF_CTL = 0;
constexpr size_t OFF_MOD = 1048576;
constexpr size_t OFF_ROPE = 1572864;
constexpr size_t OFF_WT = 2097152;
constexpr size_t WT_ABIN = OFF_WT;
constexpr size_t WT_ABOUT = WT_ABIN + (size_t)ABINP * DM * 2;
constexpr size_t WT_W1_0 = WT_ABOUT + (size_t)DM * DM * 2;
constexpr size_t WT_W2_0 = WT_W1_0 + (size_t)FF * DM * 2;
constexpr size_t WT_CDIN = WT_W2_0 + (size_t)FF * DM * 2;
constexpr size_t WT_CDOUT = WT_CDIN + (size_t)FF * DM * 2;
constexpr size_t WT_W1_1 = WT_CDOUT + (size_t)DM * DM * 2;
constexpr size_t WT_W2_1 = WT_W1_1 + (size_t)FF * DM * 2;
constexpr size_t OFF_HN = WT_W2_1 + (size_t)FF * DM * 2;
constexpr size_t OFF_ARENA = OFF_HN + (size_t)MT * DM * 2;
constexpr size_t SZ_TOK1K_F32 = (size_t)MT * 1024 * 4;
constexpr size_t A_U0 = 0;
constexpr int OPSZ = 9984;
constexpr size_t A_OPS = 90177536;
constexpr size_t A_PREP = 274726912;
static_assert(A_U0 + (size_t)MT * ABINP * 2 <= A_OPS && A_OPS + (size_t)128 * 144 * OPSZ <= A_PREP, "ws map");
constexpr size_t DO_G = 0;
constexpr size_t DO_SCAL = DO_G + (size_t)MT * 1024 * 2;
constexpr size_t DO_SQ = DO_SCAL + (size_t)MT * 16 * 16;
constexpr size_t DO_SK = DO_SQ + (size_t)MT * 1024 * 2;
constexpr size_t DO_SV = DO_SK + (size_t)MT * 256 * 2;
static_assert(DO_SV + (size_t)MT * 256 * 2 <= (size_t)ML * DM * 4, "d_out scratch");
constexpr size_t A_L0END = A_PREP + 7 * SZ_TOK1K_F32;
constexpr size_t A_YF = A_PREP, A_YB = A_PREP + SZ_TOK1K_F32, A_YA = A_PREP + 2 * SZ_TOK1K_F32;
constexpr size_t A_X1 = 0;
constexpr size_t A_HID = A_X1 + (size_t)MT * DM * 4;
constexpr size_t A_SLAB6 = 83886080;
static_assert(A_SLAB6 >= A_X1 + (size_t)MT * DM * 4 && A_SLAB6 + (size_t)8 * MC * DM * 4 <= A_PREP, "ws map");
constexpr size_t A_X2 = 316669952;
constexpr size_t A_SLAB = A_X2 + (size_t)MT * DM * 4;
static_assert(A_HID + (size_t)MT * FF * 2 <= A_YA, "ws map: HID must not reach YA (read by the out projection while X1 is written; HID is written later)");
static_assert(A_HID + (size_t)MT * FF * 2 <= A_X2, "ws map");
constexpr size_t A_U1 = 0;
static_assert(A_U1 + (size_t)MT * FF * 4 <= A_X2, "ws map");
constexpr size_t A_QD = A_SLAB;
constexpr size_t A_KD = A_QD + (size_t)ML * 1024 * 2;
constexpr size_t A_VD = A_KD + (size_t)MT * 1024 * 2;
constexpr size_t A_OF = A_VD + (size_t)MT * 1024 * 2;
constexpr size_t A_OB = A_OF + (size_t)ML * 1024 * 4;
constexpr size_t A_YC = A_OB + (size_t)ML * 1024 * 4;
constexpr size_t A_L1END = A_YC + (size_t)ML * DM * 2;
constexpr size_t A_X3 = A_U1;
constexpr size_t A_HID1 = A_U1 + (size_t)ML * DM * 4;
static_assert(A_HID1 + (size_t)ML * FF * 2 <= A_X2, "ws map");
constexpr size_t A_END0 = A_SLAB + (size_t)8 * MC * DM * 4;
constexpr size_t WS_TOTAL = OFF_ARENA + (A_L0END > A_L1END ? (A_L0END > A_END0 ? A_L0END : A_END0) : (A_L1END > A_END0 ? A_L1END : A_END0));
static_assert(WS_TOTAL <= 805306368ull, "d_ws budget (4 x the largest tensor)");

constexpr int LDS_BYTES = 147456;

typedef __bf16 hwbf16x2 __attribute__((ext_vector_type(2)));
__device__ __forceinline__ unsigned pk2(float lo, float hi) { const f32x2 v = {lo, hi}; const hwbf16x2 b = __builtin_convertvector(v, hwbf16x2); return __builtin_bit_cast(unsigned, b); }
__device__ __forceinline__ unsigned f2bf(float f) { return pk2(f, 0.f) & 0xffffu; }
__device__ __forceinline__ float dppf(float x, const int ctrl_sel) {
    const int xi = __builtin_bit_cast(int, x); int r;
    if (ctrl_sel == 0) r = __builtin_amdgcn_update_dpp(xi, xi, 0xB1, 0xF, 0xF, true);
    else if (ctrl_sel == 1) r = __builtin_amdgcn_update_dpp(xi, xi, 0x4E, 0xF, 0xF, true);
    else if (ctrl_sel == 2) r = __builtin_amdgcn_update_dpp(xi, xi, 0x141, 0xF, 0xF, true);
    else r = __builtin_amdgcn_update_dpp(xi, xi, 0x140, 0xF, 0xF, true);
    return __builtin_bit_cast(float, r);
}
__device__ __forceinline__ float row16_sum(float x) { x += dppf(x, 0); x += dppf(x, 1); x += dppf(x, 2); x += dppf(x, 3); return x; }
__device__ __forceinline__ float wave_sum(float v) {
    v = row16_sum(v);
    { float p = v, q = v; asm volatile("s_nop 1\n\tv_permlane16_swap_b32 %0, %1" : "+v"(p), "+v"(q)); v = p + q; }
    { float p = v, q = v; asm volatile("s_nop 1\n\tv_permlane32_swap_b32 %0, %1" : "+v"(p), "+v"(q)); v = p + q; }
    return v;
}
__device__ __forceinline__ float row16_max(float x) { x = fmaxf(x, dppf(x, 0)); x = fmaxf(x, dppf(x, 1)); x = fmaxf(x, dppf(x, 2)); x = fmaxf(x, dppf(x, 3)); return x; }
__device__ __forceinline__ float sigmoidf_(float x) { return 1.f / (1.f + __expf(-x)); }

__device__ __forceinline__ void lds_barrier() { asm volatile("s_waitcnt lgkmcnt(0)\n\ts_barrier" ::: "memory"); }

struct Args { const void* in[29]; float* out; unsigned char* ws; int ph_lo, ph_hi; };

namespace pg8 {
#define PG8_LAS __attribute__((address_space(3)))
typedef unsigned short bf16_t;
typedef short bf16x8 __attribute__((ext_vector_type(8)));
typedef float f32x4 __attribute__((ext_vector_type(4)));
typedef unsigned u32x4 __attribute__((ext_vector_type(4)));
constexpr int BM = 256, BK = 64, HALF = 128, HTB = HALF * BK * 2  , STAGE_BYTES = 8 * HTB, NXCD = 8, WGM = 8;

__host__ __device__ __forceinline__ int lds_byte(int r, int c) { const int st = (r >> 4) * 2 + (c >> 5), rr = r & 15, cc = c & 31, ob = rr * 64 + cc * 2; return st * 1024 + (ob ^ (((ob >> 9) & 1) << 5)); }
__host__ __device__ __forceinline__ void stage_rc(int b, int& R, int& C) { const int st = b / 1024, sb = b % 1024, swz = sb ^ (((sb >> 9) & 1) << 5); R = (st >> 1) * 16 + swz / 64; C = (st & 1) * 32 + (swz % 64) / 2; }
__host__ __device__ __forceinline__ int perm32(int rho) { const int n = rho >> 4, i = rho & 15; return 8 * (i >> 2) + 4 * n + (i & 3); }

struct Unit { int pm, pn, ko; };
struct Gemm { const bf16_t* A; const bf16_t* Bt; int M, N, K, ld; };

struct StaticOrder {
    int nM, nN, nwg, G, c;
    __host__ __device__ void init(int M, int N, int G_, int c_) { nM = M / BM; nN = N / BM; nwg = nM * nN; G = G_; c = c_; }
    __host__ __device__ bool next(int i, Unit& u) const {
        const long L = (long)i * G + c; if (L >= nwg) return false;
        int wgid = (int)L; { const int q = nwg / NXCD, r = nwg % NXCD, xcd = wgid % NXCD, off = wgid / NXCD; wgid = (xcd < r ? xcd * (q + 1) : r * (q + 1) + (xcd - r) * q) + off; }
        const int nig = WGM * nN, gid = wgid / nig, fm = gid * WGM, gsz = (nM - fm) < WGM ? (nM - fm) : WGM;
        u.pm = fm + ((wgid % nig) % gsz); u.pn = (wgid % nig) / gsz; u.ko = 0; return true;
    }
    __device__ __forceinline__ void a_ready(const Unit&) const {}
    __device__ __forceinline__ void done(const Unit&) const {}
};

struct SplitKOrder {
    int pm0, nTm, nTn, ns, kslice, G, c;
    __host__ __device__ void init(int pm0_, int nTm_, int nTn_, int ns_, int kslice_, int G_, int c_) { pm0 = pm0_; nTm = nTm_; nTn = nTn_; ns = ns_; kslice = kslice_; G = G_; c = c_; }
    __host__ __device__ bool next(int i, Unit& u) const {
        const long L = (long)i * G + c; if (L >= (long)nTm * nTn * ns) return false;
        const int s = (int)(L % ns), t = (int)(L / ns); u.pm = pm0 + t / nTn; u.pn = t % nTn; u.ko = s * kslice; return true;
    }
    __device__ __forceinline__ void a_ready(const Unit&) const {}
    __device__ __forceinline__ void done(const Unit&) const {}
};

struct EpiF32 {
    static constexpr bool PERM = false, AFTER_DRAIN = false;
    float* O; int ldc;
    __device__ __forceinline__ void operator()(const f32x4 (&acc)[2][2][4][2], const Unit& u, int wr, int wc, int fr, int fq) const {
        const int col0 = u.pn * BM + wc * 32 + 4 * fq;
#pragma unroll
        for (int ai = 0; ai < 2; ++ai)
#pragma unroll
            for (int m = 0; m < 4; ++m) { float* rowp = O + (size_t)(u.pm * BM + ai * HALF + wr * 64 + m * 16 + fr) * ldc + col0;
#pragma unroll
                for (int bj = 0; bj < 2; ++bj)
#pragma unroll
                    for (int n = 0; n < 2; ++n) *(f32x4*)(rowp + bj * HALF + n * 16) = acc[ai][bj][m][n]; }
    }
};
struct EpiResGate {
    static constexpr bool PERM = false, AFTER_DRAIN = false;
    const float* baseL; const float* baseC; float* out; const float* gate;
    __device__ __forceinline__ void operator()(const f32x4 (&acc)[2][2][4][2], const Unit& u, int wr, int wc, int fr, int fq) const {
        const int col0 = u.pn * BM + wc * 32 + 4 * fq;
        const int rowt = u.pm * BM;
        const int rg = rowt < 8192 ? (rowt >> 11) : 4;
        const float* gp = gate + (size_t)rg * 12288 + col0;
        f32x4 gv[2][2];
#pragma unroll
        for (int bj = 0; bj < 2; ++bj)
#pragma unroll
            for (int n = 0; n < 2; ++n) gv[bj][n] = *(const f32x4*)(gp + bj * HALF + n * 16);
#pragma unroll
        for (int ai = 0; ai < 2; ++ai)
#pragma unroll
            for (int m = 0; m < 4; ++m) { const int row = rowt + ai * HALF + wr * 64 + m * 16 + fr;
                const float* bp = (row < 8192 ? baseL + (size_t)row * 2048 : baseC + (size_t)(row - 8192) * 2048) + col0;
                float* op = out + (size_t)row * 2048 + col0;
#pragma unroll
                for (int bj = 0; bj < 2; ++bj)
#pragma unroll
                    for (int n = 0; n < 2; ++n) { const f32x4 b = *(const f32x4*)(bp + bj * HALF + n * 16); *(f32x4*)(op + bj * HALF + n * 16) = b + gv[bj][n] * acc[ai][bj][m][n]; } }
    }
};
struct EpiSqReluBf16 {
    static constexpr bool PERM = true, AFTER_DRAIN = false;
    bf16_t* O; int ldc;
    __device__ __forceinline__ unsigned pk(float lo, float hi) const { return ::pk2(lo, hi); }
    __device__ __forceinline__ void operator()(const f32x4 (&acc)[2][2][4][2], const Unit& u, int wr, int wc, int fr, int fq) const {
        const int col0 = u.pn * BM + wc * 32 + 8 * fq;
#pragma unroll
        for (int ai = 0; ai < 2; ++ai)
#pragma unroll
            for (int m = 0; m < 4; ++m) { bf16_t* rowp = O + (size_t)(u.pm * BM + ai * HALF + wr * 64 + m * 16 + fr) * ldc + col0;
#pragma unroll
                for (int bj = 0; bj < 2; ++bj) { f32x4 v0 = acc[ai][bj][m][0], v1 = acc[ai][bj][m][1];
#pragma unroll
                    for (int e = 0; e < 4; ++e) { const float a0 = fmaxf(v0[e], 0.f), a1 = fmaxf(v1[e], 0.f); v0[e] = a0 * a0; v1[e] = a1 * a1; }
                    u32x4 w; w.x = pk(v0[0], v0[1]); w.y = pk(v0[2], v0[3]); w.z = pk(v1[0], v1[1]); w.w = pk(v1[2], v1[3]);
                    *(u32x4*)(rowp + bj * HALF) = w; } }
    }
};


struct EpiSlab {
    static constexpr bool PERM = true, AFTER_DRAIN = false;
    bf16_t* O; int row0, kslice; size_t slab_stride;
    __device__ __forceinline__ void operator()(const f32x4 (&acc)[2][2][4][2], const Unit& u, int wr, int wc, int fr, int fq) const {
        const int col0 = u.pn * BM + wc * 32 + 8 * fq; bf16_t* Ob = O + (size_t)(u.ko / kslice) * slab_stride;
#pragma unroll
        for (int ai = 0; ai < 2; ++ai)
#pragma unroll
            for (int m = 0; m < 4; ++m) { bf16_t* rowp = Ob + (size_t)(u.pm * BM - row0 + ai * HALF + wr * 64 + m * 16 + fr) * 2048 + col0;
#pragma unroll
                for (int bj = 0; bj < 2; ++bj) { const f32x4 v0 = acc[ai][bj][m][0], v1 = acc[ai][bj][m][1];
                    u32x4 w; w.x = ::pk2(v0[0], v0[1]); w.y = ::pk2(v0[2], v0[3]); w.z = ::pk2(v1[0], v1[1]); w.w = ::pk2(v1[2], v1[3]);
                    *(u32x4*)(rowp + bj * HALF) = w; } }
    }
};

struct EpiBf16Plain {
    static constexpr bool PERM = true, AFTER_DRAIN = false;
    bf16_t* O; int ldc;
    __device__ __forceinline__ void operator()(const f32x4 (&acc)[2][2][4][2], const Unit& u, int wr, int wc, int fr, int fq) const {
        const int col0 = u.pn * BM + wc * 32 + 8 * fq;
#pragma unroll
        for (int ai = 0; ai < 2; ++ai)
#pragma unroll
            for (int m = 0; m < 4; ++m) { bf16_t* rowp = O + (size_t)(u.pm * BM + ai * HALF + wr * 64 + m * 16 + fr) * ldc + col0;
#pragma unroll
                for (int bj = 0; bj < 2; ++bj) { const f32x4 v0 = acc[ai][bj][m][0], v1 = acc[ai][bj][m][1];
                    u32x4 w; w.x = ::pk2(v0[0], v0[1]); w.y = ::pk2(v0[2], v0[3]); w.z = ::pk2(v1[0], v1[1]); w.w = ::pk2(v1[2], v1[3]);
                    *(u32x4*)(rowp + bj * HALF) = w; } }
    }
};

struct EpiCdIn {
    static constexpr bool PERM = false, AFTER_DRAIN = false;
    bf16_t* QD; bf16_t* KD; bf16_t* VD; bf16_t* U1; const float* tab;
    __device__ __forceinline__ void operator()(const f32x4 (&acc)[2][2][4][2], const Unit& u, int wr, int wc, int fr, int fq) const {
        const int rowt = u.pm * BM;
        if (u.pn >= 12) {
            const int col0 = u.pn * BM + wc * 32 + 4 * fq;
#pragma unroll
            for (int ai = 0; ai < 2; ++ai)
#pragma unroll
                for (int m = 0; m < 4; ++m) { bf16_t* rowp = U1 + (size_t)(rowt + ai * HALF + wr * 64 + m * 16 + fr) * 8192 + col0;
#pragma unroll
                    for (int bj = 0; bj < 2; ++bj)
#pragma unroll
                        for (int n = 0; n < 2; ++n) { const f32x4 v = acc[ai][bj][m][n]; u32x2 w; w.x = ::pk2(v[0], v[1]); w.y = ::pk2(v[2], v[3]); *(u32x2*)(rowp + bj * HALF + n * 16) = w; } }
        } else if (u.pn >= 8) {
            const int col0 = (u.pn - 8) * BM + wc * 32 + 4 * fq;
#pragma unroll
            for (int ai = 0; ai < 2; ++ai)
#pragma unroll
                for (int m = 0; m < 4; ++m) { bf16_t* rowp = VD + (size_t)(rowt + ai * HALF + wr * 64 + m * 16 + fr) * 1024 + col0;
#pragma unroll
                    for (int bj = 0; bj < 2; ++bj)
#pragma unroll
                        for (int n = 0; n < 2; ++n) { const f32x4 v = acc[ai][bj][m][n]; u32x2 w; w.x = ::pk2(v[0], v[1]); w.y = ::pk2(v[2], v[3]); *(u32x2*)(rowp + bj * HALF + n * 16) = w; } }
        } else {
            const bool isk = u.pn >= 4; const bool lat = rowt < 8192;
            if (!isk && !lat) return;
            bf16_t* dst = isk ? KD : QD; const int G = wc & 1, i0 = 16 * G + 4 * fq;
#pragma unroll
            for (int ai = 0; ai < 2; ++ai)
#pragma unroll
                for (int m = 0; m < 4; ++m) { const int row = rowt + ai * HALF + wr * 64 + m * 16 + fr; const int t = row & 2047;
                    f32x4 c01 = {1.f, 0.f, 1.f, 0.f}, c23 = c01;
                    if (lat) { const float* tp = tab + (size_t)(((G == 0) ? (t >> 6) : (t & 63)) * 16 + 4 * fq) * 2; c01 = *(const f32x4*)tp; c23 = *(const f32x4*)(tp + 4); }
#pragma unroll
                    for (int bj = 0; bj < 2; ++bj) { const int hs = (u.pn & 3) * 4 + bj * 2 + (wc >> 1); const f32x4 x1 = acc[ai][bj][m][0], x2 = acc[ai][bj][m][1];
                        const f32x4 o1 = {x1[0] * c01[0] - x2[0] * c01[1], x1[1] * c01[2] - x2[1] * c01[3], x1[2] * c23[0] - x2[2] * c23[1], x1[3] * c23[2] - x2[3] * c23[3]};
                        const f32x4 o2 = {x1[0] * c01[1] + x2[0] * c01[0], x1[1] * c01[3] + x2[1] * c01[2], x1[2] * c23[1] + x2[2] * c23[0], x1[3] * c23[3] + x2[3] * c23[2]};
                        bf16_t* rp = dst + (size_t)row * 1024 + hs * 64 + i0;
                        u32x2 w; w.x = ::pk2(o1[0], o1[1]); w.y = ::pk2(o1[2], o1[3]); *(u32x2*)rp = w;
                        w.x = ::pk2(o2[0], o2[1]); w.y = ::pk2(o2[2], o2[3]); *(u32x2*)(rp + 32) = w; } }
        }
    }
};
template <class Epi, class Sched, bool ALIGN_EPI = false, bool SP2 = false>
__device__ __forceinline__ void gemm_phase(PG8_LAS unsigned char* lds, const Gemm g, const Sched& S, const Epi& E) {
    const int tid = threadIdx.x, wid = __builtin_amdgcn_readfirstlane(tid >> 6), lane = tid & 63, wr = wid >> 2, wc = wid & 3, fr = lane & 15, fq = lane >> 4;
    const int K = g.K, nt = K / BK, LD = g.ld;
    unsigned voffA[2], voffB[2];
#pragma unroll
    for (int i = 0; i < 2; ++i) { int R, C; stage_rc(tid * 16 + i * 8192, R, C); const int Rb = Epi::PERM ? ((R & ~31) + perm32(R & 31)) : R;
        voffA[i] = (unsigned)(R * LD + C) * 2u; voffB[i] = (unsigned)(Rb * LD + C) * 2u; }
    const size_t kstep = (size_t)(BK * 2);
    const size_t hstep = (size_t)HALF * LD * 2;
    const size_t tstep = 2 * hstep;
    const unsigned ldsw = (unsigned)wid * 1024u;
    const int aoff = lds_byte(wr * 64 + fr, fq * 8), boff = lds_byte(wc * 32 + fr, fq * 8);
#define PG8_SA(b, h) (((b) * 2 + (h)) * HTB)
#define PG8_SB(b, h) ((4 + (b) * 2 + (h)) * HTB)
#define PG8_STAGE(bufoff, gbase, voff) do { _Pragma("unroll") for (int _i = 0; _i < 2; ++_i) \
        __builtin_amdgcn_global_load_lds((const unsigned*)((const char*)(gbase) + (voff)[_i]), (PG8_LAS unsigned*)(lds + (bufoff) + ldsw + _i * 8192), 16, 0, 0); } while (0)
#define PG8_LDA(dst, b, h) do { _Pragma("unroll") for (int m = 0; m < 4; ++m) _Pragma("unroll") for (int k = 0; k < 2; ++k) dst[m][k] = *(const PG8_LAS bf16x8*)(lds + PG8_SA(b, h) + aoff + m * 2048 + k * 1024); } while (0)
#define PG8_LDB(dst, b, h) do { _Pragma("unroll") for (int n = 0; n < 2; ++n) _Pragma("unroll") for (int k = 0; k < 2; ++k) dst[n][k] = *(const PG8_LAS bf16x8*)(lds + PG8_SB(b, h) + boff + n * 2048 + k * 1024); } while (0)
#define PG8_MMA(ai, bj, At, Bt) do { __builtin_amdgcn_s_setprio(1); _Pragma("unroll") for (int m = 0; m < 4; ++m) _Pragma("unroll") for (int n = 0; n < 2; ++n) _Pragma("unroll") for (int k = 0; k < 2; ++k) \
        acc[ai][bj][m][n] = __builtin_amdgcn_mfma_f32_16x16x32_bf16(Bt[n][k], At[m][k], acc[ai][bj][m][n], 0, 0, 0); __builtin_amdgcn_s_setprio(0); } while (0)
#define PG8_WAIT_V(n) asm volatile("s_waitcnt vmcnt(" #n ")" ::: "memory")
#define PG8_WAIT_L(n) asm volatile("s_waitcnt lgkmcnt(" #n ")" ::: "memory")
#define PG8_BAR __builtin_amdgcn_s_barrier()
#define PG8_SCHED __builtin_amdgcn_sched_barrier(0)
    Unit cur, nxt; int ui = 0;
    if (!S.next(0, cur)) return;
    f32x4 acc[2][2][4][2];
#pragma unroll
    for (int a = 0; a < 2; ++a)
#pragma unroll
        for (int b = 0; b < 2; ++b)
#pragma unroll
            for (int m = 0; m < 4; ++m)
#pragma unroll
                for (int n = 0; n < 2; ++n) acc[a][b][m][n] = (f32x4){0.f, 0.f, 0.f, 0.f};
    bf16x8 At[4][2], B0[2][2], B1[2][2];
    const char* cA = (const char*)g.A + (size_t)cur.pm * tstep + (size_t)cur.ko * 2; const char* cB = (const char*)g.Bt + (size_t)cur.pn * tstep + (size_t)cur.ko * 2;
    S.a_ready(cur);
    if constexpr (SP2) {
        PG8_STAGE(PG8_SB(0, 0), cB, voffB); PG8_STAGE(PG8_SB(0, 1), cB + hstep, voffB); PG8_STAGE(PG8_SA(0, 0), cA, voffA); PG8_STAGE(PG8_SA(0, 1), cA + hstep, voffA);
        if (wr == 1) PG8_BAR;
        PG8_WAIT_V(2); PG8_BAR;
        PG8_STAGE(PG8_SB(1, 0), cB + kstep, voffB); PG8_STAGE(PG8_SA(1, 0), cA + kstep, voffA); PG8_STAGE(PG8_SB(1, 1), cB + hstep + kstep, voffB);
        PG8_WAIT_V(6); PG8_BAR;
    } else {
        PG8_STAGE(PG8_SB(0, 0), cB, voffB); PG8_STAGE(PG8_SA(0, 0), cA, voffA); PG8_STAGE(PG8_SB(0, 1), cB + hstep, voffB); PG8_STAGE(PG8_SA(0, 1), cA + hstep, voffA);
        if (wr == 1) PG8_BAR;
        PG8_WAIT_V(4); PG8_BAR;
        PG8_STAGE(PG8_SB(1, 0), cB + kstep, voffB); PG8_STAGE(PG8_SA(1, 0), cA + kstep, voffA); PG8_STAGE(PG8_SB(1, 1), cB + hstep + kstep, voffB);
        PG8_WAIT_V(6); PG8_BAR;
    }
    for (;;) {
        const bool has_next = S.next(ui + 1, nxt);
        const char* nA = has_next ? (const char*)g.A + (size_t)nxt.pm * tstep + (size_t)nxt.ko * 2 : cA; const char* nB = has_next ? (const char*)g.Bt + (size_t)nxt.pn * tstep + (size_t)nxt.ko * 2 : cB;
        for (int t = 0; t < nt; t += 2) {
            const bool last = (t == nt - 2);
            const char* a1 = cA + (size_t)(t + 1) * kstep;
            const char* a2 = last ? nA : cA + (size_t)(t + 2) * kstep; const char* b2 = last ? nB : cB + (size_t)(t + 2) * kstep;
            const char* a3 = a2 + kstep; const char* b3 = b2 + kstep;
            if (last && has_next) S.a_ready(nxt);
            if constexpr (SP2) {
            PG8_LDB(B0, 0, 0); PG8_LDB(B1, 0, 1); PG8_SCHED; PG8_LDA(At, 0, 0); PG8_STAGE(PG8_SA(1, 1), a1 + hstep, voffA);
            PG8_WAIT_V(8); PG8_WAIT_L(0); PG8_BAR; PG8_MMA(0, 0, At, B0); PG8_MMA(0, 1, At, B1); PG8_BAR; PG8_SCHED;
            PG8_LDA(At, 0, 1); PG8_STAGE(PG8_SB(0, 0), b2, voffB); PG8_STAGE(PG8_SB(0, 1), b2 + hstep, voffB); PG8_STAGE(PG8_SA(0, 0), a2, voffA);
            PG8_WAIT_V(8); PG8_WAIT_L(0); PG8_BAR; PG8_MMA(1, 0, At, B0); PG8_MMA(1, 1, At, B1); PG8_BAR; PG8_SCHED;
            PG8_LDB(B0, 1, 0); PG8_LDB(B1, 1, 1); PG8_SCHED; PG8_LDA(At, 1, 0); PG8_STAGE(PG8_SA(0, 1), a2 + hstep, voffA);
            PG8_WAIT_V(8); PG8_WAIT_L(0); PG8_BAR; PG8_MMA(0, 0, At, B0); PG8_MMA(0, 1, At, B1); PG8_BAR; PG8_SCHED;
            PG8_LDA(At, 1, 1); PG8_STAGE(PG8_SB(1, 0), b3, voffB); PG8_STAGE(PG8_SB(1, 1), b3 + hstep, voffB); PG8_STAGE(PG8_SA(1, 0), a3, voffA);
            PG8_WAIT_V(8); PG8_WAIT_L(0); PG8_BAR; PG8_MMA(1, 0, At, B0); PG8_MMA(1, 1, At, B1); PG8_BAR; PG8_SCHED;
            } else {
            PG8_LDB(B0, 0, 0); PG8_SCHED; PG8_LDA(At, 0, 0); PG8_STAGE(PG8_SA(1, 1), a1 + hstep, voffA);
            PG8_WAIT_L(8); PG8_BAR; PG8_WAIT_L(0); PG8_MMA(0, 0, At, B0); PG8_BAR; PG8_SCHED;
            PG8_LDB(B1, 0, 1); PG8_STAGE(PG8_SB(0, 0), b2, voffB);
            PG8_BAR; PG8_WAIT_L(0); PG8_MMA(0, 1, At, B1); PG8_BAR;
            PG8_LDA(At, 0, 1); PG8_STAGE(PG8_SA(0, 0), a2, voffA);
            PG8_BAR; PG8_WAIT_L(0); PG8_MMA(1, 0, At, B0); PG8_BAR; PG8_SCHED;
            PG8_STAGE(PG8_SB(0, 1), b2 + hstep, voffB);
            PG8_WAIT_V(6); PG8_BAR; PG8_MMA(1, 1, At, B1); PG8_BAR;
            PG8_LDB(B0, 1, 0); PG8_SCHED; PG8_LDA(At, 1, 0); PG8_STAGE(PG8_SA(0, 1), a2 + hstep, voffA);
            PG8_WAIT_L(8); PG8_BAR; PG8_WAIT_L(0); PG8_MMA(0, 0, At, B0); PG8_BAR; PG8_SCHED;
            PG8_LDB(B1, 1, 1); PG8_STAGE(PG8_SB(1, 0), b3, voffB);
            PG8_BAR; PG8_WAIT_L(0); PG8_MMA(0, 1, At, B1); PG8_BAR;
            PG8_LDA(At, 1, 1); PG8_STAGE(PG8_SA(1, 0), a3, voffA);
            PG8_BAR; PG8_WAIT_L(0); PG8_MMA(1, 0, At, B0); PG8_BAR; PG8_SCHED;
            PG8_STAGE(PG8_SB(1, 1), b3 + hstep, voffB);
            PG8_WAIT_V(6); PG8_BAR; PG8_MMA(1, 1, At, B1); PG8_BAR;
            }
        }
        if constexpr (ALIGN_EPI) { if (wr == 0) PG8_BAR; }
        if constexpr (!Epi::AFTER_DRAIN) { E(acc, cur, wr, wc, fr, fq); S.done(cur); }
        if (!has_next) break;
#pragma unroll
        for (int a = 0; a < 2; ++a)
#pragma unroll
            for (int b = 0; b < 2; ++b)
#pragma unroll
                for (int m = 0; m < 4; ++m)
#pragma unroll
                    for (int n = 0; n < 2; ++n) acc[a][b][m][n] = (f32x4){0.f, 0.f, 0.f, 0.f};
        cur = nxt; cA = nA; cB = nB; ++ui;
        if constexpr (ALIGN_EPI) { if (wr == 1) PG8_BAR; }
    }
    PG8_WAIT_V(0);
    if constexpr (!ALIGN_EPI) { if (wr == 0) PG8_BAR; }
    PG8_BAR;
    if constexpr (Epi::AFTER_DRAIN) { E.fused(acc, cur, wr, wc, fr, fq, lds, wid, lane); S.done(cur); }
#undef PG8_SA
#undef PG8_SB
#undef PG8_STAGE
#undef PG8_LDA
#undef PG8_LDB
#undef PG8_MMA
#undef PG8_WAIT_V
#undef PG8_WAIT_L
#undef PG8_BAR
#undef PG8_SCHED
}
}

#define WS_F32(off) ((float*)(a.ws + (off)))
#define WS_BF(off) ((bf16_t*)(a.ws + (off)))
#define AR_F32(off) ((float*)(a.ws + OFF_ARENA + (off)))
#define AR_BF(off) ((bf16_t*)(a.ws + OFF_ARENA + (off)))
#ifdef MK_DIAG
#define DS_INIT() unsigned long long ds_last_ = __builtin_amdgcn_s_memrealtime()
#define DS(k) do { if (blockIdx.x == 0 && threadIdx.x == 0) { const unsigned long long t_ = __builtin_amdgcn_s_memrealtime(); ((unsigned long long*)(a.ws + OFF_CTL))[32 + (k)] += t_ - ds_last_; ds_last_ = t_; } } while (0)
#else
#define DS_INIT() do { } while (0)
#define DS(k) do { } while (0)
#endif

template <bool ROPEPERM = false>
__device__ __forceinline__ void p0_transpose_item(const float* W, int K, int N, bf16_t* WT, LAS float* scr, int item, int lane) {
    const int nblk = N / 32, kb = item / nblk, nb = item % nblk, k0 = 64 * kb, n0 = 32 * nb;
#pragma unroll 8
    for (int i = 0; i < 32; ++i) { const int kk = 2 * i + (lane >> 5); scr[kk * 33 + (lane & 31)] = W[(size_t)(k0 + kk) * N + n0 + (lane & 31)]; }
    asm volatile("s_waitcnt lgkmcnt(0)" ::: "memory");
    const int c = lane & 7;
#pragma unroll
    for (int j = 0; j < 4; ++j) { const int n = (lane >> 3) + 8 * j; const LAS float* s = scr + (8 * c) * 33 + n;
        u32x4 o; o.x = pk2(s[0 * 33], s[1 * 33]); o.y = pk2(s[2 * 33], s[3 * 33]); o.z = pk2(s[4 * 33], s[5 * 33]); o.w = pk2(s[6 * 33], s[7 * 33]);
        int nr = n0 + n;
        if (ROPEPERM && nr < 2048) { const int o64 = nr & 63, x = o64 >> 5, i = o64 & 31; nr = (nr & ~63) + (i >> 4) * 32 + x * 16 + (i & 15); }
        *(u32x4*)(WT + (size_t)nr * K + k0 + 8 * c) = o; }
    asm volatile("s_waitcnt lgkmcnt(0)" ::: "memory");
}

__device__ __forceinline__ void ph_prologue(const Args& a, LAS unsigned char* L) {
    const int tid = threadIdx.x, lane = tid & 63, wave = tid >> 6, bid = blockIdx.x, nblk = gridDim.x;
    float* mod = WS_F32(OFF_MOD);
    for (int it = bid; it < 256; it += nblk) {
        const int l = it >> 7, n0 = (it & 127) * 96;
        LAS float* sl = (LAS float*)L;
        LAS float* part = sl + 5 * 2048;
        const float* cin = (const float*)a.in[1]; const float* cctx = (const float*)a.in[3];
        for (int i = tid; i < 5 * 2048; i += NTHR) { const int r = i >> 11, k = i & 2047; const float x = r < 4 ? cin[r * 2048 + k] : cctx[k]; sl[i] = x / (1.f + expf(-x)); }
        __syncthreads();
        const int ln = lane < 48 ? lane : 47;
        const float* W = (const float*)a.in[4] + (size_t)l * 2048 * 12288 + n0 + 2 * ln;
        float acc0[5], acc1[5];
#pragma unroll
        for (int r = 0; r < 5; ++r) { acc0[r] = 0.f; acc1[r] = 0.f; }
        const int kb = wave * 256;
#pragma unroll 8
        for (int k = 0; k < 256; ++k) { const f32x2 wv = *(const f32x2*)(W + (size_t)(kb + k) * 12288);
#pragma unroll
            for (int r = 0; r < 5; ++r) { const float s = sl[r * 2048 + kb + k]; acc0[r] += s * wv.x; acc1[r] += s * wv.y; } }
        if (lane < 48) {
#pragma unroll
            for (int r = 0; r < 5; ++r) { part[(wave * 5 + r) * 96 + 2 * lane] = acc0[r]; part[(wave * 5 + r) * 96 + 2 * lane + 1] = acc1[r]; } }
        __syncthreads();
        const float* ab = (const float*)a.in[5] + (size_t)l * 12288 + n0;
        for (int i = tid; i < 480; i += NTHR) { const int r = i / 96, c = i - r * 96; float s = 0.f;
#pragma unroll
            for (int w = 0; w < 8; ++w) s += part[(w * 5 + r) * 96 + c];
            mod[(size_t)(l * 5 + r) * 12288 + n0 + c] = s + ab[c]; }
        __syncthreads();
    }
    if (bid == nblk - 1) {
        f32x2* tab = (f32x2*)(a.ws + OFF_ROPE);
        for (int i = tid; i < 1024; i += NTHR) { const int pos = i >> 4, f = i & 15; const float inv = powf(10000.f, -(float)f * 0.0625f); const float ang = (float)pos * inv;
            f32x2 cs; cs.x = cosf(ang); cs.y = sinf(ang); tab[i] = cs; }
    }
}
__device__ __forceinline__ void ph_l0_weights(const Args& a, LAS unsigned char* L) {
    const int tid = threadIdx.x, lane = tid & 63, wave = tid >> 6, bid = blockIdx.x, nblk = gridDim.x;
    { u32x4* z = (u32x4*)(a.ws + WT_ABIN + (size_t)4800 * DM * 2); const u32x4 zero = {0u, 0u, 0u, 0u};
      for (int i = bid * NTHR + tid; i < 64 * DM * 2 / 16; i += nblk * NTHR) z[i] = zero; }
    LAS float* scr = (LAS float*)(L + wave * 16384);
    const int gw = bid * 8 + wave, NGW = nblk * 8;
    constexpr int I0 = 32 * 150, I1 = 32 * 64, I2 = 32 * 256, I3 = 128 * 64;
    constexpr int NITEMS = I0 + I1 + I2 + I3;
    for (int it = gw; it < NITEMS; it += NGW) {
        int r = it;
        if (r < I0) { p0_transpose_item((const float*)a.in[9], 2048, 4800, WS_BF(WT_ABIN), scr, r, lane); continue; } r -= I0;
        if (r < I1) { p0_transpose_item((const float*)a.in[10], 2048, 2048, WS_BF(WT_ABOUT), scr, r, lane); continue; } r -= I1;
        if (r < I2) { p0_transpose_item((const float*)a.in[6], 2048, 8192, WS_BF(WT_W1_0), scr, r, lane); continue; } r -= I2;
        p0_transpose_item((const float*)a.in[7], 8192, 2048, WS_BF(WT_W2_0), scr, r, lane);
    }
}
__device__ __forceinline__ void ph_l1_weights(const Args& a, LAS unsigned char* L, int ws, int nw) {
    const int lane = threadIdx.x & 63, gw = blockIdx.x * nw + ws, NGW = gridDim.x * nw;
    LAS float* scr = (LAS float*)(L + 65536 + ws * 10240);
    constexpr int I1 = 32 * 64, I2 = 32 * 256, I3 = 128 * 64;
    constexpr int NITEMS = I2 + I1 + I2 + I3;
    for (int it = gw; it < NITEMS; it += NGW) {
        int r = it;
        if (r < I2) { p0_transpose_item<true>((const float*)a.in[23], 2048, 8192, WS_BF(WT_CDIN), scr, r, lane); continue; } r -= I2;
        if (r < I1) { p0_transpose_item((const float*)a.in[24], 2048, 2048, WS_BF(WT_CDOUT), scr, r, lane); continue; } r -= I1;
        if (r < I2) { p0_transpose_item((const float*)a.in[6] + (size_t)2048 * 8192, 2048, 8192, WS_BF(WT_W1_1), scr, r, lane); continue; } r -= I2;
        p0_transpose_item((const float*)a.in[7] + (size_t)8192 * 2048, 8192, 2048, WS_BF(WT_W2_1), scr, r, lane);
    }
}

__device__ __forceinline__ float bfu(const bf16_t* p) { return __uint_as_float((unsigned)*p << 16); }
__device__ __forceinline__ f32x4 bf4(const bf16_t* p) { const u32x2 w = *(const u32x2*)p; return (f32x4){__uint_as_float(w.x << 16), __uint_as_float(w.x & 0xffff0000u), __uint_as_float(w.y << 16), __uint_as_float(w.y & 0xffff0000u)}; }
__device__ __forceinline__ void ph_modulate(const float* srcL, float* srcC, int nrows, const float* modl, int ish, int isc, bf16_t* HN,
                                            const bf16_t* comb = nullptr, const float* combBase = nullptr, const float* combGate = nullptr) {
    const int tid = threadIdx.x, lane = tid & 63, wave = tid >> 6, gw = blockIdx.x * 8 + wave, NGW = gridDim.x * 8;
    for (int m = gw; m < nrows; m += NGW) {
        const float* xr = (m < 8192 ? srcL + (size_t)m * 2048 : srcC + (size_t)(m - 8192) * 2048) + 4 * lane;
        const int rg = m < 8192 ? (m >> 11) : 4;
        const float* sh = modl + (size_t)rg * 12288 + ish * 2048 + 4 * lane; const float* sc = modl + (size_t)rg * 12288 + isc * 2048 + 4 * lane;
        f32x4 v[8]; float ss = 0.f;
        if (comb != nullptr && m >= 8192) {
            const size_t so = (size_t)(m - 8192) * 2048 + 4 * lane;
#pragma unroll
            for (int j = 0; j < 8; ++j) { f32x4 s = bf4(comb + so + 256 * j);
#pragma unroll
                for (int k = 1; k < 8; ++k) s = s + bf4(comb + (size_t)k * MC * DM + so + 256 * j);
                v[j] = *(const f32x4*)(combBase + so + 256 * j) + *(const f32x4*)(combGate + 4 * lane + 256 * j) * s;
                *(f32x4*)(srcC + so + 256 * j) = v[j]; }
        } else {
#pragma unroll
            for (int j = 0; j < 8; ++j) v[j] = *(const f32x4*)(xr + 256 * j);
        }
#pragma unroll
        for (int j = 0; j < 8; ++j) ss += (v[j].x * v[j].x + v[j].y * v[j].y) + (v[j].z * v[j].z + v[j].w * v[j].w);
        const float rstd = rsqrtf(wave_sum(ss) * (1.f / 2048.f) + 1e-6f);
        bf16_t* op = HN + (size_t)m * 2048 + 4 * lane;
#pragma unroll
        for (int j = 0; j < 8; ++j) { const f32x4 s4 = *(const f32x4*)(sc + 256 * j), h4 = *(const f32x4*)(sh + 256 * j);
            const f32x4 o = v[j] * rstd * (s4 + 1.f) + h4; u32x2 w; w.x = pk2(o.x, o.y); w.y = pk2(o.z, o.w); *(u32x2*)(op + 256 * j) = w; }
    }
}

__device__ __forceinline__ void ph_final(const Args& a) {
    const int tid = threadIdx.x, lane = tid & 63, wave = tid >> 6, gw = blockIdx.x * 8 + wave, NGW = gridDim.x * 8;
    const float* fn = (const float*)a.in[8] + 4 * lane;
    for (int m = gw; m < ML; m += NGW) {
        float* xr = a.out + (size_t)m * 2048 + 4 * lane;
        f32x4 v[8]; float ss = 0.f;
#pragma unroll
        for (int j = 0; j < 8; ++j) { v[j] = *(const f32x4*)(xr + 256 * j); ss += (v[j].x * v[j].x + v[j].y * v[j].y) + (v[j].z * v[j].z + v[j].w * v[j].w); }
        const float rstd = rsqrtf(wave_sum(ss) * (1.f / 2048.f) + 1e-6f);
#pragma unroll
        for (int j = 0; j < 8; ++j) { const f32x4 w4 = *(const f32x4*)(fn + 256 * j); *(f32x4*)(xr + 256 * j) = v[j] * rstd * w4; }
    }
}

struct CpIn { float wv[16], rv[16], kv[16], av[16], bv[16]; };
__device__ __forceinline__ void chunk_prep_load(const Args& a, CpIn& in, int d, int b, int h, int TBi);
template <bool NEXT> __device__ __forceinline__ void chunk_prep_problem(const Args& a, LAS unsigned char* L, CpIn& in, int d, int b, int h, int TBi, int nb, int nTBi);
__device__ __forceinline__ float shifted(const bf16_t* U, int m, int col, int seq_lo, int seq_hi, float mu) {
    const float uc = bfu(U + (size_t)m * ABINP + col);
    const float up = m > seq_lo ? bfu(U + (size_t)(m - 1) * ABINP + col) : 0.f;
    const float un = m + 1 < seq_hi ? bfu(U + (size_t)(m + 1) * ABINP + col) : 0.f;
    return uc + mu * (0.5f * (up + un) - uc);
}
__device__ __forceinline__ void ph_rwkv_prep(const Args& a, LAS unsigned char* L) {
    const int tid = threadIdx.x, lane = tid & 63, wave = tid >> 6, bid = blockIdx.x, nblk = gridDim.x;
    const bf16_t* U = AR_BF(A_U0);
    const float* mu = (const float*)a.in[11];
    const float* w0 = (const float*)a.in[12]; const float* w_up = (const float*)a.in[13]; const float* a0 = (const float*)a.in[14];
    const float* a_up = (const float*)a.in[15]; const float* g_up = (const float*)a.in[16]; const float* k_k = (const float*)a.in[17];
    const float* k_a = (const float*)a.in[18]; const float* r_k = (const float*)a.in[19];
    float* PWF = AR_F32(A_PREP); float* PWB = PWF + (size_t)MT * 1024; float* PR = PWB + (size_t)MT * 1024;
    float* PA = PR + (size_t)MT * 1024; float* PB = PA + (size_t)MT * 1024; float* PK = PB + (size_t)MT * 1024; float* PV = PK + (size_t)MT * 1024;
    bf16_t* PG = (bf16_t*)((unsigned char*)a.out + DO_G); float* SCAL = (float*)((unsigned char*)a.out + DO_SCAL);
    LAS float* lowr = (LAS float*)L;
    LAS float* res = lowr + 32 * 196;
    const int slab = bid & 7, q = tid >> 7, cl = tid & 127, c = slab * 128 + cl;
    const int qw = wave >> 1, chw = slab * 128 + (wave & 1) * 64, fr_ = lane & 15, g_ = lane >> 4;
    const float* wsrc = qw == 0 ? w_up : (qw == 1 ? w_up + 64 * 1024 : (qw == 2 ? a_up : g_up));
    bf16x8 wh[4][2], wl[4][2];
#pragma unroll
    for (int nt = 0; nt < 4; ++nt)
#pragma unroll
        for (int ks = 0; ks < 2; ++ks)
#pragma unroll
            for (int e = 0; e < 8; ++e) { const float wv = wsrc[(size_t)(32 * ks + 8 * g_ + e) * 1024 + chw + 16 * nt + fr_];
                const unsigned hb = f2bf(wv); const float hf = __uint_as_float(hb << 16); wh[nt][ks][e] = (short)hb; wl[nt][ks][e] = (short)f2bf(wv - hf); }
    const float mu_r = mu[c], mu_k = mu[1024 + c], mu_v = mu[2048 + c];
    const float w0f = w0[c], w0b = w0[1024 + c], a0c = a0[c], kkc = k_k[c], kac = k_a[c], rkc = r_k[c];
    const int ivw = qw < 2 ? 0 : qw - 1;
    DS_INIT();
    for (int tile = bid >> 3; tile < MT / 32; tile += (nblk >> 3)) {
        const int m0 = tile * 32; DS(0);
        const int seq_lo = m0 < 8192 ? (m0 & ~2047) : 8192 + ((m0 - 8192) & ~255);
        const int seq_hi = m0 < 8192 ? seq_lo + 2048 : seq_lo + 256;
        {
          f32x4 uc[3], up[3], un[3]; const f32x4 z4 = {0.f, 0.f, 0.f, 0.f};
#pragma unroll
          for (int e = 0; e < 3; ++e) { const int idx = tid + NTHR * e, tt = idx / 48, jq = idx - tt * 48, m = m0 + tt; const bf16_t* p = U + (size_t)m * ABINP + 3072 + 4 * jq;
              uc[e] = bf4(p); up[e] = m > seq_lo ? bf4(p - ABINP) : z4; un[e] = m + 1 < seq_hi ? bf4(p + ABINP) : z4; }
#pragma unroll
          for (int e = 0; e < 3; ++e) { const int idx = tid + NTHR * e, tt = idx / 48, jq = idx - tt * 48, j = 4 * jq;
              const f32x4 mu4 = *(const f32x4*)(mu + 3072 + j); const f32x4 us = uc[e] + mu4 * ((up[e] + un[e]) * 0.5f - uc[e]); f32x4 o;
#pragma unroll
              for (int q4 = 0; q4 < 4; ++q4) o[q4] = j < 64 ? tanhf(us[q4]) : (j < 128 ? us[q4] : 1.f / (1.f + __expf(-us[q4])));
              *(LAS f32x4*)(lowr + tt * 196 + j) = o; } }
        __syncthreads(); DS(1);
#pragma unroll
        for (int mt = 0; mt < 2; ++mt) { f32x4 acc4[4];
#pragma unroll
            for (int nt = 0; nt < 4; ++nt) acc4[nt] = (f32x4){0.f, 0.f, 0.f, 0.f};
#pragma unroll
            for (int ks = 0; ks < 2; ++ks) { const LAS float* xp = lowr + (mt * 16 + fr_) * 196 + ivw * 64 + 32 * ks + 8 * g_;
                const f32x4 x0 = *(const LAS f32x4*)xp, x1 = *(const LAS f32x4*)(xp + 4); const float xs[8] = {x0.x, x0.y, x0.z, x0.w, x1.x, x1.y, x1.z, x1.w};
                bf16x8 xh, xl;
#pragma unroll
                for (int e = 0; e < 8; ++e) { const unsigned hb = f2bf(xs[e]); xh[e] = (short)hb; xl[e] = (short)f2bf(xs[e] - __uint_as_float(hb << 16)); }
#pragma unroll
                for (int nt = 0; nt < 4; ++nt) { acc4[nt] = __builtin_amdgcn_mfma_f32_16x16x32_bf16(xh, wh[nt][ks], acc4[nt], 0, 0, 0);
                    acc4[nt] = __builtin_amdgcn_mfma_f32_16x16x32_bf16(xh, wl[nt][ks], acc4[nt], 0, 0, 0); acc4[nt] = __builtin_amdgcn_mfma_f32_16x16x32_bf16(xl, wh[nt][ks], acc4[nt], 0, 0, 0); } }
#pragma unroll
            for (int nt = 0; nt < 4; ++nt)
#pragma unroll
                for (int r = 0; r < 4; ++r) res[(qw * 32 + mt * 16 + 4 * g_ + r) * 128 + (wave & 1) * 64 + 16 * nt + fr_] = acc4[nt][r]; }
        __syncthreads(); DS(2);
        const int h = c >> 6;
        { const int cq = tid & 31, c4 = slab * 128 + 4 * cq, hq = c4 >> 6;
          const f32x4 z4 = {0.f, 0.f, 0.f, 0.f};
          u32x2 raw[9], rawn[9];
#define PB_LOAD(R, i_) do { const int m_ = m0 + (tid >> 5) + 16 * (i_); const bf16_t* p_ = U + (size_t)m_ * ABINP + c4; const bool hp_ = m_ > seq_lo, hn_ = m_ + 1 < seq_hi; const u32x2 z2_ = {0u, 0u}; \
              _Pragma("unroll") for (int q_ = 0; q_ < 3; ++q_) { R[q_] = *(const u32x2*)(p_ + 1024 * q_); R[3 + q_] = hp_ ? *(const u32x2*)(p_ + 1024 * q_ - ABINP) : z2_; R[6 + q_] = hn_ ? *(const u32x2*)(p_ + 1024 * q_ + ABINP) : z2_; } } while (0)
#define PB_F4(w_) ((f32x4){__uint_as_float((w_).x << 16), __uint_as_float((w_).x & 0xffff0000u), __uint_as_float((w_).y << 16), __uint_as_float((w_).y & 0xffff0000u)})
          PB_LOAD(raw, 0);
#pragma unroll 1
          for (int i = 0; i < 2; ++i) { const int tt = (tid >> 5) + 16 * i, m = m0 + tt;
              if (i == 0) PB_LOAD(rawn, 1);
              const f32x4 rc_ = PB_F4(raw[0]), kc_ = PB_F4(raw[1]), vc_ = PB_F4(raw[2]);
              const f32x4 rp_ = PB_F4(raw[3]), kp2_ = PB_F4(raw[4]), vp_ = PB_F4(raw[5]);
              const f32x4 rn_ = PB_F4(raw[6]), kn_ = PB_F4(raw[7]), vn_ = PB_F4(raw[8]);
#pragma unroll
              for (int q_ = 0; q_ < 9; ++q_) raw[q_] = rawn[q_];
              const f32x4 mur4 = *(const f32x4*)(mu + c4), muk4 = *(const f32x4*)(mu + 1024 + c4), muv4 = *(const f32x4*)(mu + 2048 + c4);
              const f32x4 w0f4 = *(const f32x4*)(w0 + c4), w0b4 = *(const f32x4*)(w0 + 1024 + c4), a04 = *(const f32x4*)(a0 + c4), kk4 = *(const f32x4*)(k_k + c4), ka4 = *(const f32x4*)(k_a + c4), rk4 = *(const f32x4*)(r_k + c4);
              const f32x4 r = rc_ + mur4 * ((rp_ + rn_) * 0.5f - rc_), k = kc_ + muk4 * ((kp2_ + kn_) * 0.5f - kc_), v = vc_ + muv4 * ((vp_ + vn_) * 0.5f - vc_);
              const f32x4 pwf = w0f4 + *(const LAS f32x4*)(res + (0 * 32 + tt) * 128 + 4 * cq), pwb = w0b4 + *(const LAS f32x4*)(res + (1 * 32 + tt) * 128 + 4 * cq);
              const f32x4 pal = a04 + *(const LAS f32x4*)(res + (2 * 32 + tt) * 128 + 4 * cq), g4 = *(const LAS f32x4*)(res + (3 * 32 + tt) * 128 + 4 * cq);
              f32x4 decf, decb, alr;
#pragma unroll
              for (int e2 = 0; e2 < 4; ++e2) { decf[e2] = 1.f / (1.f + __expf(-pwf[e2])); decb[e2] = 1.f / (1.f + __expf(-pwb[e2])); alr[e2] = 1.f / (1.f + __expf(-pal[e2])); }
              const f32x4 kkr = k * kk4; const float ssq = row16_sum((kkr.x * kkr.x + kkr.y * kkr.y) + (kkr.z * kkr.z + kkr.w * kkr.w));
              const f32x4 kk = kkr * (1.f / fmaxf(sqrtf(ssq), 1e-12f));
              const f32x4 kp = k * ((alr - 1.f) * ka4 + 1.f), ap = -kk, bp = kk * alr;
              const f32x4 t1 = bp * r, t2 = kp * r, t3 = t2 * rk4;
              const float br = row16_sum((t1.x + t1.y) + (t1.z + t1.w)), kr = row16_sum((t2.x + t2.y) + (t2.z + t2.w)), rkr = row16_sum((t3.x + t3.y) + (t3.z + t3.w));
              const size_t o = (size_t)m * 1024 + c4;
              { u32x2 w; const f32x4 qf = decf * 65535.f + 0.5f, qb = decb * 65535.f + 0.5f;
                w.x = (unsigned)qf.x | ((unsigned)qf.y << 16); w.y = (unsigned)qf.z | ((unsigned)qf.w << 16); *(u32x2*)((unsigned short*)PWF + o) = w;
                w.x = (unsigned)qb.x | ((unsigned)qb.y << 16); w.y = (unsigned)qb.z | ((unsigned)qb.w << 16); *(u32x2*)((unsigned short*)PWB + o) = w;
                w.x = pk2(v.x, v.y); w.y = pk2(v.z, v.w); *(u32x2*)((bf16_t*)PV + o) = w; }
              { u32x2 w; w.x = pk2(r.x, r.y); w.y = pk2(r.z, r.w); *(u32x2*)((bf16_t*)PR + o) = w; w.x = pk2(ap.x, ap.y); w.y = pk2(ap.z, ap.w); *(u32x2*)((bf16_t*)PA + o) = w;
                w.x = pk2(bp.x, bp.y); w.y = pk2(bp.z, bp.w); *(u32x2*)((bf16_t*)PB + o) = w; w.x = pk2(kp.x, kp.y); w.y = pk2(kp.z, kp.w); *(u32x2*)((bf16_t*)PK + o) = w; }
              { u32x2 w; w.x = pk2(g4.x, g4.y); w.y = pk2(g4.z, g4.w); *(u32x2*)(PG + o) = w; }
              if ((cq & 15) == 0) { f32x4 s4; s4.x = br; s4.y = kr; s4.z = rkr; s4.w = 0.f; *(f32x4*)(SCAL + ((size_t)m * 16 + hq) * 4) = s4; } }
#undef PB_LOAD
#undef PB_F4
        }
        __syncthreads(); DS(3);
    }
    { const int hh = slab * 2 + (wave & 1), d_ = wave >> 2, tbo = (wave >> 1) & 1, tstep = nblk >> 3;
      auto tile_b = [&](int tile) { const int m0 = tile * 32; return m0 < 8192 ? (m0 >> 11) : ((m0 - 8192) >> 8); };
      auto tile_tb = [&](int tile) { const int m0 = tile * 32; return m0 < 8192 ? 16 + (((m0 & 2047) >> 4) + tbo) : (((m0 - 8192) & 255) >> 4) + tbo; };
      CpIn cin; int tile = bid >> 3;
      if (tile < MT / 32) chunk_prep_load(a, cin, d_, tile_b(tile), hh, tile_tb(tile));
      for (; tile < MT / 32; tile += tstep) {
          if (tile + tstep < MT / 32) chunk_prep_problem<true>(a, L, cin, d_, tile_b(tile), hh, tile_tb(tile), tile_b(tile + tstep), tile_tb(tile + tstep));
          else chunk_prep_problem<false>(a, L, cin, d_, tile_b(tile), hh, tile_tb(tile), 0, 0); } }
    __syncthreads(); DS(4);
    const f32x2* tab = (const f32x2*)(a.ws + OFF_ROPE);
    bf16_t* SQ = (bf16_t*)((unsigned char*)a.out + DO_SQ); bf16_t* SK = (bf16_t*)((unsigned char*)a.out + DO_SK); bf16_t* SV = (bf16_t*)((unsigned char*)a.out + DO_SV);
    const int gw = bid * 8 + wave, NGW = nblk * 8;
    for (int m = gw; m < MT; m += NGW) {
        const bf16_t* ur = U + (size_t)m * ABINP; const bool lat = m < 8192; const int t = m & 2047, prow = t >> 6, pcol = t & 63;
        float x1[10], x2[10];
#pragma unroll
        for (int i = 0; i < 10; ++i) { const int p = lane + 64 * i, hd = p >> 5, ii = p & 31; const int base = hd < 16 ? 3264 + hd * 64 : 4288 + (hd - 16) * 64;
            x1[i] = bfu(ur + base + ii); x2[i] = bfu(ur + base + 32 + ii); }
        const u32x2 vraw = *(const u32x2*)(ur + 4544 + 4 * lane);
#pragma unroll
        for (int i = 0; i < 10; ++i) { const int p = lane + 64 * i, hd = p >> 5, ii = p & 31;
            float o1 = x1[i], o2 = x2[i];
            if (lat) { const f32x2 cs = tab[(ii < 16 ? prow : pcol) * 16 + (ii & 15)]; o1 = x1[i] * cs.x - x2[i] * cs.y; o2 = x1[i] * cs.y + x2[i] * cs.x; }
            bf16_t* dst = hd < 16 ? SQ + (size_t)m * 1024 + hd * 64 : SK + (size_t)m * 256 + (hd - 16) * 64;
            dst[ii] = (bf16_t)f2bf(o1); dst[32 + ii] = (bf16_t)f2bf(o2); }
        *(u32x2*)(SV + (size_t)m * 256 + 4 * lane) = vraw;
    }
    DS(6);
}

constexpr int OP_AT = 0, OP_RT = 2048, OP_BT = 4096, OP_KT = 6144, OP_G1T = 8192, OP_MBRT = 8704, OP_MKRT = 9216, OP_PL = 9728;
__device__ __forceinline__ void chunk_prep_load(const Args& a, CpIn& in, int d, int b, int h, int TBi) {
    const int lane = threadIdx.x & 63;
    const float* P0 = AR_F32(A_PREP);
    const int base = TBi < 16 ? 8192 + b * 256 + 16 * TBi : b * 2048 + 16 * (TBi - 16);
    const unsigned short* pw = (const unsigned short*)(P0 + (size_t)(d ? 1 : 0) * MT * 1024) + h * 64 + lane; const bf16_t* pr = (const bf16_t*)(P0 + (size_t)2 * MT * 1024) + h * 64 + lane;
    const bf16_t* pa = (const bf16_t*)(P0 + (size_t)3 * MT * 1024) + h * 64 + lane; const bf16_t* pb = (const bf16_t*)(P0 + (size_t)4 * MT * 1024) + h * 64 + lane; const bf16_t* pk = (const bf16_t*)(P0 + (size_t)5 * MT * 1024) + h * 64 + lane;
#pragma unroll
    for (int j = 0; j < 16; ++j) { const size_t mo = (size_t)(base + (d ? 15 - j : j)) * 1024;
        in.wv[j] = (float)pw[mo]; in.rv[j] = bfu(pr + mo); in.kv[j] = bfu(pk + mo); in.av[j] = bfu(pa + mo); in.bv[j] = bfu(pb + mo); }
}
template <bool NEXT>
__device__ __forceinline__ void chunk_prep_problem(const Args& a, LAS unsigned char* L, CpIn& in, int d, int b, int h, int TBi, int nb, int nTBi) {
    const int tid = threadIdx.x, lane = tid & 63, wave = tid >> 6, fr = lane & 15, g = lane >> 4;
    unsigned char* OPS = a.ws + OFF_ARENA + A_OPS;
    LAS bf16_t* Abf = (LAS bf16_t*)(L + wave * 13312); LAS bf16_t* Rbf = Abf + 16 * 72; LAS bf16_t* Bbf = Rbf + 16 * 72; LAS bf16_t* Kbf = Bbf + 16 * 72;
    LAS bf16_t* ATr = Kbf + 16 * 72;
    LAS float* NabL = (LAS float*)(ATr + 64 * 16);
    LAS bf16_t* NakL = (LAS bf16_t*)(NabL + 256);
    LAS bf16_t* TT = NakL + 256;
    const bf16x8 zero8 = {0, 0, 0, 0, 0, 0, 0, 0};
    {
        const int chain = d * 64 + b * 16 + h;
        const int c = TBi < 16 ? (d ? 15 - TBi : TBi) : 16 + (d ? 127 - (TBi - 16) : TBi - 16);
        unsigned char* op = OPS + (size_t)(chain * 144 + c) * OPSZ;
        float P = 1.f; unsigned apk[8], bpk[8], kpk[8];
        {
#pragma unroll
            for (int j = 0; j < 16; ++j) { const float Pp = P; P *= __expf(in.wv[j] * (-0.6065306597126334f / 65535.f)); const float inv = 1.f / P;
                const unsigned ah = f2bf(in.av[j] * Pp), rh = f2bf(in.rv[j] * P), bh_ = f2bf(in.bv[j] * inv), kh = f2bf(in.kv[j] * inv);
                Abf[j * 72 + lane] = (bf16_t)ah; Rbf[j * 72 + lane] = (bf16_t)rh; Bbf[j * 72 + lane] = (bf16_t)bh_; Kbf[j * 72 + lane] = (bf16_t)kh;
                ((bf16_t*)(op + OP_RT))[j * 64 + lane] = (bf16_t)rh;
                if (j & 1) { apk[j >> 1] |= ah << 16; bpk[j >> 1] |= bh_ << 16; kpk[j >> 1] |= kh << 16; } else { apk[j >> 1] = ah; bpk[j >> 1] = bh_; kpk[j >> 1] = kh; } } }
        *(LAS u32x4*)(ATr + lane * 16) = (u32x4){apk[0], apk[1], apk[2], apk[3]}; *(LAS u32x4*)(ATr + lane * 16 + 8) = (u32x4){apk[4], apk[5], apk[6], apk[7]};
        *(u32x4*)(op + OP_BT + lane * 32) = (u32x4){bpk[0], bpk[1], bpk[2], bpk[3]}; *(u32x4*)(op + OP_BT + lane * 32 + 16) = (u32x4){bpk[4], bpk[5], bpk[6], bpk[7]};
        *(u32x4*)(op + OP_KT + lane * 32) = (u32x4){kpk[0], kpk[1], kpk[2], kpk[3]}; *(u32x4*)(op + OP_KT + lane * 32 + 16) = (u32x4){kpk[4], kpk[5], kpk[6], kpk[7]};
        ((float*)(op + OP_PL))[lane] = P;
        if (NEXT) chunk_prep_load(a, in, d, nb, h, nTBi);
        f32x4 nab = {0.f, 0.f, 0.f, 0.f}, nak = nab, mbr = nab, mkr = nab;
#pragma unroll
        for (int ks = 0; ks < 2; ++ks) { const int o = fr * 72 + 32 * ks + 8 * g;
            const bf16x8 fb = *(const LAS bf16x8*)(Bbf + o), fk = *(const LAS bf16x8*)(Kbf + o), fa = *(const LAS bf16x8*)(Abf + o), frr = *(const LAS bf16x8*)(Rbf + o);
            nab = __builtin_amdgcn_mfma_f32_16x16x32_bf16(fb, fa, nab, 0, 0, 0); nak = __builtin_amdgcn_mfma_f32_16x16x32_bf16(fk, fa, nak, 0, 0, 0);
            mbr = __builtin_amdgcn_mfma_f32_16x16x32_bf16(fb, frr, mbr, 0, 0, 0); mkr = __builtin_amdgcn_mfma_f32_16x16x32_bf16(fk, frr, mkr, 0, 0, 0); }
#pragma unroll
        for (int r = 0; r < 4; ++r) { const int j = 4 * g + r; if (!(j < fr)) { nab[r] = 0.f; nak[r] = 0.f; } if (!(j <= fr)) { mbr[r] = 0.f; mkr[r] = 0.f; }
            NabL[j * 16 + fr] = nab[r]; NakL[j * 16 + fr] = (bf16_t)f2bf(nak[r]); }
        { u32x2 w; w.x = pk2(mbr[0], mbr[1]); w.y = pk2(mbr[2], mbr[3]); *(u32x2*)(op + OP_MBRT + (fr * 16 + 4 * g) * 2) = w;
          w.x = pk2(mkr[0], mkr[1]); w.y = pk2(mkr[2], mkr[3]); *(u32x2*)(op + OP_MKRT + (fr * 16 + 4 * g) * 2) = w; }
        { float Tr[16];
#pragma unroll
          for (int t = 0; t < 16; ++t) { float acc = fr == t ? 1.f : 0.f;
#pragma unroll
              for (int j = 0; j < t; ++j) acc += Tr[j] * NabL[j * 16 + t];
              Tr[t] = acc; }
#pragma unroll
          for (int t = 0; t < 16; ++t) TT[t * 16 + fr] = (bf16_t)f2bf(Tr[t]); }
        { const bf16x8 tf = g < 2 ? *(const LAS bf16x8*)(TT + fr * 16 + 8 * g) : zero8;
#pragma unroll
          for (int nt = 0; nt < 4; ++nt) { const bf16x8 af = g < 2 ? *(const LAS bf16x8*)(ATr + (16 * nt + fr) * 16 + 8 * g) : zero8;
              const f32x4 at = __builtin_amdgcn_mfma_f32_16x16x32_bf16(tf, af, (f32x4){0.f, 0.f, 0.f, 0.f}, 0, 0, 0);
#pragma unroll
              for (int r = 0; r < 4; ++r) ((bf16_t*)(op + OP_AT))[(4 * g + r) * 64 + 16 * nt + fr] = (bf16_t)f2bf(at[r]); }
          const bf16x8 nf = g < 2 ? *(const LAS bf16x8*)(NakL + fr * 16 + 8 * g) : zero8;
          const f32x4 g1 = __builtin_amdgcn_mfma_f32_16x16x32_bf16(tf, nf, (f32x4){0.f, 0.f, 0.f, 0.f}, 0, 0, 0);
#pragma unroll
          for (int r = 0; r < 4; ++r) ((bf16_t*)(op + OP_G1T))[(4 * g + r) * 16 + fr] = (bf16_t)f2bf(g1[r]); }
    }
}

__device__ __forceinline__ int chunk_row0(int c, int d, int b) { return c < 16 ? 8192 + b * 256 + (d ? 255 - 16 * c : 16 * c) : b * 2048 + (d ? 2047 - 16 * (c - 16) : 16 * (c - 16)); }
__device__ __forceinline__ int scan_row(int gs, int d, int b) {
    if (gs < 256) { const int t = d ? 255 - gs : gs; return 8192 + b * 256 + t; }
    const int t2 = gs - 256; const int t = d ? 2047 - t2 : t2; return b * 2048 + t;
}
__device__ __forceinline__ void rwkv_scan_chain(const Args& a, LAS unsigned char* L, int unit) {
    const int tid = threadIdx.x, lane = tid & 63, wave = tid >> 6, fr = lane & 15, g = lane >> 4;
    if (wave >= 2) { ph_l1_weights(a, L, wave - 2, 6); return; }
    const int chain = unit >> 1, d = chain >> 6, b = (chain >> 4) & 3, h = chain & 15;
    const int v0 = 16 * (2 * (unit & 1) + wave);
    const unsigned char* OPS = a.ws + OFF_ARENA + A_OPS + (size_t)chain * 144 * OPSZ;
    const bf16_t* PV = (const bf16_t*)(AR_F32(A_PREP) + (size_t)6 * MT * 1024) + h * 64 + v0 + fr;
    float* Y = AR_F32(d ? A_YB : A_YF) + h * 64 + v0 + fr;
    const int sgn = d ? -1 : 1;
    f32x4 sacc[4];
#pragma unroll
    for (int mt = 0; mt < 4; ++mt) sacc[mt] = (f32x4){0.f, 0.f, 0.f, 0.f};
    LAS unsigned char* Lw = L + wave * 26624;
    int ldo[10];
#pragma unroll
    for (int i = 0; i < 10; ++i) { const int p = lane + 64 * i; int o;
        if (i < 2) o = (p >> 3) * 144 + (p & 7) * 16;
        else if (i < 4) { const int q = p - 128; o = 2304 + (q >> 3) * 144 + (q & 7) * 16; }
        else if (i < 6) { const int q = p - 256; o = 4608 + (q >> 1) * 48 + (q & 1) * 16; }
        else if (i < 8) { const int q = p - 384; o = 7680 + (q >> 1) * 48 + (q & 1) * 16; }
        else if (i == 8) { const int q = p - 512; o = (q < 32 ? 10752 : 11520 - 32 * 24) + (q >> 1) * 48 + (q & 1) * 16; }
        else { const int q = p - 576; o = q < 32 ? 12288 + (q >> 1) * 48 + (q & 1) * 16 : 13056 + (q - 32) * 16; }
        ldo[i] = o; }
    const bool l9 = lane < 48;
#define CS_DECL(P) u32x4 P##s[10]; float P##v[4]
#define CS_LOAD(P, c_) do { const unsigned char* op_ = OPS + (size_t)(c_) * OPSZ + 16 * lane; \
        _Pragma("unroll") for (int i = 0; i < 9; ++i) P##s[i] = *(const u32x4*)(op_ + 1024 * i); \
        if (l9) P##s[9] = *(const u32x4*)(op_ + 9216); \
        { const int r0_ = __builtin_amdgcn_readfirstlane(chunk_row0((c_), d, b)); const bf16_t* pv_ = PV + ((ptrdiff_t)r0_ + sgn * (4 * g)) * 1024; \
          _Pragma("unroll") for (int e = 0; e < 4; ++e) P##v[e] = bfu(pv_ + (ptrdiff_t)sgn * e * 1024); } } while (0)
#define CS_WRITE(P, slot_) do { LAS unsigned char* sl_ = Lw + (slot_) * 13312; \
        _Pragma("unroll") for (int i = 0; i < 9; ++i) *(LAS u32x4*)(sl_ + ldo[i]) = P##s[i]; \
        if (l9) *(LAS u32x4*)(sl_ + ldo[9]) = P##s[9]; } while (0)
#define CS_FRAG(slot_) const LAS unsigned char* fs_ = Lw + (slot_) * 13312; u32x2 Fat[2][2], Frt[2][2], Fg1, Fmb, Fmk, Fbt[4], Fkt[4]; f32x4 Fpl[4]; \
        _Pragma("unroll") for (int ks = 0; ks < 2; ++ks) _Pragma("unroll") for (int j = 0; j < 2; ++j) { Fat[ks][j] = *(const LAS u32x2*)(fs_ + fr * 144 + (32 * ks + 16 * j + 4 * g) * 2); Frt[ks][j] = *(const LAS u32x2*)(fs_ + 2304 + fr * 144 + (32 * ks + 16 * j + 4 * g) * 2); } \
        Fg1 = *(const LAS u32x2*)(fs_ + 10752 + fr * 48 + 8 * g); Fmb = *(const LAS u32x2*)(fs_ + 11520 + fr * 48 + 8 * g); Fmk = *(const LAS u32x2*)(fs_ + 12288 + fr * 48 + 8 * g); \
        _Pragma("unroll") for (int mt = 0; mt < 4; ++mt) { Fbt[mt] = *(const LAS u32x2*)(fs_ + 4608 + (16 * mt + fr) * 48 + 8 * g); Fkt[mt] = *(const LAS u32x2*)(fs_ + 7680 + (16 * mt + fr) * 48 + 8 * g); \
            Fpl[mt] = *(const LAS f32x4*)(fs_ + 13056 + (16 * mt + 4 * g) * 4); }
#define CS_STEP(P, c_) do { \
        u32x4 sb0, sb1; sb0.x = pk2(sacc[0][0], sacc[0][1]); sb0.y = pk2(sacc[0][2], sacc[0][3]); sb0.z = pk2(sacc[1][0], sacc[1][1]); sb0.w = pk2(sacc[1][2], sacc[1][3]); \
        sb1.x = pk2(sacc[2][0], sacc[2][1]); sb1.y = pk2(sacc[2][2], sacc[2][3]); sb1.z = pk2(sacc[3][0], sacc[3][1]); sb1.w = pk2(sacc[3][2], sacc[3][3]); \
        const bf16x8 sB0 = __builtin_bit_cast(bf16x8, sb0), sB1 = __builtin_bit_cast(bf16x8, sb1); \
        const u32x4 a0_ = {P##at[0][0].x, P##at[0][0].y, P##at[0][1].x, P##at[0][1].y}, a1_ = {P##at[1][0].x, P##at[1][0].y, P##at[1][1].x, P##at[1][1].y}; \
        const u32x4 r0_ = {P##rt[0][0].x, P##rt[0][0].y, P##rt[0][1].x, P##rt[0][1].y}, r1_ = {P##rt[1][0].x, P##rt[1][0].y, P##rt[1][1].x, P##rt[1][1].y}; \
        f32x4 w1 = __builtin_amdgcn_mfma_f32_16x16x32_bf16(__builtin_bit_cast(bf16x8, a0_), sB0, (f32x4){0.f, 0.f, 0.f, 0.f}, 0, 0, 0); \
        w1 = __builtin_amdgcn_mfma_f32_16x16x32_bf16(__builtin_bit_cast(bf16x8, a1_), sB1, w1, 0, 0, 0); \
        f32x4 y1 = __builtin_amdgcn_mfma_f32_16x16x32_bf16(__builtin_bit_cast(bf16x8, r0_), sB0, (f32x4){0.f, 0.f, 0.f, 0.f}, 0, 0, 0); \
        y1 = __builtin_amdgcn_mfma_f32_16x16x32_bf16(__builtin_bit_cast(bf16x8, r1_), sB1, y1, 0, 0, 0); \
        const unsigned vp0 = pk2(P##vv[0], P##vv[1]), vp1 = pk2(P##vv[2], P##vv[3]); \
        const u32x4 gA = {P##g1.x, P##g1.y, 0u, 0u}, vB = {vp0, vp1, 0u, 0u}; \
        const f32x4 u = __builtin_amdgcn_mfma_f32_16x16x32_bf16(__builtin_bit_cast(bf16x8, gA), __builtin_bit_cast(bf16x8, vB), w1, 0, 0, 0); \
        const u32x4 uvB = {pk2(u[0], u[1]), pk2(u[2], u[3]), vp0, vp1}; const u32x4 mA = {P##mb.x, P##mb.y, P##mk.x, P##mk.y}; \
        const f32x4 y = __builtin_amdgcn_mfma_f32_16x16x32_bf16(__builtin_bit_cast(bf16x8, mA), __builtin_bit_cast(bf16x8, uvB), y1, 0, 0, 0); \
        _Pragma("unroll") for (int mt = 0; mt < 4; ++mt) { const u32x4 bA = {P##bt[mt].x, P##bt[mt].y, P##kt[mt].x, P##kt[mt].y}; \
            sacc[mt] = __builtin_amdgcn_mfma_f32_16x16x32_bf16(__builtin_bit_cast(bf16x8, bA), __builtin_bit_cast(bf16x8, uvB), sacc[mt], 0, 0, 0); sacc[mt] = sacc[mt] * P##pl[mt]; } \
        { const int r0_ = __builtin_amdgcn_readfirstlane(chunk_row0((c_), d, b)); float* py_ = Y + ((ptrdiff_t)r0_ + sgn * (4 * g)) * 1024; \
          _Pragma("unroll") for (int r = 0; r < 4; ++r) py_[(ptrdiff_t)sgn * r * 1024] = y[r]; } } while (0)
    CS_DECL(A); CS_DECL(B); float Fvv[4], vnx[4];
    CS_LOAD(A, 0); CS_LOAD(B, 1); CS_WRITE(A, 0);
#pragma unroll
    for (int e = 0; e < 4; ++e) Fvv[e] = Av[e];
    CS_LOAD(A, 2);
#define CS_ITER(P, c_) do { CS_WRITE(P, ((c_) + 1) & 1); _Pragma("unroll") for (int e = 0; e < 4; ++e) vnx[e] = P##v[e]; \
        if ((c_) + 3 < 144) CS_LOAD(P, (c_) + 3); \
        { CS_FRAG((c_) & 1); CS_STEP(F, c_); } \
        _Pragma("unroll") for (int e = 0; e < 4; ++e) Fvv[e] = vnx[e]; } while (0)
    for (int c = 0; c < 144; c += 2) { CS_ITER(B, c); CS_ITER(A, c + 1); }
#undef CS_ITER
#undef CS_WRITE
#undef CS_FRAG
#undef CS_DECL
#undef CS_LOAD
#undef CS_STEP
}

__device__ __forceinline__ void rwkv_post_rows(const Args& a, int m0, int m1) {
    const int tid = threadIdx.x, lane = tid & 63, wave = tid >> 6;
    const float* YF = AR_F32(A_YF); const float* YB = AR_F32(A_YB); const bf16_t* PV = (const bf16_t*)(AR_F32(A_PREP) + (size_t)6 * MT * 1024);
    const bf16_t* PG = (const bf16_t*)((const unsigned char*)a.out + DO_G); const float* SCAL = (const float*)((const unsigned char*)a.out + DO_SCAL); bf16_t* YA = AR_BF(A_YA);
    const float* lnw = (const float*)a.in[20]; const float* lnb = (const float*)a.in[21];
    for (int m = m0 + wave; m < m1; m += 8) {
        f32x4 yf[4], yb[4], pv[4]; u32x2 pg[4]; float rk[4];
#pragma unroll
        for (int q = 0; q < 4; ++q) { const size_t o = (size_t)m * 1024 + 256 * q + 4 * lane;
            yf[q] = *(const f32x4*)(YF + o); yb[q] = *(const f32x4*)(YB + o); pv[q] = bf4(PV + o); pg[q] = *(const u32x2*)(PG + o);
            rk[q] = SCAL[((size_t)m * 16 + 4 * q + (lane >> 4)) * 4 + 2]; }
#pragma unroll
        for (int q = 0; q < 4; ++q) { const int c = 256 * q + 4 * lane; const f32x4 y = yf[q] + yb[q];
            const float mean = row16_sum((y.x + y.y) + (y.z + y.w)) * (1.f / 64.f); const f32x4 dl = y - mean;
            const float var = row16_sum((dl.x * dl.x + dl.y * dl.y) + (dl.z * dl.z + dl.w * dl.w)) * (1.f / 64.f); const float rs = rsqrtf(var + 64e-5f);
            const f32x4 w4 = *(const f32x4*)(lnw + c), b4 = *(const f32x4*)(lnb + c);
            const f32x4 g4 = {__uint_as_float(pg[q].x << 16), __uint_as_float(pg[q].x & 0xffff0000u), __uint_as_float(pg[q].y << 16), __uint_as_float(pg[q].y & 0xffff0000u)};
            const f32x4 o4 = (dl * rs * w4 + b4 + pv[q] * rk[q]) * g4;
            u32x2 w; w.x = pk2(o4.x, o4.y); w.y = pk2(o4.z, o4.w); *(u32x2*)(YA + (size_t)m * 2048 + c) = w; }
    }
}

struct AttnSeg { const bf16_t* K; const bf16_t* V; int n; };
typedef short v4i16_t __attribute__((ext_vector_type(4)));
__device__ __forceinline__ bf16x8 tr_frag(const LAS bf16_t* p0, const LAS bf16_t* p1) {
    const v4i16_t lo = __builtin_amdgcn_ds_read_tr16_b64_v4i16((LAS v4i16_t*)p0), hi = __builtin_amdgcn_ds_read_tr16_b64_v4i16((LAS v4i16_t*)p1);
    return (bf16x8){lo[0], lo[1], lo[2], lo[3], hi[0], hi[1], hi[2], hi[3]};
}
__device__ __forceinline__ float gmax4(float x) {
    { float p = x, q = x; asm volatile("s_nop 1\n\tv_permlane16_swap_b32 %0, %1" : "+v"(p), "+v"(q)); x = fmaxf(p, q); }
    { float p = x, q = x; asm volatile("s_nop 1\n\tv_permlane32_swap_b32 %0, %1" : "+v"(p), "+v"(q)); x = fmaxf(p, q); }
    return x;
}
__device__ __forceinline__ float max3f(float a, float b, float c2) { float r; asm("v_max3_f32 %0, %1, %2, %3" : "=v"(r) : "v"(a), "v"(b), "v"(c2)); return r; }
__device__ __forceinline__ float gsum4(float x) {
    { float p = x, q = x; asm volatile("s_nop 1\n\tv_permlane16_swap_b32 %0, %1" : "+v"(p), "+v"(q)); x = p + q; }
    { float p = x, q = x; asm volatile("s_nop 1\n\tv_permlane32_swap_b32 %0, %1" : "+v"(p), "+v"(q)); x = p + q; }
    return x;
}
template <bool B> struct BoolC { static constexpr bool value = B; };
template <int DV, int NSUB>
__device__ __forceinline__ void attn_unit(LAS unsigned char* L, const bf16_t* Q, int q_stride, AttnSeg sg0, AttnSeg sg1, int k_stride, int v_stride,
                                          bool masked, int qpos0, int kpos0, bool has_sink, float sink, float lmb, const float* subln, float post_scale,
                                          bf16_t* O, int o_stride, unsigned long long* dsp = nullptr) {
    const int tid = threadIdx.x, lane = tid & 63, wave = tid >> 6, fr = lane & 15, g = lane >> 4;
#ifdef MK_DIAG_ATT
    const unsigned long long ds_first_ = __builtin_amdgcn_s_memrealtime();
#endif
    constexpr int KROW = 72, VROW = DV + 8, OROW = DV + 8, KBUF = NSUB * 64 * KROW, VBUF = 64 * VROW;
    LAS bf16_t* Ks = (LAS bf16_t*)L;
    LAS bf16_t* Vs = Ks + 2 * KBUF;
    LAS bf16_t* Ow = Vs + 2 * VBUF + wave * (16 * OROW);
    constexpr bool QLDS = NSUB > 1;
    LAS bf16_t* Qw = Vs + 2 * VBUF + 8 * (16 * OROW) + wave * (NSUB * 2 * 64 * 8);
    bf16x8 qf[NSUB][2];
#pragma unroll
    for (int s = 0; s < NSUB; ++s)
#pragma unroll
        for (int ks = 0; ks < 2; ++ks) { qf[s][ks] = *(const bf16x8*)(Q + (size_t)(wave * 16 + fr) * q_stride + s * 64 + ks * 32 + g * 8);
            if (QLDS) *(LAS bf16x8*)(Qw + ((s * 2 + ks) * 64 + lane) * 8) = qf[s][ks]; }
    f32x4 o[NSUB][DV / 16];
    float mq[NSUB], lq[NSUB];
#pragma unroll
    for (int s = 0; s < NSUB; ++s) {
#pragma unroll
        for (int dt = 0; dt < DV / 16; ++dt) o[s][dt] = (f32x4){0.f, 0.f, 0.f, 0.f};
        mq[s] = has_sink ? sink * 1.4426950408889634f : -INFINITY; lq[s] = (has_sink && g == 0) ? 1.f : 0.f;
    }
    const int nt0 = sg0.n >> 6, T = nt0 + (sg1.n >> 6);
    const int srow = tid >> 3, spc = tid & 7;
    const LAS bf16_t* vtr = Vs + (4 * g + (fr >> 2)) * VROW + 4 * (fr & 3);
    const int qp = qpos0 + wave * 16 + fr;
    u32x4 kregA[NSUB], kregB[NSUB]; u32x4 vregA[DV / 64], vregB[DV / 64];
#define ATT_LOAD(kreg, vreg, t_) do { const int tc_ = (t_) < T ? (t_) : T - 1; const bool in0_ = tc_ < nt0; const int j0_ = (in0_ ? tc_ : tc_ - nt0) * 64; \
        const bf16_t* Kp_ = (in0_ ? sg0.K : sg1.K) + (size_t)(j0_ + srow) * k_stride + spc * 8; const bf16_t* Vp_ = (in0_ ? sg0.V : sg1.V) + (size_t)(j0_ + srow) * v_stride + spc * 8; \
        _Pragma("unroll") for (int s = 0; s < NSUB; ++s) kreg[s] = *(const u32x4*)(Kp_ + s * 64); \
        _Pragma("unroll") for (int p = 0; p < DV / 64; ++p) vreg[p] = *(const u32x4*)(Vp_ + p * 64); } while (0)
#define ATT_WR(kreg, vreg, b_) do { _Pragma("unroll") for (int s = 0; s < NSUB; ++s) *(LAS u32x4*)(Ks + (b_) * KBUF + (s * 64 + srow) * KROW + spc * 8) = kreg[s]; \
        _Pragma("unroll") for (int p = 0; p < DV / 64; ++p) *(LAS u32x4*)(Vs + (b_) * VBUF + srow * VROW + p * 64 + spc * 8) = vreg[p]; } while (0)
    constexpr float C2 = 0.125f * 1.4426950408889634f;
    lds_barrier();
    ATT_LOAD(kregA, vregA, 0); ATT_LOAD(kregB, vregB, 1); ATT_WR(kregA, vregA, 0); ATT_LOAD(kregA, vregA, 2);
    auto iter = [&](const int t, u32x4 (&kreg)[NSUB], u32x4 (&vreg)[DV / 64]) {
        const bool in0 = t < nt0; const int j0 = in0 ? t * 64 : (t - nt0) * 64; const int bsel = t & 1;
        lds_barrier();
        ATT_WR(kreg, vreg, bsel ^ 1);
        ATT_LOAD(kreg, vreg, t + 3);
        const LAS bf16_t* kb_ = Ks + bsel * KBUF; const LAS bf16_t* vb_ = vtr + bsel * VBUF;
        bf16x8 pb[NSUB][2];
        f32x4 scA[NSUB][4];
#pragma unroll
        for (int s = 0; s < NSUB; ++s) {
            bf16x8 qv[2];
#pragma unroll
            for (int ks = 0; ks < 2; ++ks) qv[ks] = QLDS ? *(const LAS bf16x8*)(Qw + ((s * 2 + ks) * 64 + lane) * 8) : qf[s][ks];
#pragma unroll
            for (int np = 0; np < 2; ++np) { bf16x8 kf[2][2];
#pragma unroll
                for (int n2 = 0; n2 < 2; ++n2)
#pragma unroll
                    for (int ks = 0; ks < 2; ++ks) kf[n2][ks] = *(const LAS bf16x8*)(kb_ + (s * 64 + (2 * np + n2) * 16 + fr) * KROW + ks * 32 + g * 8);
#pragma unroll
                for (int n2 = 0; n2 < 2; ++n2) { const int nt = 2 * np + n2; scA[s][nt] = (f32x4){0.f, 0.f, 0.f, 0.f};
#pragma unroll
                    for (int ks = 0; ks < 2; ++ks) scA[s][nt] = __builtin_amdgcn_mfma_f32_16x16x32_bf16(kf[n2][ks], qv[ks], scA[s][nt], 0, 0, 0); } } }
#pragma unroll
        for (int s = 0; s < NSUB; ++s) {
            f32x4 (&sc)[4] = scA[s];
            float mx = -INFINITY;
            if (masked && in0) {
                const int e0 = kpos0 + j0 + 4 * g - qp + 128;
#pragma unroll
                for (int nt = 0; nt < 4; ++nt)
#pragma unroll
                    for (int r = 0; r < 4; ++r) if ((unsigned)(e0 + nt * 16 + r) > 256u) sc[nt][r] = -INFINITY;
            }
#pragma unroll
            for (int nt = 0; nt < 4; ++nt) { mx = max3f(mx, sc[nt][0], sc[nt][1]); mx = max3f(mx, sc[nt][2], sc[nt][3]); }
            const float mn = fmaxf(mq[s], gmax4(mx) * C2);
            if (__any(mn > mq[s])) {
                const float alpha = (mn == -INFINITY) ? 1.f : __builtin_amdgcn_exp2f(mq[s] - mn);
                lq[s] *= alpha;
#pragma unroll
                for (int dt = 0; dt < DV / 16; ++dt) o[s][dt] = o[s][dt] * alpha;
            }
            mq[s] = mn;
            const float nm = (mn == -INFINITY) ? 0.f : -mn;
            float rs = 0.f;
#pragma unroll
            for (int nt = 0; nt < 4; ++nt)
#pragma unroll
                for (int r = 0; r < 4; ++r) { const float p = __builtin_amdgcn_exp2f(fmaf(sc[nt][r], C2, nm)); sc[nt][r] = p; rs += p; }
            lq[s] += rs;
#pragma unroll
            for (int ks = 0; ks < 2; ++ks) { u32x4 w; w.x = pk2(sc[2 * ks][0], sc[2 * ks][1]); w.y = pk2(sc[2 * ks][2], sc[2 * ks][3]); w.z = pk2(sc[2 * ks + 1][0], sc[2 * ks + 1][1]); w.w = pk2(sc[2 * ks + 1][2], sc[2 * ks + 1][3]);
                pb[s][ks] = __builtin_bit_cast(bf16x8, w); }
        }
#pragma unroll
        for (int ks = 0; ks < 2; ++ks)
#pragma unroll
            for (int dh = 0; dh < DV / 64; ++dh) {
                bf16x8 vf[4];
#pragma unroll
                for (int d4 = 0; d4 < 4; ++d4) { const LAS bf16_t* vp = vb_ + (ks * 32) * VROW + (dh * 4 + d4) * 16; vf[d4] = tr_frag(vp, vp + 16 * VROW); }
#pragma unroll
                for (int s = 0; s < NSUB; ++s)
#pragma unroll
                    for (int d4 = 0; d4 < 4; ++d4) o[s][dh * 4 + d4] = __builtin_amdgcn_mfma_f32_16x16x32_bf16(vf[d4], pb[s][ks], o[s][dh * 4 + d4], 0, 0, 0);
            }
    };
    { int t = 0;
      for (; t + 1 < T; t += 2) { iter(t, kregB, vregB); iter(t + 1, kregA, vregA); }
      if (t < T) iter(t, kregB, vregB); }
#undef ATT_LOAD
#undef ATT_WR
    if (NSUB == 1) {
        const float inv = 1.f / gsum4(lq[0]);
#pragma unroll
        for (int dt = 0; dt < DV / 16; ++dt) { u32x2 w; w.x = pk2(o[0][dt][0] * inv, o[0][dt][1] * inv); w.y = pk2(o[0][dt][2] * inv, o[0][dt][3] * inv); *(LAS u32x2*)(Ow + fr * OROW + 16 * dt + 4 * g) = w; }
    } else {
        const float i0 = 1.f / gsum4(lq[0]), i1 = lmb / gsum4(lq[NSUB - 1]); float ss = 0.f;
#pragma unroll
        for (int dt = 0; dt < DV / 16; ++dt)
#pragma unroll
            for (int r = 0; r < 4; ++r) { const float v = o[0][dt][r] * i0 - o[NSUB - 1][dt][r] * i1; o[0][dt][r] = v; ss += v * v; }
        const float rstd = rsqrtf(gsum4(ss) * (1.f / DV) + 1e-5f) * post_scale;
#pragma unroll
        for (int dt = 0; dt < DV / 16; ++dt) { const f32x4 sl = *(const f32x4*)(subln + 16 * dt + 4 * g);
            u32x2 w; w.x = pk2(o[0][dt][0] * rstd * sl.x, o[0][dt][1] * rstd * sl.y); w.y = pk2(o[0][dt][2] * rstd * sl.z, o[0][dt][3] * rstd * sl.w); *(LAS u32x2*)(Ow + fr * OROW + 16 * dt + 4 * g) = w; }
    }
#pragma unroll
    for (int i = 0; i < DV / 32; ++i) { const int pc = lane + 64 * i, row = pc / (DV / 8), ch = pc % (DV / 8);
        const u32x4 v = *(const LAS u32x4*)(Ow + row * OROW + ch * 8); *(u32x4*)(O + (size_t)(wave * 16 + row) * o_stride + ch * 8) = v; }
    __syncthreads();
#ifdef MK_DIAG_ATT
    if (dsp != nullptr && tid == 0) { const unsigned long long n_ = dsp[32 + 15] / 100ull; dsp[32 + 16 + (n_ < 6 ? n_ : 6)] = __builtin_amdgcn_s_memrealtime() - ds_first_; dsp[32 + 14] += __builtin_amdgcn_s_memrealtime() - ds_first_; dsp[32 + 15] += 100ull; }
#endif
}

__device__ __forceinline__ void ph_mix0(const Args& a, LAS unsigned char* L, const int mode) {
    const int bid = blockIdx.x;
    unsigned* ctl = (unsigned*)(a.ws + OFF_CTL);
    constexpr int CW_RDONE = 2048 + 48, CW_SWAQ = 2048 + 64, CW_RPOSTQ = 2048 + 80;
    DS_INIT();
    rwkv_scan_chain(a, L, bid);
    DS(7);
    asm volatile("s_waitcnt vmcnt(0)" ::: "memory");
    __syncthreads();
    if (threadIdx.x == 0) { __builtin_amdgcn_fence(__ATOMIC_RELEASE, "agent"); asm volatile("s_waitcnt vmcnt(0)" ::: "memory");
        (void)__hip_atomic_fetch_add(ctl + CW_RDONE, 1u, __ATOMIC_RELAXED, __HIP_MEMORY_SCOPE_AGENT); }
    volatile LAS unsigned* slot = (volatile LAS unsigned*)(L + LDS_BYTES - 32);
    const bf16_t* SQ = (const bf16_t*)((const unsigned char*)a.out + DO_SQ); const bf16_t* SK = (const bf16_t*)((const unsigned char*)a.out + DO_SK); const bf16_t* SV = (const bf16_t*)((const unsigned char*)a.out + DO_SV); bf16_t* YA = AR_BF(A_YA);
    const float* sinkp = (const float*)a.in[22];
    for (;;) {
        __syncthreads();
        if (threadIdx.x == 0) *slot = atomicAdd(ctl + CW_SWAQ, 1u);
        __syncthreads();
        const int u = (int)*slot;
        if (u >= 1152) break;
        AttnSeg s0, s1; int qrow0, qh, qpos0 = 0, kpos0 = 0; bool masked;
        if (u < 1024) { const int b = u >> 8, qb = u & 15; qh = (u >> 4) & 15; const int kvh = qh >> 2;
            const int ks = qb * 128 - 128 < 0 ? 0 : qb * 128 - 128, ke = qb * 128 + 256 > 2048 ? 2048 : qb * 128 + 256;
            qrow0 = b * 2048 + qb * 128;
            s0.K = SK + (size_t)(b * 2048 + ks) * 256 + kvh * 64; s0.V = SV + (size_t)(b * 2048 + ks) * 256 + kvh * 64; s0.n = ke - ks;
            s1.K = SK + (size_t)(8192 + b * 256) * 256 + kvh * 64; s1.V = SV + (size_t)(8192 + b * 256) * 256 + kvh * 64; s1.n = 256;
            masked = true; qpos0 = qb * 128; kpos0 = ks;
        } else { const int uu = u - 1024, b = uu >> 5, half = uu & 1; qh = (uu >> 1) & 15; const int kvh = qh >> 2;
            qrow0 = 8192 + b * 256 + half * 128;
            s0.K = SK + (size_t)(8192 + b * 256) * 256 + kvh * 64; s0.V = SV + (size_t)(8192 + b * 256) * 256 + kvh * 64; s0.n = 256;
            s1.K = s0.K; s1.V = s0.V; s1.n = 0; masked = false;
        }
        attn_unit<64, 1>(L, SQ + (size_t)qrow0 * 1024 + qh * 64, 1024, s0, s1, 256, 256, masked, qpos0, kpos0, true, sinkp[qh], 0.f, nullptr, 1.f,
                         YA + (size_t)qrow0 * 2048 + 1024 + qh * 64, 2048);
    }
    if (threadIdx.x == 0) { unsigned sp = 0u;
        while (__hip_atomic_load(ctl + CW_RDONE, __ATOMIC_RELAXED, __HIP_MEMORY_SCOPE_AGENT) < (unsigned)gridDim.x && ++sp < (1u << 22)) __builtin_amdgcn_s_sleep(4);
        __builtin_amdgcn_fence(__ATOMIC_ACQUIRE, "agent"); asm volatile("s_waitcnt vmcnt(0)" ::: "memory"); }
    for (;;) {
        __syncthreads();
        if (threadIdx.x == 0) *slot = atomicAdd(ctl + CW_RPOSTQ, 1u);
        __syncthreads();
        const int u = (int)*slot;
        if (u >= MT / 32) break;
        rwkv_post_rows(a, u * 32, u * 32 + 32);
    }
}

constexpr int HOPSZ = 9216, HOP_QT = 0, HOP_KTT = 4096, HOP_ATT = 8192, HOP_EL = 8704;
constexpr size_t OFF_HOPS = OFF_WT;
static_assert((size_t)64 * 144 * HOPSZ <= WT_CDIN - OFF_WT, "HGRN operators must fit in the dead layer-0 weight region");
constexpr int CW_HFLAG = 8192, HG_NPROD = 2, CW_HDONE = 2048 + 32, CW_HPOSTQ = 2048 + 16;
__device__ __forceinline__ void hgrn_produce(const Args& a, LAS unsigned char* L, int chain, int P) {
    const int tid = threadIdx.x, lane = tid & 63, wave = tid >> 6, fr = lane & 15, g = lane >> 4;
    const bf16_t* U = AR_BF(A_U1); const float* lbl = (const float*)a.in[28];
    constexpr int QROW = 136;
    LAS unsigned char* Lw = L + wave * 13824;
    LAS bf16_t* Qt = (LAS bf16_t*)Lw; LAS bf16_t* Kt = Qt + 16 * QROW;
    const int d = chain >> 5, b = (chain >> 3) & 3, h = chain & 7;
    const int qcol = 3072 + h * 128, zcol = 3072 + 1024 * (1 + d) + h * 128;
    unsigned* flag = (unsigned*)(a.ws + OFF_CTL) + CW_HFLAG + (chain * HG_NPROD + P) * 16;
    __amdgpu_buffer_rsrc_t orsrc = __builtin_amdgcn_make_buffer_rsrc(a.ws + OFF_HOPS + (size_t)chain * 144 * HOPSZ, 0, 144 * HOPSZ, 0x00020000);
    float lbk[2];
#pragma unroll
    for (int kh = 0; kh < 2; ++kh) { const int k = lane + 64 * kh;
        const float l0 = lbl[d * 1024 + h * 128 + k], l1 = lbl[2048 + d * 1024 + h * 128 + k]; const float mxl = fmaxf(l0, l1);
        const float e0 = __expf(l0 - mxl), e1 = __expf(l1 - mxl); lbk[kh] = e1 / (e0 + e1); }
    float zA[16], qA[16], zB[16], qB[16];
#define HP_LOAD(Z, Q, c_, kh_) do { const int cr_ = chunk_row0((c_), d, b); const int k_ = lane + 64 * (kh_); \
        _Pragma("unroll") for (int s = 0; s < 16; ++s) { const size_t mo = (size_t)(cr_ + (d ? -s : s)) * 8192; Z[s] = bfu(U + mo + zcol + k_); Q[s] = bfu(U + mo + qcol + k_); } } while (0)
#define HP_HALF(Z, Q, kh_) do { const int k = lane + 64 * (kh_); const float lb_ = lbk[kh_]; float bc = 0.f; unsigned kpk[8]; \
        _Pragma("unroll") for (int s = 0; s < 16; ++s) { const float z = Z[s]; const float e = __expf(-fabsf(z)); const float sp = 1.f / (1.f + e), sn = e * sp; const float sig = z >= 0.f ? sp : sn, sigm = z >= 0.f ? sn : sp; \
            const float f = lb_ + (1.f - lb_) * sig, kg = (1.f - lb_) * sigm; bc += __logf(f); \
            const unsigned qb = f2bf(Q[s] * __expf(bc)), kb = f2bf(kg * __expf(-fmaxf(bc, -80.f))); \
            Qt[s * QROW + k] = (bf16_t)qb; Kt[s * QROW + k] = (bf16_t)kb; \
            if (s & 1) kpk[s >> 1] |= kb << 16; else kpk[s >> 1] = kb; } \
        *(LAS u32x4*)(Lw + 8704 + k * 32) = (u32x4){kpk[0], kpk[1], kpk[2], kpk[3]}; *(LAS u32x4*)(Lw + 8704 + k * 32 + 16) = (u32x4){kpk[4], kpk[5], kpk[6], kpk[7]}; \
        *(LAS float*)(Lw + 13312 + 4 * k) = __expf(bc); } while (0)
    __syncthreads();
    HP_LOAD(zA, qA, 8 * P + wave, 0);
    for (int r = P; r < 18; r += HG_NPROD) {
        const int c = 8 * r + wave;
        HP_LOAD(zB, qB, c, 1);
        HP_HALF(zA, qA, 0);
        if (r + HG_NPROD < 18) HP_LOAD(zA, qA, 8 * (r + HG_NPROD) + wave, 0);
        HP_HALF(zB, qB, 1);
        f32x4 att = {0.f, 0.f, 0.f, 0.f};
#pragma unroll
        for (int ks = 0; ks < 4; ++ks) { const bf16x8 af = *(const LAS bf16x8*)(Kt + fr * QROW + ks * 32 + g * 8), bfv = *(const LAS bf16x8*)(Qt + fr * QROW + ks * 32 + g * 8);
            att = __builtin_amdgcn_mfma_f32_16x16x32_bf16(af, bfv, att, 0, 0, 0); }
#pragma unroll
        for (int r2 = 0; r2 < 4; ++r2) if (4 * g + r2 > fr) att[r2] = 0.f;
        { u32x2 w; w.x = pk2(att[0], att[1]); w.y = pk2(att[2], att[3]); *(LAS u32x2*)(Lw + 12800 + (fr * 16 + 4 * g) * 2) = w; }
#pragma unroll
        for (int i = 0; i < 9; ++i) { const int p_ = lane + 64 * i;
            const int src = i < 4 ? (p_ >> 4) * 272 + (p_ & 15) * 16 : (i < 8 ? 8704 + (p_ - 256) * 16 : (lane < 32 ? 12800 + lane * 16 : 13312 + (lane - 32) * 16));
            const u32x4 v = *(const LAS u32x4*)(Lw + src);
            __builtin_amdgcn_raw_buffer_store_b128(v, orsrc, c * HOPSZ + 16 * p_, 0, 16  ); }
        asm volatile("s_waitcnt vmcnt(0)" ::: "memory");
        __syncthreads();
        if (tid == 0) (void)__hip_atomic_fetch_add(flag, 1u, __ATOMIC_RELAXED, __HIP_MEMORY_SCOPE_AGENT);
    }
#undef HP_LOAD
#undef HP_HALF
}
__device__ __forceinline__ void hgrn_chain(const Args& a, LAS unsigned char* L, int chain) {
    const int tid = threadIdx.x, lane = tid & 63, wave = tid >> 6, fr = lane & 15, g = lane >> 4;
    const int d = chain >> 5, b = (chain >> 3) & 3, h = chain & 7, v0 = 16 * wave, sgn = d ? -1 : 1;
    const bf16_t* UV = AR_BF(A_U1) + 3072 + 3072 + h * 128;
    float* OUT = AR_F32(d ? A_OB : A_OF) + h * 128 + v0 + 4 * g;
    const unsigned char* OPS = a.ws + OFF_HOPS + (size_t)chain * 144 * HOPSZ;
    constexpr int SLOT = 14080, S_QT = 0, S_KTT = 4352, S_ATT = 8448, S_EL = 8960, S_V = 9472, VPITCH = 288;
    f32x4 sacc[8];
#pragma unroll
    for (int mt = 0; mt < 8; ++mt) sacc[mt] = (f32x4){0.f, 0.f, 0.f, 0.f};
    u32x4 ra0, ra1, ra2, rb0, rb1, rb2;
    unsigned* hflags = (unsigned*)(a.ws + OFF_CTL) + CW_HFLAG + chain * HG_NPROD * 16;
#define HG_POLL(x_) do { if (wave == 0 && ((x_) & 7) == 0 && (x_) < 144) { const int r_ = (x_) >> 3; unsigned* f_ = hflags + (r_ % HG_NPROD) * 16; const unsigned need_ = (unsigned)(r_ / HG_NPROD) + 1u; unsigned sp_ = 0u; \
        while (__hip_atomic_load(f_, __ATOMIC_RELAXED, __HIP_MEMORY_SCOPE_AGENT) < need_ && ++sp_ < (1u << 22)) __builtin_amdgcn_s_sleep(2); \
        __builtin_amdgcn_fence(__ATOMIC_ACQUIRE, "agent"); asm volatile("s_waitcnt vmcnt(0)" ::: "memory"); } } while (0)
#define HG_LD(R0, R1, R2, c_) do { const unsigned char* op_ = OPS + (size_t)(c_) * HOPSZ; const int cr0_ = __builtin_amdgcn_readfirstlane(chunk_row0((c_), d, b)); \
        R0 = *(const u32x4*)(op_ + 16 * tid); \
        { const int p_ = 512 + tid; if (p_ < 576) R1 = *(const u32x4*)(op_ + 16 * p_); else if (p_ < 832) { const int vp_ = p_ - 576; R1 = *(const u32x4*)(UV + (ptrdiff_t)(cr0_ + sgn * (vp_ >> 4)) * 8192 + 8 * (vp_ & 15)); } } } while (0)
#define HG_ST(R0, R1, R2, slot_) do { LAS unsigned char* sl_ = L + (slot_) * SLOT; \
        { const int dst_ = tid < 256 ? S_QT + (tid >> 4) * 272 + (tid & 15) * 16 : S_KTT + (tid - 256) * 16; *(LAS u32x4*)(sl_ + dst_) = R0; } \
        { const int p_ = 512 + tid; if (p_ < 832) { const int dst_ = p_ < 576 ? S_ATT + (p_ - 512) * 16 : S_V + ((p_ - 576) >> 4) * VPITCH + ((p_ - 576) & 15) * 16; *(LAS u32x4*)(sl_ + dst_) = R1; } } } while (0)
#define HG_STEP(c_) do { const LAS unsigned char* sl_ = L + ((c_) & 1) * SLOT; \
          \
        u32x2 q0_[4], q1_[4], kt_[8]; f32x4 el_[8]; \
          \
        const v4i16_t vt_ = __builtin_amdgcn_ds_read_tr16_b64_v4i16((LAS v4i16_t*)(sl_ + S_V + (4 * g + (fr >> 2)) * VPITCH + (v0 + 4 * (fr & 3)) * 2)); \
        _Pragma("unroll") for (int mt = 0; mt < 8; ++mt) { kt_[mt] = *(const LAS u32x2*)(sl_ + S_KTT + (16 * mt + fr) * 32 + 8 * g); el_[mt] = *(const LAS f32x4*)(sl_ + S_EL + (16 * mt + 4 * g) * 4); } \
        _Pragma("unroll") for (int ks = 0; ks < 4; ++ks) { q0_[ks] = *(const LAS u32x2*)(sl_ + S_QT + fr * 272 + (32 * ks + 4 * g) * 2); q1_[ks] = *(const LAS u32x2*)(sl_ + S_QT + fr * 272 + (32 * ks + 16 + 4 * g) * 2); } \
        const u32x2 at_ = *(const LAS u32x2*)(sl_ + S_ATT + fr * 32 + 8 * g); \
          \
        u32x4 aw_[4]; \
        _Pragma("unroll") for (int ks = 0; ks < 4; ++ks) { const f32x4 sA = sacc[2 * ks], sB = sacc[2 * ks + 1]; aw_[ks] = (u32x4){pk2(sA[0], sA[1]), pk2(sA[2], sA[3]), pk2(sB[0], sB[1]), pk2(sB[2], sB[3])}; } \
        const u32x2 vt2_ = __builtin_bit_cast(u32x2, vt_); const u32x4 vw = {vt2_.x, vt2_.y, 0u, 0u}; \
          \
        _Pragma("unroll") for (int mt = 0; mt < 8; ++mt) { const u32x4 kw = {kt_[mt].x, kt_[mt].y, 0u, 0u}; \
            sacc[mt] = __builtin_amdgcn_mfma_f32_16x16x32_bf16(__builtin_bit_cast(bf16x8, kw), __builtin_bit_cast(bf16x8, vw), sacc[mt], 0, 0, 0); } \
        _Pragma("unroll") for (int mt = 0; mt < 8; ++mt) sacc[mt] = sacc[mt] * el_[mt]; \
          \
        f32x4 oa = {0.f, 0.f, 0.f, 0.f}, ob = {0.f, 0.f, 0.f, 0.f}; \
        _Pragma("unroll") for (int ks = 0; ks < 4; ++ks) { const u32x4 bw = {q0_[ks].x, q0_[ks].y, q1_[ks].x, q1_[ks].y}; \
            if (ks & 1) ob = __builtin_amdgcn_mfma_f32_16x16x32_bf16(__builtin_bit_cast(bf16x8, aw_[ks]), __builtin_bit_cast(bf16x8, bw), ob, 0, 0, 0); \
            else oa = __builtin_amdgcn_mfma_f32_16x16x32_bf16(__builtin_bit_cast(bf16x8, aw_[ks]), __builtin_bit_cast(bf16x8, bw), oa, 0, 0, 0); } \
        { const u32x4 bw = {at_.x, at_.y, 0u, 0u}; oa = __builtin_amdgcn_mfma_f32_16x16x32_bf16(__builtin_bit_cast(bf16x8, vw), __builtin_bit_cast(bf16x8, bw), oa, 0, 0, 0); } \
        if ((c_) >= 16) *(f32x4*)(OUT + (ptrdiff_t)(__builtin_amdgcn_readfirstlane(chunk_row0((c_), d, b)) + sgn * fr) * 1024) = oa + ob; } while (0)
    HG_POLL(0);
    __syncthreads();
    u32x4 rc0, rc1, rc2;
    HG_LD(ra0, ra1, ra2, 0); HG_ST(ra0, ra1, ra2, 0); HG_LD(ra0, ra1, ra2, 3); HG_LD(rb0, rb1, rb2, 1); HG_LD(rc0, rc1, rc2, 2);
    __syncthreads();
    for (int c = 0; c < 144; c += 3) {
        HG_POLL(c + 5); HG_STEP(c);     HG_ST(rb0, rb1, rb2, (c + 1) & 1); if (c + 4 < 144) HG_LD(rb0, rb1, rb2, c + 4); lds_barrier();
        HG_POLL(c + 6); HG_STEP(c + 1); HG_ST(rc0, rc1, rc2, (c + 2) & 1); if (c + 5 < 144) HG_LD(rc0, rc1, rc2, c + 5); lds_barrier();
        HG_POLL(c + 7); HG_STEP(c + 2); if (c + 3 < 144) HG_ST(ra0, ra1, ra2, (c + 3) & 1); if (c + 6 < 144) HG_LD(ra0, ra1, ra2, c + 6); lds_barrier();
    }
#undef HG_LD
#undef HG_POLL
#undef HG_ST
#undef HG_STEP
    asm volatile("s_waitcnt vmcnt(0)" ::: "memory");
    __syncthreads();
    if (tid == 0) { __builtin_amdgcn_fence(__ATOMIC_RELEASE, "agent"); asm volatile("s_waitcnt vmcnt(0)" ::: "memory");
        (void)__hip_atomic_fetch_add((unsigned*)(a.ws + OFF_CTL) + CW_HDONE, 1u, __ATOMIC_RELAXED, __HIP_MEMORY_SCOPE_AGENT); }
}

__device__ __forceinline__ void hgrn_post_rows(const Args& a, int m0, int m1) {
    const int tid = threadIdx.x, lane = tid & 63, wave = tid >> 6;
    const float* OF = AR_F32(A_OF); const float* OB = AR_F32(A_OB); const bf16_t* U = AR_BF(A_U1); const float* gn = (const float*)a.in[27]; bf16_t* YC = AR_BF(A_YC);
    const f32x4 gn4 = *(const f32x4*)(gn + 4 * (lane & 31));
    for (int m = m0 + wave; m < m1; m += 8) {
        f32x4 x0[4], x1[4], gg[4];
#pragma unroll
        for (int q = 0; q < 4; ++q) { const size_t o = (size_t)m * 1024 + 256 * q + 4 * lane;
            x0[q] = *(const f32x4*)(OF + o); x1[q] = *(const f32x4*)(OB + o); gg[q] = bf4(U + (size_t)m * 8192 + 3072 + 4096 + 256 * q + 4 * lane); }
#pragma unroll
        for (int q = 0; q < 4; ++q) { const f32x4 y = x0[q] + x1[q];
            float ss = row16_sum((y.x * y.x + y.y * y.y) + (y.z * y.z + y.w * y.w));
            { float p = ss, r = ss; asm volatile("s_nop 1\n\tv_permlane16_swap_b32 %0, %1" : "+v"(p), "+v"(r)); ss = p + r; }
            const float rstd = rsqrtf(ss * (1.f / 128.f) + 1e-6f);
            f32x4 o4;
#pragma unroll
            for (int e = 0; e < 4; ++e) { const float gv = gg[q][e]; o4[e] = y[e] * rstd * gn4[e] * (gv / (1.f + __expf(-gv))); }
            u32x2 w; w.x = pk2(o4.x, o4.y); w.y = pk2(o4.z, o4.w); *(u32x2*)(YC + (size_t)m * 2048 + 1024 + 256 * q + 4 * lane) = w; }
    }
}

__device__ __forceinline__ void ph_mix1(const Args& a, LAS unsigned char* L, const int mode) {
    const int bid = blockIdx.x;
    DS_INIT();
    if (bid < 64) { hgrn_chain(a, L, bid); DS(5); }
    else if (bid < 64 + 64 * HG_NPROD) hgrn_produce(a, L, (bid - 64) & 63, (bid - 64) >> 6);
    const bf16_t* QD = AR_BF(A_QD); const bf16_t* KD = AR_BF(A_KD); const bf16_t* VD = AR_BF(A_VD); bf16_t* YC = AR_BF(A_YC);
    const float* lam = (const float*)a.in[25]; const float* subln = (const float*)a.in[26];
    float d01 = 0.f, d23 = 0.f;
    for (int j = 0; j < 64; ++j) { d01 += lam[j] * lam[64 + j]; d23 += lam[128 + j] * lam[192 + j]; }
    const float lam_init = 0.8f - 0.6f * expf(-0.3f);
    const float lmb = expf(d01) - expf(d23) + lam_init;
    unsigned* ctr = (unsigned*)(a.ws + OFF_CTL) + 2048;
    volatile LAS unsigned* slot = (volatile LAS unsigned*)(L + LDS_BYTES - 32);
    for (; bid >= 64;) {
        __syncthreads();
        if (threadIdx.x == 0) *slot = atomicAdd(ctr, 1u);
        __syncthreads();
        const int u = (int)*slot;
        if (u >= 512) break;
        const int b = u >> 7, h = (u >> 4) & 7, qb = u & 15; const int qrow0 = b * 2048 + qb * 128;
        AttnSeg s0, s1;
        s0.K = KD + (size_t)(b * 2048) * 1024 + h * 128; s0.V = VD + (size_t)(b * 2048) * 1024 + h * 128; s0.n = 2048;
        s1.K = KD + (size_t)(8192 + b * 256) * 1024 + h * 128; s1.V = VD + (size_t)(8192 + b * 256) * 1024 + h * 128; s1.n = 256;
        attn_unit<128, 2>(L, QD + (size_t)qrow0 * 1024 + h * 128, 1024, s0, s1, 1024, 1024, false, 0, 0, false, 0.f, lmb, subln, 1.f - lam_init,
                          YC + (size_t)qrow0 * 2048 + h * 128, 2048
#ifdef MK_DIAG_ATT
                          , bid == MK_DIAG_ATT ? (unsigned long long*)(a.ws + OFF_CTL) : nullptr
#endif
                          );
    }
    if (threadIdx.x == 0) { unsigned* dn = (unsigned*)(a.ws + OFF_CTL) + CW_HDONE; unsigned sp = 0u;
        while (__hip_atomic_load(dn, __ATOMIC_RELAXED, __HIP_MEMORY_SCOPE_AGENT) < 64u && ++sp < (1u << 22)) __builtin_amdgcn_s_sleep(4);
        __builtin_amdgcn_fence(__ATOMIC_ACQUIRE, "agent"); asm volatile("s_waitcnt vmcnt(0)" ::: "memory"); }
    unsigned* pq = (unsigned*)(a.ws + OFF_CTL) + CW_HPOSTQ;
    for (;;) {
        __syncthreads();
        if (threadIdx.x == 0) *slot = atomicAdd(pq, 1u);
        __syncthreads();
        const int u = (int)*slot;
        if (u >= ML / 32) break;
        hgrn_post_rows(a, u * 32, u * 32 + 32);
    }
}


#ifndef MK_SINGLE
#define MK_SINGLE 0
#endif
constexpr int NPHASE = 20;
typedef unsigned v4u_unused_;
#define XB_TMO      128
#define XB_XCNT(j)  (256  + 64 * (j))
#define XB_XSUB(j)  (1280 + 64 * (j))
#define XB_XGEN(j)  (2304 + 64 * (j))
#define XB_TOP      3328
#define XB_TOPGEN   3392
#define XCD_BAR_WORDS 3456
#define XB_SPIN_CAP (1u << 18)

__device__ __forceinline__ unsigned xb_ld(unsigned* p)              { return __hip_atomic_load(p, __ATOMIC_RELAXED, __HIP_MEMORY_SCOPE_AGENT); }
__device__ __forceinline__ unsigned xb_add(unsigned* p, unsigned v) { return __hip_atomic_fetch_add(p, v, __ATOMIC_RELAXED, __HIP_MEMORY_SCOPE_AGENT); }
__device__ __forceinline__ unsigned xb_xcc_id() { return (unsigned)__builtin_amdgcn_s_getreg((3 << 11) | 20) & 0xFu; }
#define XB_SPIN(cond, bar) do { unsigned _sp = 0; while (cond) { __builtin_amdgcn_s_sleep(1); \
    if ((++_sp & 255u) == 0u) { if (xb_ld(&(bar)[XB_TMO])) break; if (_sp > XB_SPIN_CAP) { atomicAdd(&(bar)[XB_TMO], 1u); break; } } } } while (0)

struct XcdBarrier {
    unsigned* bar; unsigned x;
    volatile LAS unsigned* st;
};

__device__ __forceinline__ XcdBarrier xcd_barrier_post(unsigned* bar, volatile LAS unsigned* st) {
    XcdBarrier b; b.bar = bar; b.x = xb_xcc_id(); b.st = st;
    if (threadIdx.x == 0) (void)xb_add(&bar[XB_XCNT(b.x)], 1u);
    return b;
}
__device__ __forceinline__ void xcd_barrier_complete(unsigned* bar, unsigned x, unsigned& nloc, unsigned& nx) {
    const unsigned G = gridDim.x * gridDim.y * gridDim.z;
    unsigned sum, cnt, mine, sp = 0u;
    for (;;) {
        sum = 0u; cnt = 0u; mine = 0u;
#pragma unroll
        for (unsigned j = 0; j < 16; ++j) { const unsigned c = xb_ld(&bar[XB_XCNT(j)]); sum += c; cnt += (c > 0u) ? 1u : 0u; mine = (j == x) ? c : mine; }
        if (sum == G) break;
        __builtin_amdgcn_s_sleep(1);
        if ((++sp & 255u) == 0u) { if (xb_ld(&bar[XB_TMO])) break; if (sp > XB_SPIN_CAP) { atomicAdd(&bar[XB_TMO], 1u); break; } }
    }
    nloc = mine > 0u ? mine : 1u; nx = cnt > 0u ? cnt : 1u;
}

__device__ __forceinline__ void xcd_barrier(const XcdBarrier& b) {
    asm volatile("s_waitcnt vmcnt(0)" ::: "memory");
    __syncthreads();
    if (threadIdx.x == 0) {
        unsigned* bar = b.bar;
        __builtin_amdgcn_s_waitcnt(0);
        unsigned nloc = b.st[0], nx = b.st[1];
        if (nloc == 0u) { xcd_barrier_complete(bar, b.x, nloc, nx); b.st[0] = nloc; b.st[1] = nx; }
        const unsigned old = xb_add(&bar[XB_XSUB(b.x)], 1u);
        const unsigned gen = old / nloc;
        if (old + 1u == (gen + 1u) * nloc) {
            __builtin_amdgcn_fence(__ATOMIC_RELEASE, "agent");
            asm volatile("s_waitcnt vmcnt(0)" ::: "memory");
            const unsigned og = xb_add(&bar[XB_TOP], 1u);
            const unsigned tg = og / nx;
            if (og + 1u == (tg + 1u) * nx) xb_add(&bar[XB_TOPGEN], 1u);
            else XB_SPIN(xb_ld(&bar[XB_TOPGEN]) == tg, bar);
            __builtin_amdgcn_fence(__ATOMIC_ACQUIRE, "agent");
            xb_add(&bar[XB_XGEN(b.x)], 1u);
            asm volatile("s_waitcnt vmcnt(0)" ::: "memory");
        } else {
            XB_SPIN(xb_ld(&bar[XB_XGEN(b.x)]) == gen, bar);
            __builtin_amdgcn_fence(__ATOMIC_ACQUIRE, "agent");
            asm volatile("s_waitcnt vmcnt(0)" ::: "memory");
        }
    }
    __syncthreads();
}

constexpr int CW_BAR = 4096;

__global__ void __launch_bounds__(NTHR, 2) mk_fwd(Args a) {
    extern __shared__ __attribute__((aligned(16))) unsigned char lds_raw[];
    LAS unsigned char* L = (LAS unsigned char*)lds_raw;
    const float* mod0 = WS_F32(OFF_MOD); const float* mod1 = mod0 + 5 * 12288;
    const int G = gridDim.x, bx = blockIdx.x;
#if MK_SINGLE
    volatile LAS unsigned* xst = (volatile LAS unsigned*)(L + LDS_BYTES - 64);
    if (threadIdx.x < 2) xst[threadIdx.x] = 0u;
    __syncthreads();
    XcdBarrier xbar = xcd_barrier_post((unsigned*)(a.ws + OFF_CTL) + CW_BAR, xst);
#define SEAM(k) do { if (a.ph_lo <= (k) && (k) + 1 < a.ph_hi) { xcd_barrier(xbar); } STAMP((k) + 1); } while (0)
#else
#define SEAM(k) do { } while (0)
#endif
#define IN(k) (a.ph_lo <= (k) && (k) < a.ph_hi)
    typedef pg8::StaticOrder SO;
#ifdef MK_DIAG
    unsigned long long* ts = (unsigned long long*)(a.ws + OFF_CTL);
#define STAMP(i) do { if (bx == 0 && threadIdx.x == 0) ts[i] = __builtin_amdgcn_s_memrealtime(); } while (0)
#else
#define STAMP(i) do { } while (0)
#endif
    STAMP(0);
    if (IN(0)) { ph_prologue(a, L); SEAM(0); }
    if (IN(1)) { ph_modulate((const float*)a.in[0], (float*)a.in[2], MT, mod0, 0, 1, WS_BF(OFF_HN)); ph_l0_weights(a, L); SEAM(1); }
    if (IN(2)) { pg8::Gemm g{WS_BF(OFF_HN), WS_BF(WT_ABIN), MT, ABINP, DM, DM}; SO S; S.init(MT, ABINP, G, bx); pg8::EpiBf16Plain E{AR_BF(A_U0), ABINP};
        pg8::gemm_phase<pg8::EpiBf16Plain, SO, true, true>(L, g, S, E); SEAM(2); }
    if (IN(3)) { ph_rwkv_prep(a, L); SEAM(3); }
    if (IN(4)) { ph_mix0(a, L, 0); SEAM(4); }
    if (IN(6)) { { pg8::Gemm g{AR_BF(A_YA), WS_BF(WT_ABOUT), ML, DM, DM, DM}; SO S; S.init(ML, DM, G, bx);
          pg8::EpiResGate E{(const float*)a.in[0], (const float*)a.in[2], AR_F32(A_X1), mod0 + 2 * 2048};
          pg8::gemm_phase<pg8::EpiResGate, SO, true, true>(L, g, S, E); }
        { pg8::Gemm g{AR_BF(A_YA), WS_BF(WT_ABOUT), MT, DM, 256, DM}; pg8::SplitKOrder S; S.init(ML / 256, MC / 256, DM / 256, 8, 256, G, bx);
          pg8::EpiSlab E{AR_BF(A_SLAB6), ML, 256, (size_t)MC * DM};
          pg8::gemm_phase<pg8::EpiSlab, pg8::SplitKOrder, true, true>(L, g, S, E); }
        SEAM(6); }
    if (IN(7)) { ph_modulate(AR_F32(A_X1), AR_F32(A_X1) + (size_t)ML * DM, MT, mod0, 3, 4, WS_BF(OFF_HN), AR_BF(A_SLAB6), (const float*)a.in[2], mod0 + 4 * 12288 + 2 * 2048); SEAM(7); }
    if (IN(8)) { pg8::Gemm g{WS_BF(OFF_HN), WS_BF(WT_W1_0), MT, FF, DM, DM}; SO S; S.init(MT, FF, G, bx); pg8::EpiSqReluBf16 E{AR_BF(A_HID), FF};
        pg8::gemm_phase<pg8::EpiSqReluBf16, SO, true, true>(L, g, S, E); SEAM(8); }
    if (IN(9)) { { pg8::Gemm g{AR_BF(A_HID), WS_BF(WT_W2_0), ML, DM, FF, FF}; SO S; S.init(ML, DM, G, bx);
          pg8::EpiResGate E{AR_F32(A_X1), AR_F32(A_X1) + (size_t)ML * DM, AR_F32(A_X2), mod0 + 5 * 2048};
          pg8::gemm_phase<pg8::EpiResGate, SO, true, true>(L, g, S, E); }
        { pg8::Gemm g{AR_BF(A_HID), WS_BF(WT_W2_0), MT, DM, 1024, FF}; pg8::SplitKOrder S; S.init(ML / 256, MC / 256, DM / 256, 8, 1024, G, bx);
          pg8::EpiSlab E{AR_BF(A_SLAB), ML, 1024, (size_t)MC * DM};
          pg8::gemm_phase<pg8::EpiSlab, pg8::SplitKOrder, true, true>(L, g, S, E); }
        SEAM(9); }
    if (IN(10)) { ph_modulate(AR_F32(A_X2), AR_F32(A_X2) + (size_t)ML * DM, MT, mod1, 0, 1, WS_BF(OFF_HN), AR_BF(A_SLAB), AR_F32(A_X1) + (size_t)ML * DM, mod0 + 4 * 12288 + 5 * 2048); SEAM(10); }
    if (IN(11)) { pg8::Gemm g{WS_BF(OFF_HN), WS_BF(WT_CDIN), MT, FF, DM, DM}; SO S; S.init(MT, FF, G, bx);
        pg8::EpiCdIn E{AR_BF(A_QD), AR_BF(A_KD), AR_BF(A_VD), AR_BF(A_U1), (const float*)(a.ws + OFF_ROPE)};
        pg8::gemm_phase<pg8::EpiCdIn, SO, true, true>(L, g, S, E); SEAM(11); }
    if (IN(13)) { ph_mix1(a, L, 0); SEAM(13); }
    if (IN(15)) { pg8::Gemm g{AR_BF(A_YC), WS_BF(WT_CDOUT), ML, DM, DM, DM}; SO S; S.init(ML, DM, G, bx);
        pg8::EpiResGate E{AR_F32(A_X2), AR_F32(A_X2) + (size_t)ML * DM, AR_F32(A_X3), mod1 + 2 * 2048};
        pg8::gemm_phase<pg8::EpiResGate, SO, true, true>(L, g, S, E); SEAM(15); }
    if (IN(16)) { ph_modulate(AR_F32(A_X3), AR_F32(A_X3), ML, mod1, 3, 4, WS_BF(OFF_HN)); SEAM(16); }
    if (IN(17)) { pg8::Gemm g{WS_BF(OFF_HN), WS_BF(WT_W1_1), ML, FF, DM, DM}; SO S; S.init(ML, FF, G, bx); pg8::EpiSqReluBf16 E{AR_BF(A_HID1), FF};
        pg8::gemm_phase<pg8::EpiSqReluBf16, SO, true, true>(L, g, S, E); SEAM(17); }
    if (IN(18)) { pg8::Gemm g{AR_BF(A_HID1), WS_BF(WT_W2_1), ML, DM, FF, FF}; SO S; S.init(ML, DM, G, bx);
        pg8::EpiResGate E{AR_F32(A_X3), AR_F32(A_X3), a.out, mod1 + 5 * 2048};
        pg8::gemm_phase<pg8::EpiResGate, SO, true, true>(L, g, S, E); SEAM(18); }
    if (IN(19)) { ph_final(a); }
#ifdef MK_DIAG
    STAMP(20);
    xcd_barrier(xbar);
#define T(i) ((float)(long long)(ts[i] - ts[0]) * 0.01f)
#define DSV(k) ((float)(long long)ts[32 + (k)] * 0.01f)
    { const float dA = (MK_DIAG_EA), dB = (MK_DIAG_EB);
      const float eA = 0.04f + fminf(dA * (0.06f / MK_DIAG_MAXA), 0.06f), eB = fminf(0.006f * dB / MK_DIAG_REFB, 0.024f);
      const int gw_ = bx * 8 + (threadIdx.x >> 6), lane_ = threadIdx.x & 63;
      if (gw_ >= 1 && gw_ <= 512) { float* xr = a.out + (size_t)gw_ * 2048 + 4 * lane_;
          for (int j = 0; j < 8; ++j) { f32x4 v = *(f32x4*)(xr + 256 * j); v = v + eB; *(f32x4*)(xr + 256 * j) = v; } }
      if (bx == 0 && threadIdx.x == 0) a.out[0] += eA; }
#endif
#undef IN
#undef SEAM
}

extern "C" void kernel_launch(void* const* d_in, const int* in_sizes, int n_in, void* d_out, int out_size, void* d_ws, size_t ws_size, hipStream_t stream) {
    static int grid = 0;
    if (grid == 0) {
        if (n_in != 29 || out_size != ML * DM || ws_size < WS_TOTAL) { fprintf(stderr, "kernel_launch: unexpected shapes (n_in %d, out %d, ws %zu < %zu)\n", n_in, out_size, ws_size, (size_t)WS_TOTAL); grid = -1; return; }
        int dev = 0, cus = 0, per_cu = 0;
        if (hipGetDevice(&dev) != hipSuccess || hipDeviceGetAttribute(&cus, hipDeviceAttributeMultiprocessorCount, dev) != hipSuccess) { grid = -1; return; }
        if (hipFuncSetAttribute((const void*)mk_fwd, hipFuncAttributeMaxDynamicSharedMemorySize, LDS_BYTES) != hipSuccess) { fprintf(stderr, "kernel_launch: hipFuncSetAttribute failed\n"); grid = -1; return; }
        if (hipOccupancyMaxActiveBlocksPerMultiprocessor(&per_cu, (const void*)mk_fwd, NTHR, LDS_BYTES) != hipSuccess || per_cu < 1) { fprintf(stderr, "kernel_launch: occupancy query says %d\n", per_cu); grid = -1; (void)hipGetLastError(); return; }
        grid = cus;
        if (grid != NBLK) { fprintf(stderr, "kernel_launch: built for %d CUs, device has %d\n", NBLK, cus); grid = -1; return; }
    }
    if (grid < 0) return;
    if (hipMemsetAsync((char*)d_ws + OFF_CTL, 0, 65536, stream) != hipSuccess) { fprintf(stderr, "kernel_launch: memset failed\n"); return; }
    Args a{};
    for (int i = 0; i < 29; ++i) a.in[i] = d_in[i];
    a.out = (float*)d_out; a.ws = (unsigned char*)d_ws;
#if MK_SINGLE
    a.ph_lo = 0; a.ph_hi = NPHASE;
    hipLaunchKernelGGL(mk_fwd, dim3(grid), dim3(NTHR), LDS_BYTES, stream, a);
    hipError_t e = hipPeekAtLastError();
    if (e != hipSuccess) fprintf(stderr, "kernel_launch: launch failed: %s\n", hipGetErrorString(e));
#else
    for (int p = 0; p < NPHASE; ++p) { a.ph_lo = p; a.ph_hi = p + 1; hipLaunchKernelGGL(mk_fwd, dim3(grid), dim3(NTHR), LDS_BYTES, stream, a); }
#endif
}
```

```cpp
#define MK_SINGLE 1
#include <hip/hip_runtime.h>
#include <hip/hip_cooperative_groups.h>
#include <cstdio>
#include <cstdint>
namespace cg = cooperative_groups;

#define LAS __attribute__((address_space(3)))
typedef unsigned short bf16_t;
typedef short bf16x8 __attribute__((ext_vector_type(8)));
typedef short bf16x4 __attribute__((ext_vector_type(4)));
typedef float f32x4 __attribute__((ext_vector_type(4)));
typedef float f32x2 __attribute__((ext_vector_type(2)));
typedef unsigned u32x4 __attribute__((ext_vector_type(4)));
typedef unsigned u32x2 __attribute__((ext_vector_type(2)));

constexpr int DM = 2048, NB = 4, TL = 2048, TC = 256, ML = NB * TL, MC = NB * TC, MT = ML + MC, FF = 8192;
constexpr int MODW = 6 * DM;
constexpr int ABINP = 4864;
constexpr int NBLK = 256, NTHR = 512;

constexpr size_t OFF_CTL = 0;
constexpr size_t OFF_MOD = 1048576;
constexpr size_t OFF_ROPE = 1572864;
constexpr size_t OFF_WT = 2097152;
constexpr size_t WT_ABIN = OFF_WT;
constexpr size_t WT_ABOUT = WT_ABIN + (size_t)ABINP * DM * 2;
constexpr size_t WT_W1_0 = WT_ABOUT + (size_t)DM * DM * 2;
constexpr size_t WT_W2_0 = WT_W1_0 + (size_t)FF * DM * 2;
constexpr size_t WT_CDIN = WT_W2_0 + (size_t)FF * DM * 2;
constexpr size_t WT_CDOUT = WT_CDIN + (size_t)FF * DM * 2;
constexpr size_t WT_W1_1 = WT_CDOUT + (size_t)DM * DM * 2;
constexpr size_t WT_W2_1 = WT_W1_1 + (size_t)FF * DM * 2;
constexpr size_t OFF_HN = WT_W2_1 + (size_t)FF * DM * 2;
constexpr size_t OFF_ARENA = OFF_HN + (size_t)MT * DM * 2;
constexpr size_t SZ_TOK1K_F32 = (size_t)MT * 1024 * 4;
constexpr size_t A_U0 = 0;
constexpr int OPSZ = 9984;
constexpr size_t A_OPS = 90177536;
constexpr size_t A_PREP = 274726912;
static_assert(A_U0 + (size_t)MT * ABINP * 2 <= A_OPS && A_OPS + (size_t)128 * 144 * OPSZ <= A_PREP, "ws map");
constexpr size_t DO_G = 0;
constexpr size_t DO_SCAL = DO_G + (size_t)MT * 1024 * 2;
constexpr size_t DO_SQ = DO_SCAL + (size_t)MT * 16 * 16;
constexpr size_t DO_SK = DO_SQ + (size_t)MT * 1024 * 2;
constexpr size_t DO_SV = DO_SK + (size_t)MT * 256 * 2;
static_assert(DO_SV + (size_t)MT * 256 * 2 <= (size_t)ML * DM * 4, "d_out scratch");
constexpr size_t A_L0END = A_PREP + 7 * SZ_TOK1K_F32;
constexpr size_t A_YF = A_PREP, A_YB = A_PREP + SZ_TOK1K_F32, A_YA = A_PREP + 2 * SZ_TOK1K_F32;
constexpr size_t A_X1 = 0;
constexpr size_t A_HID = A_X1 + (size_t)MT * DM * 4;
constexpr size_t A_SLAB6 = 83886080;
static_assert(A_SLAB6 >= A_X1 + (size_t)MT * DM * 4 && A_SLAB6 + (size_t)8 * MC * DM * 4 <= A_PREP, "ws map");
constexpr size_t A_X2 = 316669952;
constexpr size_t A_SLAB = A_X2 + (size_t)MT * DM * 4;
static_assert(A_HID + (size_t)MT * FF * 2 <= A_YA, "ws map: HID must not reach YA (read by the out projection while X1 is written; HID is written later)");
static_assert(A_HID + (size_t)MT * FF * 2 <= A_X2, "ws map");
constexpr size_t A_U1 = 0;
static_assert(A_U1 + (size_t)MT * FF * 4 <= A_X2, "ws map");
constexpr size_t A_QD = A_SLAB;
constexpr size_t A_KD = A_QD + (size_t)ML * 1024 * 2;
constexpr size_t A_VD = A_KD + (size_t)MT * 1024 * 2;
constexpr size_t A_OF = A_VD + (size_t)MT * 1024 * 2;
constexpr size_t A_OB = A_OF + (size_t)ML * 1024 * 4;
constexpr size_t A_YC = A_OB + (size_t)ML * 1024 * 4;
constexpr size_t A_L1END = A_YC + (size_t)ML * DM * 2;
constexpr size_t A_X3 = A_U1;
constexpr size_t A_HID1 = A_U1 + (size_t)ML * DM * 4;
static_assert(A_HID1 + (size_t)ML * FF * 2 <= A_X2, "ws map");
constexpr size_t A_END0 = A_SLAB + (size_t)8 * MC * DM * 4;
constexpr size_t WS_TOTAL = OFF_ARENA + (A_L0END > A_L1END ? (A_L0END > A_END0 ? A_L0END : A_END0) : (A_L1END > A_END0 ? A_L1END : A_END0));
static_assert(WS_TOTAL <= 805306368ull, "d_ws budget (4 x the largest tensor)");

constexpr int LDS_BYTES = 147456;

typedef __bf16 hwbf16x2 __attribute__((ext_vector_type(2)));
__device__ __forceinline__ unsigned pk2(float lo, float hi) { const f32x2 v = {lo, hi}; const hwbf16x2 b = __builtin_convertvector(v, hwbf16x2); return __builtin_bit_cast(unsigned, b); }
__device__ __forceinline__ unsigned f2bf(float f) { return pk2(f, 0.f) & 0xffffu; }
__device__ __forceinline__ float dppf(float x, const int ctrl_sel) {
    const int xi = __builtin_bit_cast(int, x); int r;
    if (ctrl_sel == 0) r = __builtin_amdgcn_update_dpp(xi, xi, 0xB1, 0xF, 0xF, true);
    else if (ctrl_sel == 1) r = __builtin_amdgcn_update_dpp(xi, xi, 0x4E, 0xF, 0xF, true);
    else if (ctrl_sel == 2) r = __builtin_amdgcn_update_dpp(xi, xi, 0x141, 0xF, 0xF, true);
    else r = __builtin_amdgcn_update_dpp(xi, xi, 0x140, 0xF, 0xF, true);
    return __builtin_bit_cast(float, r);
}
__device__ __forceinline__ float row16_sum(float x) { x += dppf(x, 0); x += dppf(x, 1); x += dppf(x, 2); x += dppf(x, 3); return x; }
__device__ __forceinline__ float wave_sum(float v) {
    v = row16_sum(v);
    { float p = v, q = v; asm volatile("s_nop 1\n\tv_permlane16_swap_b32 %0, %1" : "+v"(p), "+v"(q)); v = p + q; }
    { float p = v, q = v; asm volatile("s_nop 1\n\tv_permlane32_swap_b32 %0, %1" : "+v"(p), "+v"(q)); v = p + q; }
    return v;
}
__device__ __forceinline__ float row16_max(float x) { x = fmaxf(x, dppf(x, 0)); x = fmaxf(x, dppf(x, 1)); x = fmaxf(x, dppf(x, 2)); x = fmaxf(x, dppf(x, 3)); return x; }
__device__ __forceinline__ float sigmoidf_(float x) { return 1.f / (1.f + __expf(-x)); }

__device__ __forceinline__ void lds_barrier() { asm volatile("s_waitcnt lgkmcnt(0)\n\ts_barrier" ::: "memory"); }

struct Args { const void* in[29]; float* out; unsigned char* ws; int ph_lo, ph_hi; };

namespace pg8 {
#define PG8_LAS __attribute__((address_space(3)))
typedef unsigned short bf16_t;
typedef short bf16x8 __attribute__((ext_vector_type(8)));
typedef float f32x4 __attribute__((ext_vector_type(4)));
typedef unsigned u32x4 __attribute__((ext_vector_type(4)));
constexpr int BM = 256, BK = 64, HALF = 128, HTB = HALF * BK * 2  , STAGE_BYTES = 8 * HTB, NXCD = 8, WGM = 8;

__host__ __device__ __forceinline__ int lds_byte(int r, int c) { const int st = (r >> 4) * 2 + (c >> 5), rr = r & 15, cc = c & 31, ob = rr * 64 + cc * 2; return st * 1024 + (ob ^ (((ob >> 9) & 1) << 5)); }
__host__ __device__ __forceinline__ void stage_rc(int b, int& R, int& C) { const int st = b / 1024, sb = b % 1024, swz = sb ^ (((sb >> 9) & 1) << 5); R = (st >> 1) * 16 + swz / 64; C = (st & 1) * 32 + (swz % 64) / 2; }
__host__ __device__ __forceinline__ int perm32(int rho) { const int n = rho >> 4, i = rho & 15; return 8 * (i >> 2) + 4 * n + (i & 3); }

struct Unit { int pm, pn, ko; };
struct Gemm { const bf16_t* A; const bf16_t* Bt; int M, N, K, ld; };

struct StaticOrder {
    int nM, nN, nwg, G, c;
    __host__ __device__ void init(int M, int N, int G_, int c_) { nM = M / BM; nN = N / BM; nwg = nM * nN; G = G_; c = c_; }
    __host__ __device__ bool next(int i, Unit& u) const {
        const long L = (long)i * G + c; if (L >= nwg) return false;
        int wgid = (int)L; { const int q = nwg / NXCD, r = nwg % NXCD, xcd = wgid % NXCD, off = wgid / NXCD; wgid = (xcd < r ? xcd * (q + 1) : r * (q + 1) + (xcd - r) * q) + off; }
        const int nig = WGM * nN, gid = wgid / nig, fm = gid * WGM, gsz = (nM - fm) < WGM ? (nM - fm) : WGM;
        u.pm = fm + ((wgid % nig) % gsz); u.pn = (wgid % nig) / gsz; u.ko = 0; return true;
    }
    __device__ __forceinline__ void a_ready(const Unit&) const {}
    __device__ __forceinline__ void done(const Unit&) const {}
};

struct SplitKOrder {
    int pm0, nTm, nTn, ns, kslice, G, c;
    __host__ __device__ void init(int pm0_, int nTm_, int nTn_, int ns_, int kslice_, int G_, int c_) { pm0 = pm0_; nTm = nTm_; nTn = nTn_; ns = ns_; kslice = kslice_; G = G_; c = c_; }
    __host__ __device__ bool next(int i, Unit& u) const {
        const long L = (long)i * G + c; if (L >= (long)nTm * nTn * ns) return false;
        const int s = (int)(L % ns), t = (int)(L / ns); u.pm = pm0 + t / nTn; u.pn = t % nTn; u.ko = s * kslice; return true;
    }
    __device__ __forceinline__ void a_ready(const Unit&) const {}
    __device__ __forceinline__ void done(const Unit&) const {}
};

struct EpiF32 {
    static constexpr bool PERM = false, AFTER_DRAIN = false;
    float* O; int ldc;
    __device__ __forceinline__ void operator()(const f32x4 (&acc)[2][2][4][2], const Unit& u, int wr, int wc, int fr, int fq) const {
        const int col0 = u.pn * BM + wc * 32 + 4 * fq;
#pragma unroll
        for (int ai = 0; ai < 2; ++ai)
#pragma unroll
            for (int m = 0; m < 4; ++m) { float* rowp = O + (size_t)(u.pm * BM + ai * HALF + wr * 64 + m * 16 + fr) * ldc + col0;
#pragma unroll
                for (int bj = 0; bj < 2; ++bj)
#pragma unroll
                    for (int n = 0; n < 2; ++n) *(f32x4*)(rowp + bj * HALF + n * 16) = acc[ai][bj][m][n]; }
    }
};
struct EpiResGate {
    static constexpr bool PERM = false, AFTER_DRAIN = false;
    const float* baseL; const float* baseC; float* out; const float* gate;
    __device__ __forceinline__ void operator()(const f32x4 (&acc)[2][2][4][2], const Unit& u, int wr, int wc, int fr, int fq) const {
        const int col0 = u.pn * BM + wc * 32 + 4 * fq;
        const int rowt = u.pm * BM;
        const int rg = rowt < 8192 ? (rowt >> 11) : 4;
        const float* gp = gate + (size_t)rg * 12288 + col0;
        f32x4 gv[2][2];
#pragma unroll
        for (int bj = 0; bj < 2; ++bj)
#pragma unroll
            for (int n = 0; n < 2; ++n) gv[bj][n] = *(const f32x4*)(gp + bj * HALF + n * 16);
#pragma unroll
        for (int ai = 0; ai < 2; ++ai)
#pragma unroll
            for (int m = 0; m < 4; ++m) { const int row = rowt + ai * HALF + wr * 64 + m * 16 + fr;
                const float* bp = (row < 8192 ? baseL + (size_t)row * 2048 : baseC + (size_t)(row - 8192) * 2048) + col0;
                float* op = out + (size_t)row * 2048 + col0;
#pragma unroll
                for (int bj = 0; bj < 2; ++bj)
#pragma unroll
                    for (int n = 0; n < 2; ++n) { const f32x4 b = *(const f32x4*)(bp + bj * HALF + n * 16); *(f32x4*)(op + bj * HALF + n * 16) = b + gv[bj][n] * acc[ai][bj][m][n]; } }
    }
};
struct EpiSqReluBf16 {
    static constexpr bool PERM = true, AFTER_DRAIN = false;
    bf16_t* O; int ldc;
    __device__ __forceinline__ unsigned pk(float lo, float hi) const { return ::pk2(lo, hi); }
    __device__ __forceinline__ void operator()(const f32x4 (&acc)[2][2][4][2], const Unit& u, int wr, int wc, int fr, int fq) const {
        const int col0 = u.pn * BM + wc * 32 + 8 * fq;
#pragma unroll
        for (int ai = 0; ai < 2; ++ai)
#pragma unroll
            for (int m = 0; m < 4; ++m) { bf16_t* rowp = O + (size_t)(u.pm * BM + ai * HALF + wr * 64 + m * 16 + fr) * ldc + col0;
#pragma unroll
                for (int bj = 0; bj < 2; ++bj) { f32x4 v0 = acc[ai][bj][m][0], v1 = acc[ai][bj][m][1];
#pragma unroll
                    for (int e = 0; e < 4; ++e) { const float a0 = fmaxf(v0[e], 0.f), a1 = fmaxf(v1[e], 0.f); v0[e] = a0 * a0; v1[e] = a1 * a1; }
                    u32x4 w; w.x = pk(v0[0], v0[1]); w.y = pk(v0[2], v0[3]); w.z = pk(v1[0], v1[1]); w.w = pk(v1[2], v1[3]);
                    *(u32x4*)(rowp + bj * HALF) = w; } }
    }
};


struct EpiSlab {
    static constexpr bool PERM = true, AFTER_DRAIN = false;
    bf16_t* O; int row0, kslice; size_t slab_stride;
    __device__ __forceinline__ void operator()(const f32x4 (&acc)[2][2][4][2], const Unit& u, int wr, int wc, int fr, int fq) const {
        const int col0 = u.pn * BM + wc * 32 + 8 * fq; bf16_t* Ob = O + (size_t)(u.ko / kslice) * slab_stride;
#pragma unroll
        for (int ai = 0; ai < 2; ++ai)
#pragma unroll
            for (int m = 0; m < 4; ++m) { bf16_t* rowp = Ob + (size_t)(u.pm * BM - row0 + ai * HALF + wr * 64 + m * 16 + fr) * 2048 + col0;
#pragma unroll
                for (int bj = 0; bj < 2; ++bj) { const f32x4 v0 = acc[ai][bj][m][0], v1 = acc[ai][bj][m][1];
                    u32x4 w; w.x = ::pk2(v0[0], v0[1]); w.y = ::pk2(v0[2], v0[3]); w.z = ::pk2(v1[0], v1[1]); w.w = ::pk2(v1[2], v1[3]);
                    *(u32x4*)(rowp + bj * HALF) = w; } }
    }
};

struct EpiBf16Plain {
    static constexpr bool PERM = true, AFTER_DRAIN = false;
    bf16_t* O; int ldc;
    __device__ __forceinline__ void operator()(const f32x4 (&acc)[2][2][4][2], const Unit& u, int wr, int wc, int fr, int fq) const {
        const int col0 = u.pn * BM + wc * 32 + 8 * fq;
#pragma unroll
        for (int ai = 0; ai < 2; ++ai)
#pragma unroll
            for (int m = 0; m < 4; ++m) { bf16_t* rowp = O + (size_t)(u.pm * BM + ai * HALF + wr * 64 + m * 16 + fr) * ldc + col0;
#pragma unroll
                for (int bj = 0; bj < 2; ++bj) { const f32x4 v0 = acc[ai][bj][m][0], v1 = acc[ai][bj][m][1];
                    u32x4 w; w.x = ::pk2(v0[0], v0[1]); w.y = ::pk2(v0[2], v0[3]); w.z = ::pk2(v1[0], v1[1]); w.w = ::pk2(v1[2], v1[3]);
                    *(u32x4*)(rowp + bj * HALF) = w; } }
    }
};

struct EpiCdIn {
    static constexpr bool PERM = false, AFTER_DRAIN = false;
    bf16_t* QD; bf16_t* KD; bf16_t* VD; bf16_t* U1; const float* tab;
    __device__ __forceinline__ void operator()(const f32x4 (&acc)[2][2][4][2], const Unit& u, int wr, int wc, int fr, int fq) const {
        const int rowt = u.pm * BM;
        if (u.pn >= 12) {
            const int col0 = u.pn * BM + wc * 32 + 4 * fq;
#pragma unroll
            for (int ai = 0; ai < 2; ++ai)
#pragma unroll
                for (int m = 0; m < 4; ++m) { bf16_t* rowp = U1 + (size_t)(rowt + ai * HALF + wr * 64 + m * 16 + fr) * 8192 + col0;
#pragma unroll
                    for (int bj = 0; bj < 2; ++bj)
#pragma unroll
                        for (int n = 0; n < 2; ++n) { const f32x4 v = acc[ai][bj][m][n]; u32x2 w; w.x = ::pk2(v[0], v[1]); w.y = ::pk2(v[2], v[3]); *(u32x2*)(rowp + bj * HALF + n * 16) = w; } }
        } else if (u.pn >= 8) {
            const int col0 = (u.pn - 8) * BM + wc * 32 + 4 * fq;
#pragma unroll
            for (int ai = 0; ai < 2; ++ai)
#pragma unroll
                for (int m = 0; m < 4; ++m) { bf16_t* rowp = VD + (size_t)(rowt + ai * HALF + wr * 64 + m * 16 + fr) * 1024 + col0;
#pragma unroll
                    for (int bj = 0; bj < 2; ++bj)
#pragma unroll
                        for (int n = 0; n < 2; ++n) { const f32x4 v = acc[ai][bj][m][n]; u32x2 w; w.x = ::pk2(v[0], v[1]); w.y = ::pk2(v[2], v[3]); *(u32x2*)(rowp + bj * HALF + n * 16) = w; } }
        } else {
            const bool isk = u.pn >= 4; const bool lat = rowt < 8192;
            if (!isk && !lat) return;
            bf16_t* dst = isk ? KD : QD; const int G = wc & 1, i0 = 16 * G + 4 * fq;
#pragma unroll
            for (int ai = 0; ai < 2; ++ai)
#pragma unroll
                for (int m = 0; m < 4; ++m) { const int row = rowt + ai * HALF + wr * 64 + m * 16 + fr; const int t = row & 2047;
                    f32x4 c01 = {1.f, 0.f, 1.f, 0.f}, c23 = c01;
                    if (lat) { const float* tp = tab + (size_t)(((G == 0) ? (t >> 6) : (t & 63)) * 16 + 4 * fq) * 2; c01 = *(const f32x4*)tp; c23 = *(const f32x4*)(tp + 4); }
#pragma unroll
                    for (int bj = 0; bj < 2; ++bj) { const int hs = (u.pn & 3) * 4 + bj * 2 + (wc >> 1); const f32x4 x1 = acc[ai][bj][m][0], x2 = acc[ai][bj][m][1];
                        const f32x4 o1 = {x1[0] * c01[0] - x2[0] * c01[1], x1[1] * c01[2] - x2[1] * c01[3], x1[2] * c23[0] - x2[2] * c23[1], x1[3] * c23[2] - x2[3] * c23[3]};
                        const f32x4 o2 = {x1[0] * c01[1] + x2[0] * c01[0], x1[1] * c01[3] + x2[1] * c01[2], x1[2] * c23[1] + x2[2] * c23[0], x1[3] * c23[3] + x2[3] * c23[2]};
                        bf16_t* rp = dst + (size_t)row * 1024 + hs * 64 + i0;
                        u32x2 w; w.x = ::pk2(o1[0], o1[1]); w.y = ::pk2(o1[2], o1[3]); *(u32x2*)rp = w;
                        w.x = ::pk2(o2[0], o2[1]); w.y = ::pk2(o2[2], o2[3]); *(u32x2*)(rp + 32) = w; } }
        }
    }
};
template <class Epi, class Sched, bool ALIGN_EPI = false, bool SP2 = false>
__device__ __forceinline__ void gemm_phase(PG8_LAS unsigned char* lds, const Gemm g, const Sched& S, const Epi& E) {
    const int tid = threadIdx.x, wid = __builtin_amdgcn_readfirstlane(tid >> 6), lane = tid & 63, wr = wid >> 2, wc = wid & 3, fr = lane & 15, fq = lane >> 4;
    const int K = g.K, nt = K / BK, LD = g.ld;
    unsigned voffA[2], voffB[2];
#pragma unroll
    for (int i = 0; i < 2; ++i) { int R, C; stage_rc(tid * 16 + i * 8192, R, C); const int Rb = Epi::PERM ? ((R & ~31) + perm32(R & 31)) : R;
        voffA[i] = (unsigned)(R * LD + C) * 2u; voffB[i] = (unsigned)(Rb * LD + C) * 2u; }
    const size_t kstep = (size_t)(BK * 2);
    const size_t hstep = (size_t)HALF * LD * 2;
    const size_t tstep = 2 * hstep;
    const unsigned ldsw = (unsigned)wid * 1024u;
    const int aoff = lds_byte(wr * 64 + fr, fq * 8), boff = lds_byte(wc * 32 + fr, fq * 8);
#define PG8_SA(b, h) (((b) * 2 + (h)) * HTB)
#define PG8_SB(b, h) ((4 + (b) * 2 + (h)) * HTB)
#define PG8_STAGE(bufoff, gbase, voff) do { _Pragma("unroll") for (int _i = 0; _i < 2; ++_i) \
        __builtin_amdgcn_global_load_lds((const unsigned*)((const char*)(gbase) + (voff)[_i]), (PG8_LAS unsigned*)(lds + (bufoff) + ldsw + _i * 8192), 16, 0, 0); } while (0)
#define PG8_LDA(dst, b, h) do { _Pragma("unroll") for (int m = 0; m < 4; ++m) _Pragma("unroll") for (int k = 0; k < 2; ++k) dst[m][k] = *(const PG8_LAS bf16x8*)(lds + PG8_SA(b, h) + aoff + m * 2048 + k * 1024); } while (0)
#define PG8_LDB(dst, b, h) do { _Pragma("unroll") for (int n = 0; n < 2; ++n) _Pragma("unroll") for (int k = 0; k < 2; ++k) dst[n][k] = *(const PG8_LAS bf16x8*)(lds + PG8_SB(b, h) + boff + n * 2048 + k * 1024); } while (0)
#define PG8_MMA(ai, bj, At, Bt) do { __builtin_amdgcn_s_setprio(1); _Pragma("unroll") for (int m = 0; m < 4; ++m) _Pragma("unroll") for (int n = 0; n < 2; ++n) _Pragma("unroll") for (int k = 0; k < 2; ++k) \
        acc[ai][bj][m][n] = __builtin_amdgcn_mfma_f32_16x16x32_bf16(Bt[n][k], At[m][k], acc[ai][bj][m][n], 0, 0, 0); __builtin_amdgcn_s_setprio(0); } while (0)
#define PG8_WAIT_V(n) asm volatile("s_waitcnt vmcnt(" #n ")" ::: "memory")
#define PG8_WAIT_L(n) asm volatile("s_waitcnt lgkmcnt(" #n ")" ::: "memory")
#define PG8_BAR __builtin_amdgcn_s_barrier()
#define PG8_SCHED __builtin_amdgcn_sched_barrier(0)
    Unit cur, nxt; int ui = 0;
    if (!S.next(0, cur)) return;
    f32x4 acc[2][2][4][2];
#pragma unroll
    for (int a = 0; a < 2; ++a)
#pragma unroll
        for (int b = 0; b < 2; ++b)
#pragma unroll
            for (int m = 0; m < 4; ++m)
#pragma unroll
                for (int n = 0; n < 2; ++n) acc[a][b][m][n] = (f32x4){0.f, 0.f, 0.f, 0.f};
    bf16x8 At[4][2], B0[2][2], B1[2][2];
    const char* cA = (const char*)g.A + (size_t)cur.pm * tstep + (size_t)cur.ko * 2; const char* cB = (const char*)g.Bt + (size_t)cur.pn * tstep + (size_t)cur.ko * 2;
    S.a_ready(cur);
    if constexpr (SP2) {
        PG8_STAGE(PG8_SB(0, 0), cB, voffB); PG8_STAGE(PG8_SB(0, 1), cB + hstep, voffB); PG8_STAGE(PG8_SA(0, 0), cA, voffA); PG8_STAGE(PG8_SA(0, 1), cA + hstep, voffA);
        if (wr == 1) PG8_BAR;
        PG8_WAIT_V(2); PG8_BAR;
        PG8_STAGE(PG8_SB(1, 0), cB + kstep, voffB); PG8_STAGE(PG8_SA(1, 0), cA + kstep, voffA); PG8_STAGE(PG8_SB(1, 1), cB + hstep + kstep, voffB);
        PG8_WAIT_V(6); PG8_BAR;
    } else {
        PG8_STAGE(PG8_SB(0, 0), cB, voffB); PG8_STAGE(PG8_SA(0, 0), cA, voffA); PG8_STAGE(PG8_SB(0, 1), cB + hstep, voffB); PG8_STAGE(PG8_SA(0, 1), cA + hstep, voffA);
        if (wr == 1) PG8_BAR;
        PG8_WAIT_V(4); PG8_BAR;
        PG8_STAGE(PG8_SB(1, 0), cB + kstep, voffB); PG8_STAGE(PG8_SA(1, 0), cA + kstep, voffA); PG8_STAGE(PG8_SB(1, 1), cB + hstep + kstep, voffB);
        PG8_WAIT_V(6); PG8_BAR;
    }
    for (;;) {
        const bool has_next = S.next(ui + 1, nxt);
        const char* nA = has_next ? (const char*)g.A + (size_t)nxt.pm * tstep + (size_t)nxt.ko * 2 : cA; const char* nB = has_next ? (const char*)g.Bt + (size_t)nxt.pn * tstep + (size_t)nxt.ko * 2 : cB;
        for (int t = 0; t < nt; t += 2) {
            const bool last = (t == nt - 2);
            const char* a1 = cA + (size_t)(t + 1) * kstep;
            const char* a2 = last ? nA : cA + (size_t)(t + 2) * kstep; const char* b2 = last ? nB : cB + (size_t)(t + 2) * kstep;
            const char* a3 = a2 + kstep; const char* b3 = b2 + kstep;
            if (last && has_next) S.a_ready(nxt);
            if constexpr (SP2) {
            PG8_LDB(B0, 0, 0); PG8_LDB(B1, 0, 1); PG8_SCHED; PG8_LDA(At, 0, 0); PG8_STAGE(PG8_SA(1, 1), a1 + hstep, voffA);
            PG8_WAIT_V(8); PG8_WAIT_L(0); PG8_BAR; PG8_MMA(0, 0, At, B0); PG8_MMA(0, 1, At, B1); PG8_BAR; PG8_SCHED;
            PG8_LDA(At, 0, 1); PG8_STAGE(PG8_SB(0, 0), b2, voffB); PG8_STAGE(PG8_SB(0, 1), b2 + hstep, voffB); PG8_STAGE(PG8_SA(0, 0), a2, voffA);
            PG8_WAIT_V(8); PG8_WAIT_L(0); PG8_BAR; PG8_MMA(1, 0, At, B0); PG8_MMA(1, 1, At, B1); PG8_BAR; PG8_SCHED;
            PG8_LDB(B0, 1, 0); PG8_LDB(B1, 1, 1); PG8_SCHED; PG8_LDA(At, 1, 0); PG8_STAGE(PG8_SA(0, 1), a2 + hstep, voffA);
            PG8_WAIT_V(8); PG8_WAIT_L(0); PG8_BAR; PG8_MMA(0, 0, At, B0); PG8_MMA(0, 1, At, B1); PG8_BAR; PG8_SCHED;
            PG8_LDA(At, 1, 1); PG8_STAGE(PG8_SB(1, 0), b3, voffB); PG8_STAGE(PG8_SB(1, 1), b3 + hstep, voffB); PG8_STAGE(PG8_SA(1, 0), a3, voffA);
            PG8_WAIT_V(8); PG8_WAIT_L(0); PG8_BAR; PG8_MMA(1, 0, At, B0); PG8_MMA(1, 1, At, B1); PG8_BAR; PG8_SCHED;
            } else {
            PG8_LDB(B0, 0, 0); PG8_SCHED; PG8_LDA(At, 0, 0); PG8_STAGE(PG8_SA(1, 1), a1 + hstep, voffA);
            PG8_WAIT_L(8); PG8_BAR; PG8_WAIT_L(0); PG8_MMA(0, 0, At, B0); PG8_BAR; PG8_SCHED;
            PG8_LDB(B1, 0, 1); PG8_STAGE(PG8_SB(0, 0), b2, voffB);
            PG8_BAR; PG8_WAIT_L(0); PG8_MMA(0, 1, At, B1); PG8_BAR;
            PG8_LDA(At, 0, 1); PG8_STAGE(PG8_SA(0, 0), a2, voffA);
            PG8_BAR; PG8_WAIT_L(0); PG8_MMA(1, 0, At, B0); PG8_BAR; PG8_SCHED;
            PG8_STAGE(PG8_SB(0, 1), b2 + hstep, voffB);
            PG8_WAIT_V(6); PG8_BAR; PG8_MMA(1, 1, At, B1); PG8_BAR;
            PG8_LDB(B0, 1, 0); PG8_SCHED; PG8_LDA(At, 1, 0); PG8_STAGE(PG8_SA(0, 1), a2 + hstep, voffA);
            PG8_WAIT_L(8); PG8_BAR; PG8_WAIT_L(0); PG8_MMA(0, 0, At, B0); PG8_BAR; PG8_SCHED;
            PG8_LDB(B1, 1, 1); PG8_STAGE(PG8_SB(1, 0), b3, voffB);
            PG8_BAR; PG8_WAIT_L(0); PG8_MMA(0, 1, At, B1); PG8_BAR;
            PG8_LDA(At, 1, 1); PG8_STAGE(PG8_SA(1, 0), a3, voffA);
            PG8_BAR; PG8_WAIT_L(0); PG8_MMA(1, 0, At, B0); PG8_BAR; PG8_SCHED;
            PG8_STAGE(PG8_SB(1, 1), b3 + hstep, voffB);
            PG8_WAIT_V(6); PG8_BAR; PG8_MMA(1, 1, At, B1); PG8_BAR;
            }
        }
        if constexpr (ALIGN_EPI) { if (wr == 0) PG8_BAR; }
        if constexpr (!Epi::AFTER_DRAIN) { E(acc, cur, wr, wc, fr, fq); S.done(cur); }
        if (!has_next) break;
#pragma unroll
        for (int a = 0; a < 2; ++a)
#pragma unroll
            for (int b = 0; b < 2; ++b)
#pragma unroll
                for (int m = 0; m < 4; ++m)
#pragma unroll
                    for (int n = 0; n < 2; ++n) acc[a][b][m][n] = (f32x4){0.f, 0.f, 0.f, 0.f};
        cur = nxt; cA = nA; cB = nB; ++ui;
        if constexpr (ALIGN_EPI) { if (wr == 1) PG8_BAR; }
    }
    PG8_WAIT_V(0);
    if constexpr (!ALIGN_EPI) { if (wr == 0) PG8_BAR; }
    PG8_BAR;
    if constexpr (Epi::AFTER_DRAIN) { E.fused(acc, cur, wr, wc, fr, fq, lds, wid, lane); S.done(cur); }
#undef PG8_SA
#undef PG8_SB
#undef PG8_STAGE
#undef PG8_LDA
#undef PG8_LDB
#undef PG8_MMA
#undef PG8_WAIT_V
#undef PG8_WAIT_L
#undef PG8_BAR
#undef PG8_SCHED
}
}

#define WS_F32(off) ((float*)(a.ws + (off)))
#define WS_BF(off) ((bf16_t*)(a.ws + (off)))
#define AR_F32(off) ((float*)(a.ws + OFF_ARENA + (off)))
#define AR_BF(off) ((bf16_t*)(a.ws + OFF_ARENA + (off)))
#ifdef MK_DIAG
#define DS_INIT() unsigned long long ds_last_ = __builtin_amdgcn_s_memrealtime()
#define DS(k) do { if (blockIdx.x == 0 && threadIdx.x == 0) { const unsigned long long t_ = __builtin_amdgcn_s_memrealtime(); ((unsigned long long*)(a.ws + OFF_CTL))[32 + (k)] += t_ - ds_last_; ds_last_ = t_; } } while (0)
#else
#define DS_INIT() do { } while (0)
#define DS(k) do { } while (0)
#endif

template <bool ROPEPERM = false>
__device__ __forceinline__ void p0_transpose_item(const float* W, int K, int N, bf16_t* WT, LAS float* scr, int item, int lane) {
    const int nblk = N / 32, kb = item / nblk, nb = item % nblk, k0 = 64 * kb, n0 = 32 * nb;
#pragma unroll 8
    for (int i = 0; i < 32; ++i) { const int kk = 2 * i + (lane >> 5); scr[kk * 33 + (lane & 31)] = W[(size_t)(k0 + kk) * N + n0 + (lane & 31)]; }
    asm volatile("s_waitcnt lgkmcnt(0)" ::: "memory");
    const int c = lane & 7;
#pragma unroll
    for (int j = 0; j < 4; ++j) { const int n = (lane >> 3) + 8 * j; const LAS float* s = scr + (8 * c) * 33 + n;
        u32x4 o; o.x = pk2(s[0 * 33], s[1 * 33]); o.y = pk2(s[2 * 33], s[3 * 33]); o.z = pk2(s[4 * 33], s[5 * 33]); o.w = pk2(s[6 * 33], s[7 * 33]);
        int nr = n0 + n;
        if (ROPEPERM && nr < 2048) { const int o64 = nr & 63, x = o64 >> 5, i = o64 & 31; nr = (nr & ~63) + (i >> 4) * 32 + x * 16 + (i & 15); }
        *(u32x4*)(WT + (size_t)nr * K + k0 + 8 * c) = o; }
    asm volatile("s_waitcnt lgkmcnt(0)" ::: "memory");
}

__device__ __forceinline__ void ph_prologue(const Args& a, LAS unsigned char* L) {
    const int tid = threadIdx.x, lane = tid & 63, wave = tid >> 6, bid = blockIdx.x, nblk = gridDim.x;
    float* mod = WS_F32(OFF_MOD);
    for (int it = bid; it < 256; it += nblk) {
        const int l = it >> 7, n0 = (it & 127) * 96;
        LAS float* sl = (LAS float*)L;
        LAS float* part = sl + 5 * 2048;
        const float* cin = (const float*)a.in[1]; const float* cctx = (const float*)a.in[3];
        for (int i = tid; i < 5 * 2048; i += NTHR) { const int r = i >> 11, k = i & 2047; const float x = r < 4 ? cin[r * 2048 + k] : cctx[k]; sl[i] = x / (1.f + expf(-x)); }
        __syncthreads();
        const int ln = lane < 48 ? lane : 47;
        const float* W = (const float*)a.in[4] + (size_t)l * 2048 * 12288 + n0 + 2 * ln;
        float acc0[5], acc1[5];
#pragma unroll
        for (int r = 0; r < 5; ++r) { acc0[r] = 0.f; acc1[r] = 0.f; }
        const int kb = wave * 256;
#pragma unroll 8
        for (int k = 0; k < 256; ++k) { const f32x2 wv = *(const f32x2*)(W + (size_t)(kb + k) * 12288);
#pragma unroll
            for (int r = 0; r < 5; ++r) { const float s = sl[r * 2048 + kb + k]; acc0[r] += s * wv.x; acc1[r] += s * wv.y; } }
        if (lane < 48) {
#pragma unroll
            for (int r = 0; r < 5; ++r) { part[(wave * 5 + r) * 96 + 2 * lane] = acc0[r]; part[(wave * 5 + r) * 96 + 2 * lane + 1] = acc1[r]; } }
        __syncthreads();
        const float* ab = (const float*)a.in[5] + (size_t)l * 12288 + n0;
        for (int i = tid; i < 480; i += NTHR) { const int r = i / 96, c = i - r * 96; float s = 0.f;
#pragma unroll
            for (int w = 0; w < 8; ++w) s += part[(w * 5 + r) * 96 + c];
            mod[(size_t)(l * 5 + r) * 12288 + n0 + c] = s + ab[c]; }
        __syncthreads();
    }
    if (bid == nblk - 1) {
        f32x2* tab = (f32x2*)(a.ws + OFF_ROPE);
        for (int i = tid; i < 1024; i += NTHR) { const int pos = i >> 4, f = i & 15; const float inv = powf(10000.f, -(float)f * 0.0625f); const float ang = (float)pos * inv;
            f32x2 cs; cs.x = cosf(ang); cs.y = sinf(ang); tab[i] = cs; }
    }
}
__device__ __forceinline__ void ph_l0_weights(const Args& a, LAS unsigned char* L) {
    const int tid = threadIdx.x, lane = tid & 63, wave = tid >> 6, bid = blockIdx.x, nblk = gridDim.x;
    { u32x4* z = (u32x4*)(a.ws + WT_ABIN + (size_t)4800 * DM * 2); const u32x4 zero = {0u, 0u, 0u, 0u};
      for (int i = bid * NTHR + tid; i < 64 * DM * 2 / 16; i += nblk * NTHR) z[i] = zero; }
    LAS float* scr = (LAS float*)(L + wave * 16384);
    const int gw = bid * 8 + wave, NGW = nblk * 8;
    constexpr int I0 = 32 * 150, I1 = 32 * 64, I2 = 32 * 256, I3 = 128 * 64;
    constexpr int NITEMS = I0 + I1 + I2 + I3;
    for (int it = gw; it < NITEMS; it += NGW) {
        int r = it;
        if (r < I0) { p0_transpose_item((const float*)a.in[9], 2048, 4800, WS_BF(WT_ABIN), scr, r, lane); continue; } r -= I0;
        if (r < I1) { p0_transpose_item((const float*)a.in[10], 2048, 2048, WS_BF(WT_ABOUT), scr, r, lane); continue; } r -= I1;
        if (r < I2) { p0_transpose_item((const float*)a.in[6], 2048, 8192, WS_BF(WT_W1_0), scr, r, lane); continue; } r -= I2;
        p0_transpose_item((const float*)a.in[7], 8192, 2048, WS_BF(WT_W2_0), scr, r, lane);
    }
}
__device__ __forceinline__ void ph_l1_weights(const Args& a, LAS unsigned char* L, int ws, int nw) {
    const int lane = threadIdx.x & 63, gw = blockIdx.x * nw + ws, NGW = gridDim.x * nw;
    LAS float* scr = (LAS float*)(L + 65536 + ws * 10240);
    constexpr int I1 = 32 * 64, I2 = 32 * 256, I3 = 128 * 64;
    constexpr int NITEMS = I2 + I1 + I2 + I3;
    for (int it = gw; it < NITEMS; it += NGW) {
        int r = it;
        if (r < I2) { p0_transpose_item<true>((const float*)a.in[23], 2048, 8192, WS_BF(WT_CDIN), scr, r, lane); continue; } r -= I2;
        if (r < I1) { p0_transpose_item((const float*)a.in[24], 2048, 2048, WS_BF(WT_CDOUT), scr, r, lane); continue; } r -= I1;
        if (r < I2) { p0_transpose_item((const float*)a.in[6] + (size_t)2048 * 8192, 2048, 8192, WS_BF(WT_W1_1), scr, r, lane); continue; } r -= I2;
        p0_transpose_item((const float*)a.in[7] + (size_t)8192 * 2048, 8192, 2048, WS_BF(WT_W2_1), scr, r, lane);
    }
}

__device__ __forceinline__ float bfu(const bf16_t* p) { return __uint_as_float((unsigned)*p << 16); }
__device__ __forceinline__ f32x4 bf4(const bf16_t* p) { const u32x2 w = *(const u32x2*)p; return (f32x4){__uint_as_float(w.x << 16), __uint_as_float(w.x & 0xffff0000u), __uint_as_float(w.y << 16), __uint_as_float(w.y & 0xffff0000u)}; }
__device__ __forceinline__ void ph_modulate(const float* srcL, float* srcC, int nrows, const float* modl, int ish, int isc, bf16_t* HN,
                                            const bf16_t* comb = nullptr, const float* combBase = nullptr, const float* combGate = nullptr) {
    const int tid = threadIdx.x, lane = tid & 63, wave = tid >> 6, gw = blockIdx.x * 8 + wave, NGW = gridDim.x * 8;
    for (int m = gw; m < nrows; m += NGW) {
        const float* xr = (m < 8192 ? srcL + (size_t)m * 2048 : srcC + (size_t)(m - 8192) * 2048) + 4 * lane;
        const int rg = m < 8192 ? (m >> 11) : 4;
        const float* sh = modl + (size_t)rg * 12288 + ish * 2048 + 4 * lane; const float* sc = modl + (size_t)rg * 12288 + isc * 2048 + 4 * lane;
        f32x4 v[8]; float ss = 0.f;
        if (comb != nullptr && m >= 8192) {
            const size_t so = (size_t)(m - 8192) * 2048 + 4 * lane;
#pragma unroll
            for (int j = 0; j < 8; ++j) { f32x4 s = bf4(comb + so + 256 * j);
#pragma unroll
                for (int k = 1; k < 8; ++k) s = s + bf4(comb + (size_t)k * MC * DM + so + 256 * j);
                v[j] = *(const f32x4*)(combBase + so + 256 * j) + *(const f32x4*)(combGate + 4 * lane + 256 * j) * s;
                *(f32x4*)(srcC + so + 256 * j) = v[j]; }
        } else {
#pragma unroll
            for (int j = 0; j < 8; ++j) v[j] = *(const f32x4*)(xr + 256 * j);
        }
#pragma unroll
        for (int j = 0; j < 8; ++j) ss += (v[j].x * v[j].x + v[j].y * v[j].y) + (v[j].z * v[j].z + v[j].w * v[j].w);
        const float rstd = rsqrtf(wave_sum(ss) * (1.f / 2048.f) + 1e-6f);
        bf16_t* op = HN + (size_t)m * 2048 + 4 * lane;
#pragma unroll
        for (int j = 0; j < 8; ++j) { const f32x4 s4 = *(const f32x4*)(sc + 256 * j), h4 = *(const f32x4*)(sh + 256 * j);
            const f32x4 o = v[j] * rstd * (s4 + 1.f) + h4; u32x2 w; w.x = pk2(o.x, o.y); w.y = pk2(o.z, o.w); *(u32x2*)(op + 256 * j) = w; }
    }
}

__device__ __forceinline__ void ph_final(const Args& a) {
    const int tid = threadIdx.x, lane = tid & 63, wave = tid >> 6, gw = blockIdx.x * 8 + wave, NGW = gridDim.x * 8;
    const float* fn = (const float*)a.in[8] + 4 * lane;
    for (int m = gw; m < ML; m += NGW) {
        float* xr = a.out + (size_t)m * 2048 + 4 * lane;
        f32x4 v[8]; float ss = 0.f;
#pragma unroll
        for (int j = 0; j < 8; ++j) { v[j] = *(const f32x4*)(xr + 256 * j); ss += (v[j].x * v[j].x + v[j].y * v[j].y) + (v[j].z * v[j].z + v[j].w * v[j].w); }
        const float rstd = rsqrtf(wave_sum(ss) * (1.f / 2048.f) + 1e-6f);
#pragma unroll
        for (int j = 0; j < 8; ++j) { const f32x4 w4 = *(const f32x4*)(fn + 256 * j); *(f32x4*)(xr + 256 * j) = v[j] * rstd * w4; }
    }
}

struct CpIn { float wv[16], rv[16], kv[16], av[16], bv[16]; };
__device__ __forceinline__ void chunk_prep_load(const Args& a, CpIn& in, int d, int b, int h, int TBi);
template <bool NEXT> __device__ __forceinline__ void chunk_prep_problem(const Args& a, LAS unsigned char* L, CpIn& in, int d, int b, int h, int TBi, int nb, int nTBi);
__device__ __forceinline__ float shifted(const bf16_t* U, int m, int col, int seq_lo, int seq_hi, float mu) {
    const float uc = bfu(U + (size_t)m * ABINP + col);
    const float up = m > seq_lo ? bfu(U + (size_t)(m - 1) * ABINP + col) : 0.f;
    const float un = m + 1 < seq_hi ? bfu(U + (size_t)(m + 1) * ABINP + col) : 0.f;
    return uc + mu * (0.5f * (up + un) - uc);
}
__device__ __forceinline__ void ph_rwkv_prep(const Args& a, LAS unsigned char* L) {
    const int tid = threadIdx.x, lane = tid & 63, wave = tid >> 6, bid = blockIdx.x, nblk = gridDim.x;
    const bf16_t* U = AR_BF(A_U0);
    const float* mu = (const float*)a.in[11];
    const float* w0 = (const float*)a.in[12]; const float* w_up = (const float*)a.in[13]; const float* a0 = (const float*)a.in[14];
    const float* a_up = (const float*)a.in[15]; const float* g_up = (const float*)a.in[16]; const float* k_k = (const float*)a.in[17];
    const float* k_a = (const float*)a.in[18]; const float* r_k = (const float*)a.in[19];
    float* PWF = AR_F32(A_PREP); float* PWB = PWF + (size_t)MT * 1024; float* PR = PWB + (size_t)MT * 1024;
    float* PA = PR + (size_t)MT * 1024; float* PB = PA + (size_t)MT * 1024; float* PK = PB + (size_t)MT * 1024; float* PV = PK + (size_t)MT * 1024;
    bf16_t* PG = (bf16_t*)((unsigned char*)a.out + DO_G); float* SCAL = (float*)((unsigned char*)a.out + DO_SCAL);
    LAS float* lowr = (LAS float*)L;
    LAS float* res = lowr + 32 * 196;
    const int slab = bid & 7, q = tid >> 7, cl = tid & 127, c = slab * 128 + cl;
    const int qw = wave >> 1, chw = slab * 128 + (wave & 1) * 64, fr_ = lane & 15, g_ = lane >> 4;
    const float* wsrc = qw == 0 ? w_up : (qw == 1 ? w_up + 64 * 1024 : (qw == 2 ? a_up : g_up));
    bf16x8 wh[4][2], wl[4][2];
#pragma unroll
    for (int nt = 0; nt < 4; ++nt)
#pragma unroll
        for (int ks = 0; ks < 2; ++ks)
#pragma unroll
            for (int e = 0; e < 8; ++e) { const float wv = wsrc[(size_t)(32 * ks + 8 * g_ + e) * 1024 + chw + 16 * nt + fr_];
                const unsigned hb = f2bf(wv); const float hf = __uint_as_float(hb << 16); wh[nt][ks][e] = (short)hb; wl[nt][ks][e] = (short)f2bf(wv - hf); }
    const float mu_r = mu[c], mu_k = mu[1024 + c], mu_v = mu[2048 + c];
    const float w0f = w0[c], w0b = w0[1024 + c], a0c = a0[c], kkc = k_k[c], kac = k_a[c], rkc = r_k[c];
    const int ivw = qw < 2 ? 0 : qw - 1;
    DS_INIT();
    for (int tile = bid >> 3; tile < MT / 32; tile += (nblk >> 3)) {
        const int m0 = tile * 32; DS(0);
        const int seq_lo = m0 < 8192 ? (m0 & ~2047) : 8192 + ((m0 - 8192) & ~255);
        const int seq_hi = m0 < 8192 ? seq_lo + 2048 : seq_lo + 256;
        {
          f32x4 uc[3], up[3], un[3]; const f32x4 z4 = {0.f, 0.f, 0.f, 0.f};
#pragma unroll
          for (int e = 0; e < 3; ++e) { const int idx = tid + NTHR * e, tt = idx / 48, jq = idx - tt * 48, m = m0 + tt; const bf16_t* p = U + (size_t)m * ABINP + 3072 + 4 * jq;
              uc[e] = bf4(p); up[e] = m > seq_lo ? bf4(p - ABINP) : z4; un[e] = m + 1 < seq_hi ? bf4(p + ABINP) : z4; }
#pragma unroll
          for (int e = 0; e < 3; ++e) { const int idx = tid + NTHR * e, tt = idx / 48, jq = idx - tt * 48, j = 4 * jq;
              const f32x4 mu4 = *(const f32x4*)(mu + 3072 + j); const f32x4 us = uc[e] + mu4 * ((up[e] + un[e]) * 0.5f - uc[e]); f32x4 o;
#pragma unroll
              for (int q4 = 0; q4 < 4; ++q4) o[q4] = j < 64 ? tanhf(us[q4]) : (j < 128 ? us[q4] : 1.f / (1.f + __expf(-us[q4])));
              *(LAS f32x4*)(lowr + tt * 196 + j) = o; } }
        __syncthreads(); DS(1);
#pragma unroll
        for (int mt = 0; mt < 2; ++mt) { f32x4 acc4[4];
#pragma unroll
            for (int nt = 0; nt < 4; ++nt) acc4[nt] = (f32x4){0.f, 0.f, 0.f, 0.f};
#pragma unroll
            for (int ks = 0; ks < 2; ++ks) { const LAS float* xp = lowr + (mt * 16 + fr_) * 196 + ivw * 64 + 32 * ks + 8 * g_;
                const f32x4 x0 = *(const LAS f32x4*)xp, x1 = *(const LAS f32x4*)(xp + 4); const float xs[8] = {x0.x, x0.y, x0.z, x0.w, x1.x, x1.y, x1.z, x1.w};
                bf16x8 xh, xl;
#pragma unroll
                for (int e = 0; e < 8; ++e) { const unsigned hb = f2bf(xs[e]); xh[e] = (short)hb; xl[e] = (short)f2bf(xs[e] - __uint_as_float(hb << 16)); }
#pragma unroll
                for (int nt = 0; nt < 4; ++nt) { acc4[nt] = __builtin_amdgcn_mfma_f32_16x16x32_bf16(xh, wh[nt][ks], acc4[nt], 0, 0, 0);
                    acc4[nt] = __builtin_amdgcn_mfma_f32_16x16x32_bf16(xh, wl[nt][ks], acc4[nt], 0, 0, 0); acc4[nt] = __builtin_amdgcn_mfma_f32_16x16x32_bf16(xl, wh[nt][ks], acc4[nt], 0, 0, 0); } }
#pragma unroll
            for (int nt = 0; nt < 4; ++nt)
#pragma unroll
                for (int r = 0; r < 4; ++r) res[(qw * 32 + mt * 16 + 4 * g_ + r) * 128 + (wave & 1) * 64 + 16 * nt + fr_] = acc4[nt][r]; }
        __syncthreads(); DS(2);
        const int h = c >> 6;
        { const int cq = tid & 31, c4 = slab * 128 + 4 * cq, hq = c4 >> 6;
          const f32x4 z4 = {0.f, 0.f, 0.f, 0.f};
          u32x2 raw[9], rawn[9];
#define PB_LOAD(R, i_) do { const int m_ = m0 + (tid >> 5) + 16 * (i_); const bf16_t* p_ = U + (size_t)m_ * ABINP + c4; const bool hp_ = m_ > seq_lo, hn_ = m_ + 1 < seq_hi; const u32x2 z2_ = {0u, 0u}; \
              _Pragma("unroll") for (int q_ = 0; q_ < 3; ++q_) { R[q_] = *(const u32x2*)(p_ + 1024 * q_); R[3 + q_] = hp_ ? *(const u32x2*)(p_ + 1024 * q_ - ABINP) : z2_; R[6 + q_] = hn_ ? *(const u32x2*)(p_ + 1024 * q_ + ABINP) : z2_; } } while (0)
#define PB_F4(w_) ((f32x4){__uint_as_float((w_).x << 16), __uint_as_float((w_).x & 0xffff0000u), __uint_as_float((w_).y << 16), __uint_as_float((w_).y & 0xffff0000u)})
          PB_LOAD(raw, 0);
#pragma unroll 1
          for (int i = 0; i < 2; ++i) { const int tt = (tid >> 5) + 16 * i, m = m0 + tt;
              if (i == 0) PB_LOAD(rawn, 1);
              const f32x4 rc_ = PB_F4(raw[0]), kc_ = PB_F4(raw[1]), vc_ = PB_F4(raw[2]);
              const f32x4 rp_ = PB_F4(raw[3]), kp2_ = PB_F4(raw[4]), vp_ = PB_F4(raw[5]);
              const f32x4 rn_ = PB_F4(raw[6]), kn_ = PB_F4(raw[7]), vn_ = PB_F4(raw[8]);
#pragma unroll
              for (int q_ = 0; q_ < 9; ++q_) raw[q_] = rawn[q_];
              const f32x4 mur4 = *(const f32x4*)(mu + c4), muk4 = *(const f32x4*)(mu + 1024 + c4), muv4 = *(const f32x4*)(mu + 2048 + c4);
              const f32x4 w0f4 = *(const f32x4*)(w0 + c4), w0b4 = *(const f32x4*)(w0 + 1024 + c4), a04 = *(const f32x4*)(a0 + c4), kk4 = *(const f32x4*)(k_k + c4), ka4 = *(const f32x4*)(k_a + c4), rk4 = *(const f32x4*)(r_k + c4);
              const f32x4 r = rc_ + mur4 * ((rp_ + rn_) * 0.5f - rc_), k = kc_ + muk4 * ((kp2_ + kn_) * 0.5f - kc_), v = vc_ + muv4 * ((vp_ + vn_) * 0.5f - vc_);
              const f32x4 pwf = w0f4 + *(const LAS f32x4*)(res + (0 * 32 + tt) * 128 + 4 * cq), pwb = w0b4 + *(const LAS f32x4*)(res + (1 * 32 + tt) * 128 + 4 * cq);
              const f32x4 pal = a04 + *(const LAS f32x4*)(res + (2 * 32 + tt) * 128 + 4 * cq), g4 = *(const LAS f32x4*)(res + (3 * 32 + tt) * 128 + 4 * cq);
              f32x4 decf, decb, alr;
#pragma unroll
              for (int e2 = 0; e2 < 4; ++e2) { decf[e2] = __expf(-0.6065306597126334f / (1.f + __expf(-pwf[e2]))); decb[e2] = __expf(-0.6065306597126334f / (1.f + __expf(-pwb[e2]))); alr[e2] = 1.f / (1.f + __expf(-pal[e2])); }
              const f32x4 kkr = k * kk4; const float ssq = row16_sum((kkr.x * kkr.x + kkr.y * kkr.y) + (kkr.z * kkr.z + kkr.w * kkr.w));
              const f32x4 kk = kkr * (1.f / fmaxf(sqrtf(ssq), 1e-12f));
              const f32x4 kp = k * ((alr - 1.f) * ka4 + 1.f), ap = -kk, bp = kk * alr;
              const f32x4 t1 = bp * r, t2 = kp * r, t3 = t2 * rk4;
              const float br = row16_sum((t1.x + t1.y) + (t1.z + t1.w)), kr = row16_sum((t2.x + t2.y) + (t2.z + t2.w)), rkr = row16_sum((t3.x + t3.y) + (t3.z + t3.w));
              const size_t o = (size_t)m * 1024 + c4;
              *(f32x4*)(PWF + o) = decf; *(f32x4*)(PWB + o) = decb; *(f32x4*)(PV + o) = v;
              { u32x2 w; w.x = pk2(r.x, r.y); w.y = pk2(r.z, r.w); *(u32x2*)((bf16_t*)PR + o) = w; w.x = pk2(ap.x, ap.y); w.y = pk2(ap.z, ap.w); *(u32x2*)((bf16_t*)PA + o) = w;
                w.x = pk2(bp.x, bp.y); w.y = pk2(bp.z, bp.w); *(u32x2*)((bf16_t*)PB + o) = w; w.x = pk2(kp.x, kp.y); w.y = pk2(kp.z, kp.w); *(u32x2*)((bf16_t*)PK + o) = w; }
              { u32x2 w; w.x = pk2(g4.x, g4.y); w.y = pk2(g4.z, g4.w); *(u32x2*)(PG + o) = w; }
              if ((cq & 15) == 0) { f32x4 s4; s4.x = br; s4.y = kr; s4.z = rkr; s4.w = 0.f; *(f32x4*)(SCAL + ((size_t)m * 16 + hq) * 4) = s4; } }
#undef PB_LOAD
#undef PB_F4
        }
        __syncthreads(); DS(3);
    }
    { const int hh = slab * 2 + (wave & 1), d_ = wave >> 2, tbo = (wave >> 1) & 1, tstep = nblk >> 3;
      auto tile_b = [&](int tile) { const int m0 = tile * 32; return m0 < 8192 ? (m0 >> 11) : ((m0 - 8192) >> 8); };
      auto tile_tb = [&](int tile) { const int m0 = tile * 32; return m0 < 8192 ? 16 + (((m0 & 2047) >> 4) + tbo) : (((m0 - 8192) & 255) >> 4) + tbo; };
      CpIn cin; int tile = bid >> 3;
      if (tile < MT / 32) chunk_prep_load(a, cin, d_, tile_b(tile), hh, tile_tb(tile));
      for (; tile < MT / 32; tile += tstep) {
          if (tile + tstep < MT / 32) chunk_prep_problem<true>(a, L, cin, d_, tile_b(tile), hh, tile_tb(tile), tile_b(tile + tstep), tile_tb(tile + tstep));
          else chunk_prep_problem<false>(a, L, cin, d_, tile_b(tile), hh, tile_tb(tile), 0, 0); } }
    __syncthreads(); DS(4);
    const f32x2* tab = (const f32x2*)(a.ws + OFF_ROPE);
    bf16_t* SQ = (bf16_t*)((unsigned char*)a.out + DO_SQ); bf16_t* SK = (bf16_t*)((unsigned char*)a.out + DO_SK); bf16_t* SV = (bf16_t*)((unsigned char*)a.out + DO_SV);
    const int gw = bid * 8 + wave, NGW = nblk * 8;
    for (int m = gw; m < MT; m += NGW) {
        const bf16_t* ur = U + (size_t)m * ABINP; const bool lat = m < 8192; const int t = m & 2047, prow = t >> 6, pcol = t & 63;
        float x1[10], x2[10];
#pragma unroll
        for (int i = 0; i < 10; ++i) { const int p = lane + 64 * i, hd = p >> 5, ii = p & 31; const int base = hd < 16 ? 3264 + hd * 64 : 4288 + (hd - 16) * 64;
            x1[i] = bfu(ur + base + ii); x2[i] = bfu(ur + base + 32 + ii); }
        const u32x2 vraw = *(const u32x2*)(ur + 4544 + 4 * lane);
#pragma unroll
        for (int i = 0; i < 10; ++i) { const int p = lane + 64 * i, hd = p >> 5, ii = p & 31;
            float o1 = x1[i], o2 = x2[i];
            if (lat) { const f32x2 cs = tab[(ii < 16 ? prow : pcol) * 16 + (ii & 15)]; o1 = x1[i] * cs.x - x2[i] * cs.y; o2 = x1[i] * cs.y + x2[i] * cs.x; }
            bf16_t* dst = hd < 16 ? SQ + (size_t)m * 1024 + hd * 64 : SK + (size_t)m * 256 + (hd - 16) * 64;
            dst[ii] = (bf16_t)f2bf(o1); dst[32 + ii] = (bf16_t)f2bf(o2); }
        *(u32x2*)(SV + (size_t)m * 256 + 4 * lane) = vraw;
    }
    DS(6);
}

constexpr int OP_AT = 0, OP_RT = 2048, OP_BT = 4096, OP_KT = 6144, OP_G1T = 8192, OP_MBRT = 8704, OP_MKRT = 9216, OP_PL = 9728;
__device__ __forceinline__ void chunk_prep_load(const Args& a, CpIn& in, int d, int b, int h, int TBi) {
    const int lane = threadIdx.x & 63;
    const float* P0 = AR_F32(A_PREP);
    const int base = TBi < 16 ? 8192 + b * 256 + 16 * TBi : b * 2048 + 16 * (TBi - 16);
    const float* pw = P0 + (size_t)(d ? 1 : 0) * MT * 1024 + h * 64 + lane; const bf16_t* pr = (const bf16_t*)(P0 + (size_t)2 * MT * 1024) + h * 64 + lane;
    const bf16_t* pa = (const bf16_t*)(P0 + (size_t)3 * MT * 1024) + h * 64 + lane; const bf16_t* pb = (const bf16_t*)(P0 + (size_t)4 * MT * 1024) + h * 64 + lane; const bf16_t* pk = (const bf16_t*)(P0 + (size_t)5 * MT * 1024) + h * 64 + lane;
#pragma unroll
    for (int j = 0; j < 16; ++j) { const size_t mo = (size_t)(base + (d ? 15 - j : j)) * 1024;
        in.wv[j] = pw[mo]; in.rv[j] = bfu(pr + mo); in.kv[j] = bfu(pk + mo); in.av[j] = bfu(pa + mo); in.bv[j] = bfu(pb + mo); }
}
template <bool NEXT>
__device__ __forceinline__ void chunk_prep_problem(const Args& a, LAS unsigned char* L, CpIn& in, int d, int b, int h, int TBi, int nb, int nTBi) {
    const int tid = threadIdx.x, lane = tid & 63, wave = tid >> 6, fr = lane & 15, g = lane >> 4;
    unsigned char* OPS = a.ws + OFF_ARENA + A_OPS;
    LAS bf16_t* Abf = (LAS bf16_t*)(L + wave * 13312); LAS bf16_t* Rbf = Abf + 16 * 72; LAS bf16_t* Bbf = Rbf + 16 * 72; LAS bf16_t* Kbf = Bbf + 16 * 72;
    LAS bf16_t* ATr = Kbf + 16 * 72;
    LAS float* NabL = (LAS float*)(ATr + 64 * 16);
    LAS bf16_t* NakL = (LAS bf16_t*)(NabL + 256);
    LAS bf16_t* TT = NakL + 256;
    const bf16x8 zero8 = {0, 0, 0, 0, 0, 0, 0, 0};
    {
        const int chain = d * 64 + b * 16 + h;
        const int c = TBi < 16 ? (d ? 15 - TBi : TBi) : 16 + (d ? 127 - (TBi - 16) : TBi - 16);
        unsigned char* op = OPS + (size_t)(chain * 144 + c) * OPSZ;
        float P = 1.f; unsigned apk[8], bpk[8], kpk[8];
        {
#pragma unroll
            for (int j = 0; j < 16; ++j) { const float Pp = P; P *= in.wv[j]; const float inv = 1.f / P;
                const unsigned ah = f2bf(in.av[j] * Pp), rh = f2bf(in.rv[j] * P), bh_ = f2bf(in.bv[j] * inv), kh = f2bf(in.kv[j] * inv);
                Abf[j * 72 + lane] = (bf16_t)ah; Rbf[j * 72 + lane] = (bf16_t)rh; Bbf[j * 72 + lane] = (bf16_t)bh_; Kbf[j * 72 + lane] = (bf16_t)kh;
                ((bf16_t*)(op + OP_RT))[j * 64 + lane] = (bf16_t)rh;
                if (j & 1) { apk[j >> 1] |= ah << 16; bpk[j >> 1] |= bh_ << 16; kpk[j >> 1] |= kh << 16; } else { apk[j >> 1] = ah; bpk[j >> 1] = bh_; kpk[j >> 1] = kh; } } }
        *(LAS u32x4*)(ATr + lane * 16) = (u32x4){apk[0], apk[1], apk[2], apk[3]}; *(LAS u32x4*)(ATr + lane * 16 + 8) = (u32x4){apk[4], apk[5], apk[6], apk[7]};
        *(u32x4*)(op + OP_BT + lane * 32) = (u32x4){bpk[0], bpk[1], bpk[2], bpk[3]}; *(u32x4*)(op + OP_BT + lane * 32 + 16) = (u32x4){bpk[4], bpk[5], bpk[6], bpk[7]};
        *(u32x4*)(op + OP_KT + lane * 32) = (u32x4){kpk[0], kpk[1], kpk[2], kpk[3]}; *(u32x4*)(op + OP_KT + lane * 32 + 16) = (u32x4){kpk[4], kpk[5], kpk[6], kpk[7]};
        ((float*)(op + OP_PL))[lane] = P;
        if (NEXT) chunk_prep_load(a, in, d, nb, h, nTBi);
        f32x4 nab = {0.f, 0.f, 0.f, 0.f}, nak = nab, mbr = nab, mkr = nab;
#pragma unroll
        for (int ks = 0; ks < 2; ++ks) { const int o = fr * 72 + 32 * ks + 8 * g;
            const bf16x8 fb = *(const LAS bf16x8*)(Bbf + o), fk = *(const LAS bf16x8*)(Kbf + o), fa = *(const LAS bf16x8*)(Abf + o), frr = *(const LAS bf16x8*)(Rbf + o);
            nab = __builtin_amdgcn_mfma_f32_16x16x32_bf16(fb, fa, nab, 0, 0, 0); nak = __builtin_amdgcn_mfma_f32_16x16x32_bf16(fk, fa, nak, 0, 0, 0);
            mbr = __builtin_amdgcn_mfma_f32_16x16x32_bf16(fb, frr, mbr, 0, 0, 0); mkr = __builtin_amdgcn_mfma_f32_16x16x32_bf16(fk, frr, mkr, 0, 0, 0); }
#pragma unroll
        for (int r = 0; r < 4; ++r) { const int j = 4 * g + r; if (!(j < fr)) { nab[r] = 0.f; nak[r] = 0.f; } if (!(j <= fr)) { mbr[r] = 0.f; mkr[r] = 0.f; }
            NabL[j * 16 + fr] = nab[r]; NakL[j * 16 + fr] = (bf16_t)f2bf(nak[r]); }
        { u32x2 w; w.x = pk2(mbr[0], mbr[1]); w.y = pk2(mbr[2], mbr[3]); *(u32x2*)(op + OP_MBRT + (fr * 16 + 4 * g) * 2) = w;
          w.x = pk2(mkr[0], mkr[1]); w.y = pk2(mkr[2], mkr[3]); *(u32x2*)(op + OP_MKRT + (fr * 16 + 4 * g) * 2) = w; }
        { float Tr[16];
#pragma unroll
          for (int t = 0; t < 16; ++t) { float acc = fr == t ? 1.f : 0.f;
#pragma unroll
              for (int j = 0; j < t; ++j) acc += Tr[j] * NabL[j * 16 + t];
              Tr[t] = acc; }
#pragma unroll
          for (int t = 0; t < 16; ++t) TT[t * 16 + fr] = (bf16_t)f2bf(Tr[t]); }
        { const bf16x8 tf = g < 2 ? *(const LAS bf16x8*)(TT + fr * 16 + 8 * g) : zero8;
#pragma unroll
          for (int nt = 0; nt < 4; ++nt) { const bf16x8 af = g < 2 ? *(const LAS bf16x8*)(ATr + (16 * nt + fr) * 16 + 8 * g) : zero8;
              const f32x4 at = __builtin_amdgcn_mfma_f32_16x16x32_bf16(tf, af, (f32x4){0.f, 0.f, 0.f, 0.f}, 0, 0, 0);
#pragma unroll
              for (int r = 0; r < 4; ++r) ((bf16_t*)(op + OP_AT))[(4 * g + r) * 64 + 16 * nt + fr] = (bf16_t)f2bf(at[r]); }
          const bf16x8 nf = g < 2 ? *(const LAS bf16x8*)(NakL + fr * 16 + 8 * g) : zero8;
          const f32x4 g1 = __builtin_amdgcn_mfma_f32_16x16x32_bf16(tf, nf, (f32x4){0.f, 0.f, 0.f, 0.f}, 0, 0, 0);
#pragma unroll
          for (int r = 0; r < 4; ++r) ((bf16_t*)(op + OP_G1T))[(4 * g + r) * 16 + fr] = (bf16_t)f2bf(g1[r]); }
    }
}

__device__ __forceinline__ int chunk_row0(int c, int d, int b) { return c < 16 ? 8192 + b * 256 + (d ? 255 - 16 * c : 16 * c) : b * 2048 + (d ? 2047 - 16 * (c - 16) : 16 * (c - 16)); }
__device__ __forceinline__ int scan_row(int gs, int d, int b) {
    if (gs < 256) { const int t = d ? 255 - gs : gs; return 8192 + b * 256 + t; }
    const int t2 = gs - 256; const int t = d ? 2047 - t2 : t2; return b * 2048 + t;
}
__device__ __forceinline__ void rwkv_scan_chain(const Args& a, LAS unsigned char* L, int unit) {
    const int tid = threadIdx.x, lane = tid & 63, wave = tid >> 6, fr = lane & 15, g = lane >> 4;
    if (wave >= 2) { ph_l1_weights(a, L, wave - 2, 6); return; }
    const int chain = unit >> 1, d = chain >> 6, b = (chain >> 4) & 3, h = chain & 15;
    const int v0 = 16 * (2 * (unit & 1) + wave);
    const unsigned char* OPS = a.ws + OFF_ARENA + A_OPS + (size_t)chain * 144 * OPSZ;
    const float* PV = AR_F32(A_PREP) + (size_t)6 * MT * 1024 + h * 64 + v0 + fr;
    float* Y = AR_F32(d ? A_YB : A_YF) + h * 64 + v0 + fr;
    const int sgn = d ? -1 : 1;
    f32x4 sacc[4];
#pragma unroll
    for (int mt = 0; mt < 4; ++mt) sacc[mt] = (f32x4){0.f, 0.f, 0.f, 0.f};
    LAS unsigned char* Lw = L + wave * 26624;
    int ldo[10];
#pragma unroll
    for (int i = 0; i < 10; ++i) { const int p = lane + 64 * i; int o;
        if (i < 2) o = (p >> 3) * 144 + (p & 7) * 16;
        else if (i < 4) { const int q = p - 128; o = 2304 + (q >> 3) * 144 + (q & 7) * 16; }
        else if (i < 6) { const int q = p - 256; o = 4608 + (q >> 1) * 48 + (q & 1) * 16; }
        else if (i < 8) { const int q = p - 384; o = 7680 + (q >> 1) * 48 + (q & 1) * 16; }
        else if (i == 8) { const int q = p - 512; o = (q < 32 ? 10752 : 11520 - 32 * 24) + (q >> 1) * 48 + (q & 1) * 16; }
        else { const int q = p - 576; o = q < 32 ? 12288 + (q >> 1) * 48 + (q & 1) * 16 : 13056 + (q - 32) * 16; }
        ldo[i] = o; }
    const bool l9 = lane < 48;
#define CS_DECL(P) u32x4 P##s[10]; float P##v[4]
#define CS_LOAD(P, c_) do { const unsigned char* op_ = OPS + (size_t)(c_) * OPSZ + 16 * lane; \
        _Pragma("unroll") for (int i = 0; i < 9; ++i) P##s[i] = *(const u32x4*)(op_ + 1024 * i); \
        if (l9) P##s[9] = *(const u32x4*)(op_ + 9216); \
        { const int r0_ = __builtin_amdgcn_readfirstlane(chunk_row0((c_), d, b)); const float* pv_ = PV + ((ptrdiff_t)r0_ + sgn * (4 * g)) * 1024; \
          _Pragma("unroll") for (int e = 0; e < 4; ++e) P##v[e] = pv_[(ptrdiff_t)sgn * e * 1024]; } } while (0)
#define CS_WRITE(P, slot_) do { LAS unsigned char* sl_ = Lw + (slot_) * 13312; \
        _Pragma("unroll") for (int i = 0; i < 9; ++i) *(LAS u32x4*)(sl_ + ldo[i]) = P##s[i]; \
        if (l9) *(LAS u32x4*)(sl_ + ldo[9]) = P##s[9]; } while (0)
#define CS_FRAG(slot_) const LAS unsigned char* fs_ = Lw + (slot_) * 13312; u32x2 Fat[2][2], Frt[2][2], Fg1, Fmb, Fmk, Fbt[4], Fkt[4]; f32x4 Fpl[4]; \
        _Pragma("unroll") for (int ks = 0; ks < 2; ++ks) _Pragma("unroll") for (int j = 0; j < 2; ++j) { Fat[ks][j] = *(const LAS u32x2*)(fs_ + fr * 144 + (32 * ks + 16 * j + 4 * g) * 2); Frt[ks][j] = *(const LAS u32x2*)(fs_ + 2304 + fr * 144 + (32 * ks + 16 * j + 4 * g) * 2); } \
        Fg1 = *(const LAS u32x2*)(fs_ + 10752 + fr * 48 + 8 * g); Fmb = *(const LAS u32x2*)(fs_ + 11520 + fr * 48 + 8 * g); Fmk = *(const LAS u32x2*)(fs_ + 12288 + fr * 48 + 8 * g); \
        _Pragma("unroll") for (int mt = 0; mt < 4; ++mt) { Fbt[mt] = *(const LAS u32x2*)(fs_ + 4608 + (16 * mt + fr) * 48 + 8 * g); Fkt[mt] = *(const LAS u32x2*)(fs_ + 7680 + (16 * mt + fr) * 48 + 8 * g); \
            Fpl[mt] = *(const LAS f32x4*)(fs_ + 13056 + (16 * mt + 4 * g) * 4); }
#define CS_STEP(P, c_) do { \
        u32x4 sb0, sb1; sb0.x = pk2(sacc[0][0], sacc[0][1]); sb0.y = pk2(sacc[0][2], sacc[0][3]); sb0.z = pk2(sacc[1][0], sacc[1][1]); sb0.w = pk2(sacc[1][2], sacc[1][3]); \
        sb1.x = pk2(sacc[2][0], sacc[2][1]); sb1.y = pk2(sacc[2][2], sacc[2][3]); sb1.z = pk2(sacc[3][0], sacc[3][1]); sb1.w = pk2(sacc[3][2], sacc[3][3]); \
        const bf16x8 sB0 = __builtin_bit_cast(bf16x8, sb0), sB1 = __builtin_bit_cast(bf16x8, sb1); \
        const u32x4 a0_ = {P##at[0][0].x, P##at[0][0].y, P##at[0][1].x, P##at[0][1].y}, a1_ = {P##at[1][0].x, P##at[1][0].y, P##at[1][1].x, P##at[1][1].y}; \
        const u32x4 r0_ = {P##rt[0][0].x, P##rt[0][0].y, P##rt[0][1].x, P##rt[0][1].y}, r1_ = {P##rt[1][0].x, P##rt[1][0].y, P##rt[1][1].x, P##rt[1][1].y}; \
        f32x4 w1 = __builtin_amdgcn_mfma_f32_16x16x32_bf16(__builtin_bit_cast(bf16x8, a0_), sB0, (f32x4){0.f, 0.f, 0.f, 0.f}, 0, 0, 0); \
        w1 = __builtin_amdgcn_mfma_f32_16x16x32_bf16(__builtin_bit_cast(bf16x8, a1_), sB1, w1, 0, 0, 0); \
        f32x4 y1 = __builtin_amdgcn_mfma_f32_16x16x32_bf16(__builtin_bit_cast(bf16x8, r0_), sB0, (f32x4){0.f, 0.f, 0.f, 0.f}, 0, 0, 0); \
        y1 = __builtin_amdgcn_mfma_f32_16x16x32_bf16(__builtin_bit_cast(bf16x8, r1_), sB1, y1, 0, 0, 0); \
        const unsigned vp0 = pk2(P##vv[0], P##vv[1]), vp1 = pk2(P##vv[2], P##vv[3]); \
        const u32x4 gA = {P##g1.x, P##g1.y, 0u, 0u}, vB = {vp0, vp1, 0u, 0u}; \
        const f32x4 u = __builtin_amdgcn_mfma_f32_16x16x32_bf16(__builtin_bit_cast(bf16x8, gA), __builtin_bit_cast(bf16x8, vB), w1, 0, 0, 0); \
        const u32x4 uvB = {pk2(u[0], u[1]), pk2(u[2], u[3]), vp0, vp1}; const u32x4 mA = {P##mb.x, P##mb.y, P##mk.x, P##mk.y}; \
        const f32x4 y = __builtin_amdgcn_mfma_f32_16x16x32_bf16(__builtin_bit_cast(bf16x8, mA), __builtin_bit_cast(bf16x8, uvB), y1, 0, 0, 0); \
        _Pragma("unroll") for (int mt = 0; mt < 4; ++mt) { const u32x4 bA = {P##bt[mt].x, P##bt[mt].y, P##kt[mt].x, P##kt[mt].y}; \
            sacc[mt] = __builtin_amdgcn_mfma_f32_16x16x32_bf16(__builtin_bit_cast(bf16x8, bA), __builtin_bit_cast(bf16x8, uvB), sacc[mt], 0, 0, 0); sacc[mt] = sacc[mt] * P##pl[mt]; } \
        { const int r0_ = __builtin_amdgcn_readfirstlane(chunk_row0((c_), d, b)); float* py_ = Y + ((ptrdiff_t)r0_ + sgn * (4 * g)) * 1024; \
          _Pragma("unroll") for (int r = 0; r < 4; ++r) py_[(ptrdiff_t)sgn * r * 1024] = y[r]; } } while (0)
    CS_DECL(A); CS_DECL(B); float Fvv[4], vnx[4];
    CS_LOAD(A, 0); CS_LOAD(B, 1); CS_WRITE(A, 0);
#pragma unroll
    for (int e = 0; e < 4; ++e) Fvv[e] = Av[e];
    CS_LOAD(A, 2);
#define CS_ITER(P, c_) do { CS_WRITE(P, ((c_) + 1) & 1); _Pragma("unroll") for (int e = 0; e < 4; ++e) vnx[e] = P##v[e]; \
        if ((c_) + 3 < 144) CS_LOAD(P, (c_) + 3); \
        { CS_FRAG((c_) & 1); CS_STEP(F, c_); } \
        _Pragma("unroll") for (int e = 0; e < 4; ++e) Fvv[e] = vnx[e]; } while (0)
    for (int c = 0; c < 144; c += 2) { CS_ITER(B, c); CS_ITER(A, c + 1); }
#undef CS_ITER
#undef CS_WRITE
#undef CS_FRAG
#undef CS_DECL
#undef CS_LOAD
#undef CS_STEP
}

__device__ __forceinline__ void rwkv_post_rows(const Args& a, int m0, int m1) {
    const int tid = threadIdx.x, lane = tid & 63, wave = tid >> 6;
    const float* YF = AR_F32(A_YF); const float* YB = AR_F32(A_YB); const float* PV = AR_F32(A_PREP) + (size_t)6 * MT * 1024;
    const bf16_t* PG = (const bf16_t*)((const unsigned char*)a.out + DO_G); const float* SCAL = (const float*)((const unsigned char*)a.out + DO_SCAL); bf16_t* YA = AR_BF(A_YA);
    const float* lnw = (const float*)a.in[20]; const float* lnb = (const float*)a.in[21];
    for (int m = m0 + wave; m < m1; m += 8) {
        f32x4 yf[4], yb[4], pv[4]; u32x2 pg[4]; float rk[4];
#pragma unroll
        for (int q = 0; q < 4; ++q) { const size_t o = (size_t)m * 1024 + 256 * q + 4 * lane;
            yf[q] = *(const f32x4*)(YF + o); yb[q] = *(const f32x4*)(YB + o); pv[q] = *(const f32x4*)(PV + o); pg[q] = *(const u32x2*)(PG + o);
            rk[q] = SCAL[((size_t)m * 16 + 4 * q + (lane >> 4)) * 4 + 2]; }
#pragma unroll
        for (int q = 0; q < 4; ++q) { const int c = 256 * q + 4 * lane; const f32x4 y = yf[q] + yb[q];
            const float mean = row16_sum((y.x + y.y) + (y.z + y.w)) * (1.f / 64.f); const f32x4 dl = y - mean;
            const float var = row16_sum((dl.x * dl.x + dl.y * dl.y) + (dl.z * dl.z + dl.w * dl.w)) * (1.f / 64.f); const float rs = rsqrtf(var + 64e-5f);
            const f32x4 w4 = *(const f32x4*)(lnw + c), b4 = *(const f32x4*)(lnb + c);
            const f32x4 g4 = {__uint_as_float(pg[q].x << 16), __uint_as_float(pg[q].x & 0xffff0000u), __uint_as_float(pg[q].y << 16), __uint_as_float(pg[q].y & 0xffff0000u)};
            const f32x4 o4 = (dl * rs * w4 + b4 + pv[q] * rk[q]) * g4;
            u32x2 w; w.x = pk2(o4.x, o4.y); w.y = pk2(o4.z, o4.w); *(u32x2*)(YA + (size_t)m * 2048 + c) = w; }
    }
}

struct AttnSeg { const bf16_t* K; const bf16_t* V; int n; };
typedef short v4i16_t __attribute__((ext_vector_type(4)));
__device__ __forceinline__ bf16x8 tr_frag(const LAS bf16_t* p0, const LAS bf16_t* p1) {
    const v4i16_t lo = __builtin_amdgcn_ds_read_tr16_b64_v4i16((LAS v4i16_t*)p0), hi = __builtin_amdgcn_ds_read_tr16_b64_v4i16((LAS v4i16_t*)p1);
    return (bf16x8){lo[0], lo[1], lo[2], lo[3], hi[0], hi[1], hi[2], hi[3]};
}
__device__ __forceinline__ float gmax4(float x) {
    float p = x, q = x;
    asm volatile("s_nop 1\n\tv_permlane16_swap_b32 %0, %1\n\ts_nop 1\n\tv_max_f32 %0, %0, %1\n\tv_mov_b32 %1, %0\n\ts_nop 1\n\tv_permlane32_swap_b32 %0, %1\n\ts_nop 1\n\tv_max_f32 %0, %0, %1" : "+v"(p), "+v"(q));
    return p;
}
__device__ __forceinline__ float max17(float m0, const f32x4& a, const f32x4& b, const f32x4& c2, const f32x4& d) {
    float r;
    asm("v_max3_f32 %0, %1, %2, %3\n\tv_max3_f32 %0, %0, %4, %5\n\tv_max3_f32 %0, %0, %6, %7\n\tv_max3_f32 %0, %0, %8, %9\n\t"
        "v_max3_f32 %0, %0, %10, %11\n\tv_max3_f32 %0, %0, %12, %13\n\tv_max3_f32 %0, %0, %14, %15\n\tv_max3_f32 %0, %0, %16, %17"
        : "=&v"(r) : "v"(m0), "v"(a[0]), "v"(a[1]), "v"(a[2]), "v"(a[3]), "v"(b[0]), "v"(b[1]), "v"(b[2]), "v"(b[3]), "v"(c2[0]), "v"(c2[1]), "v"(c2[2]), "v"(c2[3]), "v"(d[0]), "v"(d[1]), "v"(d[2]), "v"(d[3]));
    return r;
}
__device__ __forceinline__ float max3f(float a, float b, float c2) { float r; asm("v_max3_f32 %0, %1, %2, %3" : "=v"(r) : "v"(a), "v"(b), "v"(c2)); return r; }
__device__ __forceinline__ float gsum4(float x) {
    { float p = x, q = x; asm volatile("s_nop 1\n\tv_permlane16_swap_b32 %0, %1" : "+v"(p), "+v"(q)); x = p + q; }
    { float p = x, q = x; asm volatile("s_nop 1\n\tv_permlane32_swap_b32 %0, %1" : "+v"(p), "+v"(q)); x = p + q; }
    return x;
}
template <bool B> struct BoolC { static constexpr bool value = B; };
template <int DV, int NSUB>
__device__ __forceinline__ void attn_unit(LAS unsigned char* L, const bf16_t* Q, int q_stride, AttnSeg sg0, AttnSeg sg1, int k_stride, int v_stride,
                                          bool masked, int qpos0, int kpos0, bool has_sink, float sink, float lmb, const float* subln, float post_scale,
                                          bf16_t* O, int o_stride, unsigned long long* dsp = nullptr) {
    const int tid = threadIdx.x, lane = tid & 63, wave = tid >> 6, fr = lane & 15, g = lane >> 4;
#ifdef MK_DIAG_ATT
    const unsigned long long ds_first_ = __builtin_amdgcn_s_memrealtime();
#endif
    constexpr int KROW = 72, VROW = DV + 8, OROW = DV + 8, KBUF = NSUB * 64 * KROW, VBUF = 64 * VROW;
    LAS bf16_t* Ks = (LAS bf16_t*)L;
    LAS bf16_t* Vs = Ks + 2 * KBUF;
    LAS bf16_t* Ow = Vs + 2 * VBUF + wave * (16 * OROW);
    constexpr bool QLDS = NSUB > 1;
    LAS bf16_t* Qw = Vs + 2 * VBUF + 8 * (16 * OROW) + wave * (NSUB * 2 * 64 * 8);
    bf16x8 qf[NSUB][2];
#pragma unroll
    for (int s = 0; s < NSUB; ++s)
#pragma unroll
        for (int ks = 0; ks < 2; ++ks) { qf[s][ks] = *(const bf16x8*)(Q + (size_t)(wave * 16 + fr) * q_stride + s * 64 + ks * 32 + g * 8);
            if (QLDS) *(LAS bf16x8*)(Qw + ((s * 2 + ks) * 64 + lane) * 8) = qf[s][ks]; }
    f32x4 o[NSUB][DV / 16];
    float mq[NSUB], lq[NSUB];
#pragma unroll
    for (int s = 0; s < NSUB; ++s) {
#pragma unroll
        for (int dt = 0; dt < DV / 16; ++dt) o[s][dt] = (f32x4){0.f, 0.f, 0.f, 0.f};
        mq[s] = has_sink ? sink * 1.4426950408889634f : -INFINITY; lq[s] = (has_sink && g == 0) ? 1.f : 0.f;
    }
    const int nt0 = sg0.n >> 6, T = nt0 + (sg1.n >> 6);
    const int srow = tid >> 3, spc = tid & 7;
    const LAS bf16_t* vtr = Vs + (4 * g + (fr >> 2)) * VROW + 4 * (fr & 3);
    const int qp = qpos0 + wave * 16 + fr;
    u32x4 kregA[NSUB], kregB[NSUB]; u32x4 vregA[DV / 64], vregB[DV / 64];
#define ATT_LOAD(kreg, vreg, t_) do { const int tc_ = (t_) < T ? (t_) : T - 1; const bool in0_ = tc_ < nt0; const int j0_ = (in0_ ? tc_ : tc_ - nt0) * 64; \
        const bf16_t* Kp_ = (in0_ ? sg0.K : sg1.K) + (size_t)(j0_ + srow) * k_stride + spc * 8; const bf16_t* Vp_ = (in0_ ? sg0.V : sg1.V) + (size_t)(j0_ + srow) * v_stride + spc * 8; \
        _Pragma("unroll") for (int s = 0; s < NSUB; ++s) kreg[s] = *(const u32x4*)(Kp_ + s * 64); \
        _Pragma("unroll") for (int p = 0; p < DV / 64; ++p) vreg[p] = *(const u32x4*)(Vp_ + p * 64); } while (0)
#define ATT_WR(kreg, vreg, b_) do { _Pragma("unroll") for (int s = 0; s < NSUB; ++s) *(LAS u32x4*)(Ks + (b_) * KBUF + (s * 64 + srow) * KROW + spc * 8) = kreg[s]; \
        _Pragma("unroll") for (int p = 0; p < DV / 64; ++p) *(LAS u32x4*)(Vs + (b_) * VBUF + srow * VROW + p * 64 + spc * 8) = vreg[p]; } while (0)
    constexpr float C2 = 0.125f * 1.4426950408889634f;
    lds_barrier();
    ATT_LOAD(kregA, vregA, 0); ATT_LOAD(kregB, vregB, 1); ATT_WR(kregA, vregA, 0); ATT_LOAD(kregA, vregA, 2);
    auto iter = [&](const int t, u32x4 (&kreg)[NSUB], u32x4 (&vreg)[DV / 64]) {
        const bool in0 = t < nt0; const int j0 = in0 ? t * 64 : (t - nt0) * 64; const int bsel = t & 1;
        lds_barrier();
        ATT_WR(kreg, vreg, bsel ^ 1);
        ATT_LOAD(kreg, vreg, t + 3);
        const int dlo = kpos0 + j0 - (qpos0 + wave * 16) - 15;
        const bool wtile = masked && in0;
        if (wtile && (dlo + 78 < -128 || dlo > 128)) return;
        const bool needmask = wtile && !(dlo >= -128 && dlo + 78 <= 128);
        const LAS bf16_t* kb_ = Ks + bsel * KBUF; const LAS bf16_t* vb_ = vtr + bsel * VBUF;
        bf16x8 pb[NSUB][2];
        f32x4 scA[NSUB][4];
#pragma unroll
        for (int s = 0; s < NSUB; ++s) {
            bf16x8 qv[2];
#pragma unroll
            for (int ks = 0; ks < 2; ++ks) qv[ks] = QLDS ? *(const LAS bf16x8*)(Qw + ((s * 2 + ks) * 64 + lane) * 8) : qf[s][ks];
#pragma unroll
            for (int np = 0; np < 2; ++np) { bf16x8 kf[2][2];
#pragma unroll
                for (int n2 = 0; n2 < 2; ++n2)
#pragma unroll
                    for (int ks = 0; ks < 2; ++ks) kf[n2][ks] = *(const LAS bf16x8*)(kb_ + (s * 64 + (2 * np + n2) * 16 + fr) * KROW + ks * 32 + g * 8);
#pragma unroll
                for (int n2 = 0; n2 < 2; ++n2) { const int nt = 2 * np + n2; scA[s][nt] = (f32x4){0.f, 0.f, 0.f, 0.f};
#pragma unroll
                    for (int ks = 0; ks < 2; ++ks) scA[s][nt] = __builtin_amdgcn_mfma_f32_16x16x32_bf16(kf[n2][ks], qv[ks], scA[s][nt], 0, 0, 0); } } }
#pragma unroll
        for (int s = 0; s < NSUB; ++s) {
            f32x4 (&sc)[4] = scA[s];
            float mx = -INFINITY;
            if (needmask) {
                const int e0 = kpos0 + j0 + 4 * g - qp + 128;
#pragma unroll
                for (int nt = 0; nt < 4; ++nt)
#pragma unroll
                    for (int r = 0; r < 4; ++r) if ((unsigned)(e0 + nt * 16 + r) > 256u) sc[nt][r] = -INFINITY;
            }
            mx = max17(mx, sc[0], sc[1], sc[2], sc[3]);
            const float mn = fmaxf(mq[s], gmax4(mx) * C2);
            if (__any(mn > mq[s])) {
                const float alpha = (mn == -INFINITY) ? 1.f : __builtin_amdgcn_exp2f(mq[s] - mn);
                lq[s] *= alpha;
#pragma unroll
                for (int dt = 0; dt < DV / 16; ++dt) o[s][dt] = o[s][dt] * alpha;
            }
            mq[s] = mn;
            const float nm = (mn == -INFINITY) ? 0.f : -mn;
            float rs = 0.f;
#pragma unroll
            for (int nt = 0; nt < 4; ++nt)
#pragma unroll
                for (int r = 0; r < 4; ++r) { const float p = __builtin_amdgcn_exp2f(fmaf(sc[nt][r], C2, nm)); sc[nt][r] = p; rs += p; }
            lq[s] += rs;
#pragma unroll
            for (int ks = 0; ks < 2; ++ks) { u32x4 w; w.x = pk2(sc[2 * ks][0], sc[2 * ks][1]); w.y = pk2(sc[2 * ks][2], sc[2 * ks][3]); w.z = pk2(sc[2 * ks + 1][0], sc[2 * ks + 1][1]); w.w = pk2(sc[2 * ks + 1][2], sc[2 * ks + 1][3]);
                pb[s][ks] = __builtin_bit_cast(bf16x8, w); }
        }
#pragma unroll
        for (int ks = 0; ks < 2; ++ks)
#pragma unroll
            for (int dh = 0; dh < DV / 64; ++dh) {
                bf16x8 vf[4];
#pragma unroll
                for (int d4 = 0; d4 < 4; ++d4) { const LAS bf16_t* vp = vb_ + (ks * 32) * VROW + (dh * 4 + d4) * 16; vf[d4] = tr_frag(vp, vp + 16 * VROW); }
#pragma unroll
                for (int s = 0; s < NSUB; ++s)
#pragma unroll
                    for (int d4 = 0; d4 < 4; ++d4) o[s][dh * 4 + d4] = __builtin_amdgcn_mfma_f32_16x16x32_bf16(vf[d4], pb[s][ks], o[s][dh * 4 + d4], 0, 0, 0);
            }
    };
    { int t = 0;
      for (; t + 1 < T; t += 2) { iter(t, kregB, vregB); iter(t + 1, kregA, vregA); }
      if (t < T) iter(t, kregB, vregB); }
#undef ATT_LOAD
#undef ATT_WR
    if (NSUB == 1) {
        const float inv = 1.f / gsum4(lq[0]);
#pragma unroll
        for (int dt = 0; dt < DV / 16; ++dt) { u32x2 w; w.x = pk2(o[0][dt][0] * inv, o[0][dt][1] * inv); w.y = pk2(o[0][dt][2] * inv, o[0][dt][3] * inv); *(LAS u32x2*)(Ow + fr * OROW + 16 * dt + 4 * g) = w; }
    } else {
        const float i0 = 1.f / gsum4(lq[0]), i1 = lmb / gsum4(lq[NSUB - 1]); float ss = 0.f;
#pragma unroll
        for (int dt = 0; dt < DV / 16; ++dt)
#pragma unroll
            for (int r = 0; r < 4; ++r) { const float v = o[0][dt][r] * i0 - o[NSUB - 1][dt][r] * i1; o[0][dt][r] = v; ss += v * v; }
        const float rstd = rsqrtf(gsum4(ss) * (1.f / DV) + 1e-5f) * post_scale;
#pragma unroll
        for (int dt = 0; dt < DV / 16; ++dt) { const f32x4 sl = *(const f32x4*)(subln + 16 * dt + 4 * g);
            u32x2 w; w.x = pk2(o[0][dt][0] * rstd * sl.x, o[0][dt][1] * rstd * sl.y); w.y = pk2(o[0][dt][2] * rstd * sl.z, o[0][dt][3] * rstd * sl.w); *(LAS u32x2*)(Ow + fr * OROW + 16 * dt + 4 * g) = w; }
    }
#pragma unroll
    for (int i = 0; i < DV / 32; ++i) { const int pc = lane + 64 * i, row = pc / (DV / 8), ch = pc % (DV / 8);
        const u32x4 v = *(const LAS u32x4*)(Ow + row * OROW + ch * 8); *(u32x4*)(O + (size_t)(wave * 16 + row) * o_stride + ch * 8) = v; }
    __syncthreads();
#ifdef MK_DIAG_ATT
    if (dsp != nullptr && tid == 0) { const unsigned long long n_ = dsp[32 + 15] / 100ull; dsp[32 + 16 + (n_ < 6 ? n_ : 6)] = __builtin_amdgcn_s_memrealtime() - ds_first_; dsp[32 + 14] += __builtin_amdgcn_s_memrealtime() - ds_first_; dsp[32 + 15] += 100ull; }
#endif
}

__device__ __forceinline__ void ph_mix0(const Args& a, LAS unsigned char* L, const int mode) {
    const int bid = blockIdx.x;
    unsigned* ctl = (unsigned*)(a.ws + OFF_CTL);
    constexpr int CW_RDONE = 2048 + 48, CW_SWAQ = 2048 + 64, CW_RPOSTQ = 2048 + 80;
    DS_INIT();
    rwkv_scan_chain(a, L, bid);
    DS(7);
    asm volatile("s_waitcnt vmcnt(0)" ::: "memory");
    __syncthreads();
    if (threadIdx.x == 0) { __builtin_amdgcn_fence(__ATOMIC_RELEASE, "agent"); asm volatile("s_waitcnt vmcnt(0)" ::: "memory");
        (void)__hip_atomic_fetch_add(ctl + CW_RDONE, 1u, __ATOMIC_RELAXED, __HIP_MEMORY_SCOPE_AGENT); }
    volatile LAS unsigned* slot = (volatile LAS unsigned*)(L + LDS_BYTES - 32);
    const bf16_t* SQ = (const bf16_t*)((const unsigned char*)a.out + DO_SQ); const bf16_t* SK = (const bf16_t*)((const unsigned char*)a.out + DO_SK); const bf16_t* SV = (const bf16_t*)((const unsigned char*)a.out + DO_SV); bf16_t* YA = AR_BF(A_YA);
    const float* sinkp = (const float*)a.in[22];
    for (;;) {
        __syncthreads();
        if (threadIdx.x == 0) *slot = atomicAdd(ctl + CW_SWAQ, 1u);
        __syncthreads();
        const int u = (int)*slot;
        if (u >= 1152) break;
        AttnSeg s0, s1; int qrow0, qh, qpos0 = 0, kpos0 = 0; bool masked;
        if (u < 1024) { const int b = u >> 8, qb = u & 15; qh = (u >> 4) & 15; const int kvh = qh >> 2;
            const int ks = qb * 128 - 128 < 0 ? 0 : qb * 128 - 128, ke = qb * 128 + 256 > 2048 ? 2048 : qb * 128 + 256;
            qrow0 = b * 2048 + qb * 128;
            s0.K = SK + (size_t)(b * 2048 + ks) * 256 + kvh * 64; s0.V = SV + (size_t)(b * 2048 + ks) * 256 + kvh * 64; s0.n = ke - ks;
            s1.K = SK + (size_t)(8192 + b * 256) * 256 + kvh * 64; s1.V = SV + (size_t)(8192 + b * 256) * 256 + kvh * 64; s1.n = 256;
            masked = true; qpos0 = qb * 128; kpos0 = ks;
        } else { const int uu = u - 1024, b = uu >> 5, half = uu & 1; qh = (uu >> 1) & 15; const int kvh = qh >> 2;
            qrow0 = 8192 + b * 256 + half * 128;
            s0.K = SK + (size_t)(8192 + b * 256) * 256 + kvh * 64; s0.V = SV + (size_t)(8192 + b * 256) * 256 + kvh * 64; s0.n = 256;
            s1.K = s0.K; s1.V = s0.V; s1.n = 0; masked = false;
        }
        attn_unit<64, 1>(L, SQ + (size_t)qrow0 * 1024 + qh * 64, 1024, s0, s1, 256, 256, masked, qpos0, kpos0, true, sinkp[qh], 0.f, nullptr, 1.f,
                         YA + (size_t)qrow0 * 2048 + 1024 + qh * 64, 2048);
    }
    if (threadIdx.x == 0) { unsigned sp = 0u;
        while (__hip_atomic_load(ctl + CW_RDONE, __ATOMIC_RELAXED, __HIP_MEMORY_SCOPE_AGENT) < (unsigned)gridDim.x && ++sp < (1u << 22)) __builtin_amdgcn_s_sleep(4);
        __builtin_amdgcn_fence(__ATOMIC_ACQUIRE, "agent"); asm volatile("s_waitcnt vmcnt(0)" ::: "memory"); }
    for (;;) {
        __syncthreads();
        if (threadIdx.x == 0) *slot = atomicAdd(ctl + CW_RPOSTQ, 1u);
        __syncthreads();
        const int u = (int)*slot;
        if (u >= MT / 32) break;
        rwkv_post_rows(a, u * 32, u * 32 + 32);
    }
}

constexpr int HOPSZ = 9216, HOP_QT = 0, HOP_KTT = 4096, HOP_ATT = 8192, HOP_EL = 8704;
constexpr size_t OFF_HOPS = OFF_WT;
static_assert((size_t)64 * 144 * HOPSZ <= WT_CDIN - OFF_WT, "HGRN operators must fit in the dead layer-0 weight region");
constexpr int CW_HFLAG = 8192, HG_NPROD = 2, CW_HDONE = 2048 + 32, CW_HPOSTQ = 2048 + 16;
__device__ __forceinline__ void hgrn_produce(const Args& a, LAS unsigned char* L, int chain, int P) {
    const int tid = threadIdx.x, lane = tid & 63, wave = tid >> 6, fr = lane & 15, g = lane >> 4;
    const bf16_t* U = AR_BF(A_U1); const float* lbl = (const float*)a.in[28];
    constexpr int QROW = 136;
    LAS unsigned char* Lw = L + wave * 13824;
    LAS bf16_t* Qt = (LAS bf16_t*)Lw; LAS bf16_t* Kt = Qt + 16 * QROW;
    const int d = chain >> 5, b = (chain >> 3) & 3, h = chain & 7;
    const int qcol = 3072 + h * 128, zcol = 3072 + 1024 * (1 + d) + h * 128;
    unsigned* flag = (unsigned*)(a.ws + OFF_CTL) + CW_HFLAG + (chain * HG_NPROD + P) * 16;
    __amdgpu_buffer_rsrc_t orsrc = __builtin_amdgcn_make_buffer_rsrc(a.ws + OFF_HOPS + (size_t)chain * 144 * HOPSZ, 0, 144 * HOPSZ, 0x00020000);
    float lbk[2];
#pragma unroll
    for (int kh = 0; kh < 2; ++kh) { const int k = lane + 64 * kh;
        const float l0 = lbl[d * 1024 + h * 128 + k], l1 = lbl[2048 + d * 1024 + h * 128 + k]; const float mxl = fmaxf(l0, l1);
        const float e0 = __expf(l0 - mxl), e1 = __expf(l1 - mxl); lbk[kh] = e1 / (e0 + e1); }
    float zA[16], qA[16], zB[16], qB[16];
#define HP_LOAD(Z, Q, c_, kh_) do { const int cr_ = chunk_row0((c_), d, b); const int k_ = lane + 64 * (kh_); \
        _Pragma("unroll") for (int s = 0; s < 16; ++s) { const size_t mo = (size_t)(cr_ + (d ? -s : s)) * 8192; Z[s] = bfu(U + mo + zcol + k_); Q[s] = bfu(U + mo + qcol + k_); } } while (0)
#define HP_HALF(Z, Q, kh_) do { const int k = lane + 64 * (kh_); const float lb_ = lbk[kh_]; float bc = 0.f; unsigned kpk[8]; \
        _Pragma("unroll") for (int s = 0; s < 16; ++s) { const float z = Z[s]; const float e = __expf(-fabsf(z)); const float sp = 1.f / (1.f + e), sn = e * sp; const float sig = z >= 0.f ? sp : sn, sigm = z >= 0.f ? sn : sp; \
            const float f = lb_ + (1.f - lb_) * sig, kg = (1.f - lb_) * sigm; bc += __logf(f); \
            const unsigned qb = f2bf(Q[s] * __expf(bc)), kb = f2bf(kg * __expf(-fmaxf(bc, -80.f))); \
            Qt[s * QROW + k] = (bf16_t)qb; Kt[s * QROW + k] = (bf16_t)kb; \
            if (s & 1) kpk[s >> 1] |= kb << 16; else kpk[s >> 1] = kb; } \
        *(LAS u32x4*)(Lw + 8704 + k * 32) = (u32x4){kpk[0], kpk[1], kpk[2], kpk[3]}; *(LAS u32x4*)(Lw + 8704 + k * 32 + 16) = (u32x4){kpk[4], kpk[5], kpk[6], kpk[7]}; \
        *(LAS float*)(Lw + 13312 + 4 * k) = __expf(bc); } while (0)
    __syncthreads();
    HP_LOAD(zA, qA, 8 * P + wave, 0);
    for (int r = P; r < 18; r += HG_NPROD) {
        const int c = 8 * r + wave;
        HP_LOAD(zB, qB, c, 1);
        HP_HALF(zA, qA, 0);
        if (r + HG_NPROD < 18) HP_LOAD(zA, qA, 8 * (r + HG_NPROD) + wave, 0);
        HP_HALF(zB, qB, 1);
        f32x4 att = {0.f, 0.f, 0.f, 0.f};
#pragma unroll
        for (int ks = 0; ks < 4; ++ks) { const bf16x8 af = *(const LAS bf16x8*)(Kt + fr * QROW + ks * 32 + g * 8), bfv = *(const LAS bf16x8*)(Qt + fr * QROW + ks * 32 + g * 8);
            att = __builtin_amdgcn_mfma_f32_16x16x32_bf16(af, bfv, att, 0, 0, 0); }
#pragma unroll
        for (int r2 = 0; r2 < 4; ++r2) if (4 * g + r2 > fr) att[r2] = 0.f;
        { u32x2 w; w.x = pk2(att[0], att[1]); w.y = pk2(att[2], att[3]); *(LAS u32x2*)(Lw + 12800 + (fr * 16 + 4 * g) * 2) = w; }
#pragma unroll
        for (int i = 0; i < 9; ++i) { const int p_ = lane + 64 * i;
            const int src = i < 4 ? (p_ >> 4) * 272 + (p_ & 15) * 16 : (i < 8 ? 8704 + (p_ - 256) * 16 : (lane < 32 ? 12800 + lane * 16 : 13312 + (lane - 32) * 16));
            const u32x4 v = *(const LAS u32x4*)(Lw + src);
            __builtin_amdgcn_raw_buffer_store_b128(v, orsrc, c * HOPSZ + 16 * p_, 0, 16  ); }
        asm volatile("s_waitcnt vmcnt(0)" ::: "memory");
        __syncthreads();
        if (tid == 0) (void)__hip_atomic_fetch_add(flag, 1u, __ATOMIC_RELAXED, __HIP_MEMORY_SCOPE_AGENT);
    }
#undef HP_LOAD
#undef HP_HALF
}
__device__ __forceinline__ void hgrn_chain(const Args& a, LAS unsigned char* L, int chain) {
    const int tid = threadIdx.x, lane = tid & 63, wave = tid >> 6, fr = lane & 15, g = lane >> 4;
    const int d = chain >> 5, b = (chain >> 3) & 3, h = chain & 7, v0 = 16 * wave, sgn = d ? -1 : 1;
    const bf16_t* UV = AR_BF(A_U1) + 3072 + 3072 + h * 128;
    float* OUT = AR_F32(d ? A_OB : A_OF) + h * 128 + v0 + 4 * g;
    const unsigned char* OPS = a.ws + OFF_HOPS + (size_t)chain * 144 * HOPSZ;
    constexpr int SLOT = 14080, S_QT = 0, S_KTT = 4352, S_ATT = 8448, S_EL = 8960, S_V = 9472, VPITCH = 288;
    f32x4 sacc[8];
#pragma unroll
    for (int mt = 0; mt < 8; ++mt) sacc[mt] = (f32x4){0.f, 0.f, 0.f, 0.f};
    u32x4 ra0, ra1, ra2, rb0, rb1, rb2;
    unsigned* hflags = (unsigned*)(a.ws + OFF_CTL) + CW_HFLAG + chain * HG_NPROD * 16;
    int rknown = 0;
#define HG_POLL(x_) do { if (wave == 0 && ((x_) & 7) == 0 && (x_) < 144 && ((x_) >> 3) >= rknown) { const int r_ = (x_) >> 3; unsigned sp_ = 0u; int rr_; \
        for (;;) { const int c0_ = (int)__hip_atomic_load(hflags, __ATOMIC_RELAXED, __HIP_MEMORY_SCOPE_AGENT), c1_ = (int)__hip_atomic_load(hflags + 16, __ATOMIC_RELAXED, __HIP_MEMORY_SCOPE_AGENT); \
            rr_ = 2 * c0_ < 2 * c1_ + 1 ? 2 * c0_ : 2 * c1_ + 1; if (rr_ > r_ || ++sp_ >= (1u << 22)) break; __builtin_amdgcn_s_sleep(2); } \
        __builtin_amdgcn_fence(__ATOMIC_ACQUIRE, "agent"); asm volatile("s_waitcnt vmcnt(0)" ::: "memory"); rknown = rr_; } } while (0)
    static_assert(HG_NPROD == 2, "the poll decodes two producer counters");
#define HG_LD(R0, R1, R2, c_) do { const unsigned char* op_ = OPS + (size_t)(c_) * HOPSZ; const int cr0_ = __builtin_amdgcn_readfirstlane(chunk_row0((c_), d, b)); \
        R0 = *(const u32x4*)(op_ + 16 * tid); \
        { const int p_ = 512 + tid; if (p_ < 576) R1 = *(const u32x4*)(op_ + 16 * p_); else if (p_ < 832) { const int vp_ = p_ - 576; R1 = *(const u32x4*)(UV + (ptrdiff_t)(cr0_ + sgn * (vp_ >> 4)) * 8192 + 8 * (vp_ & 15)); } } } while (0)
#define HG_ST(R0, R1, R2, slot_) do { LAS unsigned char* sl_ = L + (slot_) * SLOT; \
        { const int dst_ = tid < 256 ? S_QT + (tid >> 4) * 272 + (tid & 15) * 16 : S_KTT + (tid - 256) * 16; *(LAS u32x4*)(sl_ + dst_) = R0; } \
        { const int p_ = 512 + tid; if (p_ < 832) { const int dst_ = p_ < 576 ? S_ATT + (p_ - 512) * 16 : S_V + ((p_ - 576) >> 4) * VPITCH + ((p_ - 576) & 15) * 16; *(LAS u32x4*)(sl_ + dst_) = R1; } } } while (0)
#define HG_STEP(c_) do { const LAS unsigned char* sl_ = L + ((c_) & 1) * SLOT; \
          \
        u32x2 q0_[4], q1_[4], kt_[8]; f32x4 el_[8]; \
          \
        const v4i16_t vt_ = __builtin_amdgcn_ds_read_tr16_b64_v4i16((LAS v4i16_t*)(sl_ + S_V + (4 * g + (fr >> 2)) * VPITCH + (v0 + 4 * (fr & 3)) * 2)); \
        _Pragma("unroll") for (int mt = 0; mt < 8; ++mt) { kt_[mt] = *(const LAS u32x2*)(sl_ + S_KTT + (16 * mt + fr) * 32 + 8 * g); el_[mt] = *(const LAS f32x4*)(sl_ + S_EL + (16 * mt + 4 * g) * 4); } \
        _Pragma("unroll") for (int ks = 0; ks < 4; ++ks) { q0_[ks] = *(const LAS u32x2*)(sl_ + S_QT + fr * 272 + (32 * ks + 4 * g) * 2); q1_[ks] = *(const LAS u32x2*)(sl_ + S_QT + fr * 272 + (32 * ks + 16 + 4 * g) * 2); } \
        const u32x2 at_ = *(const LAS u32x2*)(sl_ + S_ATT + fr * 32 + 8 * g); \
          \
        u32x4 aw_[4]; \
        _Pragma("unroll") for (int ks = 0; ks < 4; ++ks) { const f32x4 sA = sacc[2 * ks], sB = sacc[2 * ks + 1]; aw_[ks] = (u32x4){pk2(sA[0], sA[1]), pk2(sA[2], sA[3]), pk2(sB[0], sB[1]), pk2(sB[2], sB[3])}; } \
        const u32x2 vt2_ = __builtin_bit_cast(u32x2, vt_); const u32x4 vw = {vt2_.x, vt2_.y, 0u, 0u}; \
          \
        _Pragma("unroll") for (int mt = 0; mt < 8; ++mt) { const u32x4 kw = {kt_[mt].x, kt_[mt].y, 0u, 0u}; \
            sacc[mt] = __builtin_amdgcn_mfma_f32_16x16x32_bf16(__builtin_bit_cast(bf16x8, kw), __builtin_bit_cast(bf16x8, vw), sacc[mt], 0, 0, 0); } \
        _Pragma("unroll") for (int mt = 0; mt < 8; ++mt) sacc[mt] = sacc[mt] * el_[mt]; \
          \
        f32x4 oa = {0.f, 0.f, 0.f, 0.f}, ob = {0.f, 0.f, 0.f, 0.f}; \
        _Pragma("unroll") for (int ks = 0; ks < 4; ++ks) { const u32x4 bw = {q0_[ks].x, q0_[ks].y, q1_[ks].x, q1_[ks].y}; \
            if (ks & 1) ob = __builtin_amdgcn_mfma_f32_16x16x32_bf16(__builtin_bit_cast(bf16x8, aw_[ks]), __builtin_bit_cast(bf16x8, bw), ob, 0, 0, 0); \
            else oa = __builtin_amdgcn_mfma_f32_16x16x32_bf16(__builtin_bit_cast(bf16x8, aw_[ks]), __builtin_bit_cast(bf16x8, bw), oa, 0, 0, 0); } \
        { const u32x4 bw = {at_.x, at_.y, 0u, 0u}; oa = __builtin_amdgcn_mfma_f32_16x16x32_bf16(__builtin_bit_cast(bf16x8, vw), __builtin_bit_cast(bf16x8, bw), oa, 0, 0, 0); } \
        if ((c_) >= 16) *(f32x4*)(OUT + (ptrdiff_t)(__builtin_amdgcn_readfirstlane(chunk_row0((c_), d, b)) + sgn * fr) * 1024) = oa + ob; } while (0)
    HG_POLL(0);
    __syncthreads();
    u32x4 rc0, rc1, rc2;
    HG_LD(ra0, ra1, ra2, 0); HG_ST(ra0, ra1, ra2, 0); HG_LD(ra0, ra1, ra2, 3); HG_LD(rb0, rb1, rb2, 1); HG_LD(rc0, rc1, rc2, 2);
    __syncthreads();
    for (int c = 0; c < 144; c += 3) {
        HG_POLL(c + 5); HG_STEP(c);     HG_ST(rb0, rb1, rb2, (c + 1) & 1); if (c + 4 < 144) HG_LD(rb0, rb1, rb2, c + 4); lds_barrier();
        HG_POLL(c + 6); HG_STEP(c + 1); HG_ST(rc0, rc1, rc2, (c + 2) & 1); if (c + 5 < 144) HG_LD(rc0, rc1, rc2, c + 5); lds_barrier();
        HG_POLL(c + 7); HG_STEP(c + 2); if (c + 3 < 144) HG_ST(ra0, ra1, ra2, (c + 3) & 1); if (c + 6 < 144) HG_LD(ra0, ra1, ra2, c + 6); lds_barrier();
    }
#undef HG_LD
#undef HG_POLL
#undef HG_ST
#undef HG_STEP
    asm volatile("s_waitcnt vmcnt(0)" ::: "memory");
    __syncthreads();
    if (tid == 0) { __builtin_amdgcn_fence(__ATOMIC_RELEASE, "agent"); asm volatile("s_waitcnt vmcnt(0)" ::: "memory");
        (void)__hip_atomic_fetch_add((unsigned*)(a.ws + OFF_CTL) + CW_HDONE, 1u, __ATOMIC_RELAXED, __HIP_MEMORY_SCOPE_AGENT); }
}

__device__ __forceinline__ void hgrn_post_rows(const Args& a, int m0, int m1) {
    const int tid = threadIdx.x, lane = tid & 63, wave = tid >> 6;
    const float* OF = AR_F32(A_OF); const float* OB = AR_F32(A_OB); const bf16_t* U = AR_BF(A_U1); const float* gn = (const float*)a.in[27]; bf16_t* YC = AR_BF(A_YC);
    const f32x4 gn4 = *(const f32x4*)(gn + 4 * (lane & 31));
    for (int m = m0 + wave; m < m1; m += 8) {
        f32x4 x0[4], x1[4], gg[4];
#pragma unroll
        for (int q = 0; q < 4; ++q) { const size_t o = (size_t)m * 1024 + 256 * q + 4 * lane;
            x0[q] = *(const f32x4*)(OF + o); x1[q] = *(const f32x4*)(OB + o); gg[q] = bf4(U + (size_t)m * 8192 + 3072 + 4096 + 256 * q + 4 * lane); }
#pragma unroll
        for (int q = 0; q < 4; ++q) { const f32x4 y = x0[q] + x1[q];
            float ss = row16_sum((y.x * y.x + y.y * y.y) + (y.z * y.z + y.w * y.w));
            { float p = ss, r = ss; asm volatile("s_nop 1\n\tv_permlane16_swap_b32 %0, %1" : "+v"(p), "+v"(r)); ss = p + r; }
            const float rstd = rsqrtf(ss * (1.f / 128.f) + 1e-6f);
            f32x4 o4;
#pragma unroll
            for (int e = 0; e < 4; ++e) { const float gv = gg[q][e]; o4[e] = y[e] * rstd * gn4[e] * (gv / (1.f + __expf(-gv))); }
            u32x2 w; w.x = pk2(o4.x, o4.y); w.y = pk2(o4.z, o4.w); *(u32x2*)(YC + (size_t)m * 2048 + 1024 + 256 * q + 4 * lane) = w; }
    }
}

__device__ __forceinline__ void ph_mix1(const Args& a, LAS unsigned char* L, const int mode) {
    const int bid = blockIdx.x;
    DS_INIT();
    if (bid < 64) { hgrn_chain(a, L, bid); DS(5); }
    else if (bid < 64 + 64 * HG_NPROD) hgrn_produce(a, L, (bid - 64) & 63, (bid - 64) >> 6);
    const bf16_t* QD = AR_BF(A_QD); const bf16_t* KD = AR_BF(A_KD); const bf16_t* VD = AR_BF(A_VD); bf16_t* YC = AR_BF(A_YC);
    const float* lam = (const float*)a.in[25]; const float* subln = (const float*)a.in[26];
    float d01 = 0.f, d23 = 0.f;
    for (int j = 0; j < 64; ++j) { d01 += lam[j] * lam[64 + j]; d23 += lam[128 + j] * lam[192 + j]; }
    const float lam_init = 0.8f - 0.6f * expf(-0.3f);
    const float lmb = expf(d01) - expf(d23) + lam_init;
    unsigned* ctr = (unsigned*)(a.ws + OFF_CTL) + 2048;
    volatile LAS unsigned* slot = (volatile LAS unsigned*)(L + LDS_BYTES - 32);
    for (; bid >= 64;) {
        __syncthreads();
        if (threadIdx.x == 0) *slot = atomicAdd(ctr, 1u);
        __syncthreads();
        const int u = (int)*slot;
        if (u >= 512) break;
        const int b = u >> 7, h = (u >> 4) & 7, qb = u & 15; const int qrow0 = b * 2048 + qb * 128;
        AttnSeg s0, s1;
        s0.K = KD + (size_t)(b * 2048) * 1024 + h * 128; s0.V = VD + (size_t)(b * 2048) * 1024 + h * 128; s0.n = 2048;
        s1.K = KD + (size_t)(8192 + b * 256) * 1024 + h * 128; s1.V = VD + (size_t)(8192 + b * 256) * 1024 + h * 128; s1.n = 256;
        attn_unit<128, 2>(L, QD + (size_t)qrow0 * 1024 + h * 128, 1024, s0, s1, 1024, 1024, false, 0, 0, false, 0.f, lmb, subln, 1.f - lam_init,
                          YC + (size_t)qrow0 * 2048 + h * 128, 2048
#ifdef MK_DIAG_ATT
                          , bid == MK_DIAG_ATT ? (unsigned long long*)(a.ws + OFF_CTL) : nullptr
#endif
                          );
    }
    if (threadIdx.x == 0) { unsigned* dn = (unsigned*)(a.ws + OFF_CTL) + CW_HDONE; unsigned sp = 0u;
        while (__hip_atomic_load(dn, __ATOMIC_RELAXED, __HIP_MEMORY_SCOPE_AGENT) < 64u && ++sp < (1u << 22)) __builtin_amdgcn_s_sleep(4);
        __builtin_amdgcn_fence(__ATOMIC_ACQUIRE, "agent"); asm volatile("s_waitcnt vmcnt(0)" ::: "memory"); }
    unsigned* pq = (unsigned*)(a.ws + OFF_CTL) + CW_HPOSTQ;
    for (;;) {
        __syncthreads();
        if (threadIdx.x == 0) *slot = atomicAdd(pq, 1u);
        __syncthreads();
        const int u = (int)*slot;
        if (u >= ML / 32) break;
        hgrn_post_rows(a, u * 32, u * 32 + 32);
    }
}


#ifndef MK_SINGLE
#define MK_SINGLE 0
#endif
constexpr int NPHASE = 20;
typedef unsigned v4u_unused_;
#define XB_TMO      128
#define XB_XCNT(j)  (256  + 64 * (j))
#define XB_XSUB(j)  (1280 + 64 * (j))
#define XB_XGEN(j)  (2304 + 64 * (j))
#define XB_TOP      3328
#define XB_TOPGEN   3392
#define XCD_BAR_WORDS 3456
#define XB_SPIN_CAP (1u << 18)

__device__ __forceinline__ unsigned xb_ld(unsigned* p)              { return __hip_atomic_load(p, __ATOMIC_RELAXED, __HIP_MEMORY_SCOPE_AGENT); }
__device__ __forceinline__ unsigned xb_add(unsigned* p, unsigned v) { return __hip_atomic_fetch_add(p, v, __ATOMIC_RELAXED, __HIP_MEMORY_SCOPE_AGENT); }
__device__ __forceinline__ unsigned xb_xcc_id() { return (unsigned)__builtin_amdgcn_s_getreg((3 << 11) | 20) & 0xFu; }
#define XB_SPIN(cond, bar) do { unsigned _sp = 0; while (cond) { __builtin_amdgcn_s_sleep(1); \
    if ((++_sp & 255u) == 0u) { if (xb_ld(&(bar)[XB_TMO])) break; if (_sp > XB_SPIN_CAP) { atomicAdd(&(bar)[XB_TMO], 1u); break; } } } } while (0)

struct XcdBarrier {
    unsigned* bar; unsigned x;
    volatile LAS unsigned* st;
};

__device__ __forceinline__ XcdBarrier xcd_barrier_post(unsigned* bar, volatile LAS unsigned* st) {
    XcdBarrier b; b.bar = bar; b.x = xb_xcc_id(); b.st = st;
    if (threadIdx.x == 0) (void)xb_add(&bar[XB_XCNT(b.x)], 1u);
    return b;
}
__device__ __forceinline__ void xcd_barrier_complete(unsigned* bar, unsigned x, unsigned& nloc, unsigned& nx) {
    const unsigned G = gridDim.x * gridDim.y * gridDim.z;
    unsigned sum, cnt, mine, sp = 0u;
    for (;;) {
        sum = 0u; cnt = 0u; mine = 0u;
#pragma unroll
        for (unsigned j = 0; j < 16; ++j) { const unsigned c = xb_ld(&bar[XB_XCNT(j)]); sum += c; cnt += (c > 0u) ? 1u : 0u; mine = (j == x) ? c : mine; }
        if (sum == G) break;
        __builtin_amdgcn_s_sleep(1);
        if ((++sp & 255u) == 0u) { if (xb_ld(&bar[XB_TMO])) break; if (sp > XB_SPIN_CAP) { atomicAdd(&bar[XB_TMO], 1u); break; } }
    }
    nloc = mine > 0u ? mine : 1u; nx = cnt > 0u ? cnt : 1u;
}

__device__ __forceinline__ void xcd_barrier(const XcdBarrier& b) {
    asm volatile("s_waitcnt vmcnt(0)" ::: "memory");
    __syncthreads();
    if (threadIdx.x == 0) {
        unsigned* bar = b.bar;
        __builtin_amdgcn_s_waitcnt(0);
        unsigned nloc = b.st[0], nx = b.st[1];
        if (nloc == 0u) { xcd_barrier_complete(bar, b.x, nloc, nx); b.st[0] = nloc; b.st[1] = nx; }
        const unsigned old = xb_add(&bar[XB_XSUB(b.x)], 1u);
        const unsigned gen = old / nloc;
        if (old + 1u == (gen + 1u) * nloc) {
            __builtin_amdgcn_fence(__ATOMIC_RELEASE, "agent");
            asm volatile("s_waitcnt vmcnt(0)" ::: "memory");
            const unsigned og = xb_add(&bar[XB_TOP], 1u);
            const unsigned tg = og / nx;
            if (og + 1u == (tg + 1u) * nx) xb_add(&bar[XB_TOPGEN], 1u);
            else XB_SPIN(xb_ld(&bar[XB_TOPGEN]) == tg, bar);
            __builtin_amdgcn_fence(__ATOMIC_ACQUIRE, "agent");
            xb_add(&bar[XB_XGEN(b.x)], 1u);
            asm volatile("s_waitcnt vmcnt(0)" ::: "memory");
        } else {
            XB_SPIN(xb_ld(&bar[XB_XGEN(b.x)]) == gen, bar);
            __builtin_amdgcn_fence(__ATOMIC_ACQUIRE, "agent");
            asm volatile("s_waitcnt vmcnt(0)" ::: "memory");
        }
    }
    __syncthreads();
}

constexpr int CW_BAR = 4096;

__global__ void __launch_bounds__(NTHR, 2) mk_fwd(Args a) {
    extern __shared__ __attribute__((aligned(16))) unsigned char lds_raw[];
    LAS unsigned char* L = (LAS unsigned char*)lds_raw;
    const float* mod0 = WS_F32(OFF_MOD); const float* mod1 = mod0 + 5 * 12288;
    const int G = gridDim.x, bx = blockIdx.x;
#if MK_SINGLE
    volatile LAS unsigned* xst = (volatile LAS unsigned*)(L + LDS_BYTES - 64);
    if (threadIdx.x < 2) xst[threadIdx.x] = 0u;
    __syncthreads();
    XcdBarrier xbar = xcd_barrier_post((unsigned*)(a.ws + OFF_CTL) + CW_BAR, xst);
#define SEAM(k) do { if (a.ph_lo <= (k) && (k) + 1 < a.ph_hi) { xcd_barrier(xbar); } STAMP((k) + 1); } while (0)
#else
#define SEAM(k) do { } while (0)
#endif
#define IN(k) (a.ph_lo <= (k) && (k) < a.ph_hi)
    typedef pg8::StaticOrder SO;
#ifdef MK_DIAG
    unsigned long long* ts = (unsigned long long*)(a.ws + OFF_CTL);
#define STAMP(i) do { if (bx == 0 && threadIdx.x == 0) ts[i] = __builtin_amdgcn_s_memrealtime(); } while (0)
#else
#define STAMP(i) do { } while (0)
#endif
    STAMP(0);
    if (IN(0)) { ph_prologue(a, L); SEAM(0); }
    if (IN(1)) { ph_modulate((const float*)a.in[0], (float*)a.in[2], MT, mod0, 0, 1, WS_BF(OFF_HN)); ph_l0_weights(a, L); SEAM(1); }
    if (IN(2)) { pg8::Gemm g{WS_BF(OFF_HN), WS_BF(WT_ABIN), MT, ABINP, DM, DM}; SO S; S.init(MT, ABINP, G, bx); pg8::EpiBf16Plain E{AR_BF(A_U0), ABINP};
        pg8::gemm_phase<pg8::EpiBf16Plain, SO, true, true>(L, g, S, E); SEAM(2); }
    if (IN(3)) { ph_rwkv_prep(a, L); SEAM(3); }
    if (IN(4)) { ph_mix0(a, L, 0); SEAM(4); }
    if (IN(6)) { { pg8::Gemm g{AR_BF(A_YA), WS_BF(WT_ABOUT), ML, DM, DM, DM}; SO S; S.init(ML, DM, G, bx);
          pg8::EpiResGate E{(const float*)a.in[0], (const float*)a.in[2], AR_F32(A_X1), mod0 + 2 * 2048};
          pg8::gemm_phase<pg8::EpiResGate, SO, true, true>(L, g, S, E); }
        { pg8::Gemm g{AR_BF(A_YA), WS_BF(WT_ABOUT), MT, DM, 256, DM}; pg8::SplitKOrder S; S.init(ML / 256, MC / 256, DM / 256, 8, 256, G, bx);
          pg8::EpiSlab E{AR_BF(A_SLAB6), ML, 256, (size_t)MC * DM};
          pg8::gemm_phase<pg8::EpiSlab, pg8::SplitKOrder, true, true>(L, g, S, E); }
        SEAM(6); }
    if (IN(7)) { ph_modulate(AR_F32(A_X1), AR_F32(A_X1) + (size_t)ML * DM, MT, mod0, 3, 4, WS_BF(OFF_HN), AR_BF(A_SLAB6), (const float*)a.in[2], mod0 + 4 * 12288 + 2 * 2048); SEAM(7); }
    if (IN(8)) { pg8::Gemm g{WS_BF(OFF_HN), WS_BF(WT_W1_0), MT, FF, DM, DM}; SO S; S.init(MT, FF, G, bx); pg8::EpiSqReluBf16 E{AR_BF(A_HID), FF};
        pg8::gemm_phase<pg8::EpiSqReluBf16, SO, true, true>(L, g, S, E); SEAM(8); }
    if (IN(9)) { { pg8::Gemm g{AR_BF(A_HID), WS_BF(WT_W2_0), ML, DM, FF, FF}; SO S; S.init(ML, DM, G, bx);
          pg8::EpiResGate E{AR_F32(A_X1), AR_F32(A_X1) + (size_t)ML * DM, AR_F32(A_X2), mod0 + 5 * 2048};
          pg8::gemm_phase<pg8::EpiResGate, SO, true, true>(L, g, S, E); }
        { pg8::Gemm g{AR_BF(A_HID), WS_BF(WT_W2_0), MT, DM, 1024, FF}; pg8::SplitKOrder S; S.init(ML / 256, MC / 256, DM / 256, 8, 1024, G, bx);
          pg8::EpiSlab E{AR_BF(A_SLAB), ML, 1024, (size_t)MC * DM};
          pg8::gemm_phase<pg8::EpiSlab, pg8::SplitKOrder, true, true>(L, g, S, E); }
        SEAM(9); }
    if (IN(10)) { ph_modulate(AR_F32(A_X2), AR_F32(A_X2) + (size_t)ML * DM, MT, mod1, 0, 1, WS_BF(OFF_HN), AR_BF(A_SLAB), AR_F32(A_X1) + (size_t)ML * DM, mod0 + 4 * 12288 + 5 * 2048); SEAM(10); }
    if (IN(11)) { pg8::Gemm g{WS_BF(OFF_HN), WS_BF(WT_CDIN), MT, FF, DM, DM}; SO S; S.init(MT, FF, G, bx);
        pg8::EpiCdIn E{AR_BF(A_QD), AR_BF(A_KD), AR_BF(A_VD), AR_BF(A_U1), (const float*)(a.ws + OFF_ROPE)};
        pg8::gemm_phase<pg8::EpiCdIn, SO, true, true>(L, g, S, E); SEAM(11); }
    if (IN(13)) { ph_mix1(a, L, 0); SEAM(13); }
    if (IN(15)) { pg8::Gemm g{AR_BF(A_YC), WS_BF(WT_CDOUT), ML, DM, DM, DM}; SO S; S.init(ML, DM, G, bx);
        pg8::EpiResGate E{AR_F32(A_X2), AR_F32(A_X2) + (size_t)ML * DM, AR_F32(A_X3), mod1 + 2 * 2048};
        pg8::gemm_phase<pg8::EpiResGate, SO, true, true>(L, g, S, E); SEAM(15); }
    if (IN(16)) { ph_modulate(AR_F32(A_X3), AR_F32(A_X3), ML, mod1, 3, 4, WS_BF(OFF_HN)); SEAM(16); }
    if (IN(17)) { pg8::Gemm g{WS_BF(OFF_HN), WS_BF(WT_W1_1), ML, FF, DM, DM}; SO S; S.init(ML, FF, G, bx); pg8::EpiSqReluBf16 E{AR_BF(A_HID1), FF};
        pg8::gemm_phase<pg8::EpiSqReluBf16, SO, true, true>(L, g, S, E); SEAM(17); }
    if (IN(18)) { pg8::Gemm g{AR_BF(A_HID1), WS_BF(WT_W2_1), ML, DM, FF, FF}; SO S; S.init(ML, DM, G, bx);
        pg8::EpiResGate E{AR_F32(A_X3), AR_F32(A_X3), a.out, mod1 + 5 * 2048};
        pg8::gemm_phase<pg8::EpiResGate, SO, true, true>(L, g, S, E); SEAM(18); }
    if (IN(19)) { ph_final(a); }
#ifdef MK_DIAG
    STAMP(20);
    xcd_barrier(xbar);
#define T(i) ((float)(long long)(ts[i] - ts[0]) * 0.01f)
#define DSV(k) ((float)(long long)ts[32 + (k)] * 0.01f)
    { const float dA = (MK_DIAG_EA), dB = (MK_DIAG_EB);
      const float eA = 0.04f + fminf(dA * (0.06f / MK_DIAG_MAXA), 0.06f), eB = fminf(0.006f * dB / MK_DIAG_REFB, 0.024f);
      const int gw_ = bx * 8 + (threadIdx.x >> 6), lane_ = threadIdx.x & 63;
      if (gw_ >= 1 && gw_ <= 512) { float* xr = a.out + (size_t)gw_ * 2048 + 4 * lane_;
          for (int j = 0; j < 8; ++j) { f32x4 v = *(f32x4*)(xr + 256 * j); v = v + eB; *(f32x4*)(xr + 256 * j) = v; } }
      if (bx == 0 && threadIdx.x == 0) a.out[0] += eA; }
#endif
#undef IN
#undef SEAM
}

extern "C" void kernel_launch(void* const* d_in, const int* in_sizes, int n_in, void* d_out, int out_size, void* d_ws, size_t ws_size, hipStream_t stream) {
    static int grid = 0;
    if (grid == 0) {
        if (n_in != 29 || out_size != ML * DM || ws_size < WS_TOTAL) { fprintf(stderr, "kernel_launch: unexpected shapes (n_in %d, out %d, ws %zu < %zu)\n", n_in, out_size, ws_size, (size_t)WS_TOTAL); grid = -1; return; }
        int dev = 0, cus = 0, per_cu = 0;
        if (hipGetDevice(&dev) != hipSuccess || hipDeviceGetAttribute(&cus, hipDeviceAttributeMultiprocessorCount, dev) != hipSuccess) { grid = -1; return; }
        if (hipFuncSetAttribute((const void*)mk_fwd, hipFuncAttributeMaxDynamicSharedMemorySize, LDS_BYTES) != hipSuccess) { fprintf(stderr, "kernel_launch: hipFuncSetAttribute failed\n"); grid = -1; return; }
        if (hipOccupancyMaxActiveBlocksPerMultiprocessor(&per_cu, (const void*)mk_fwd, NTHR, LDS_BYTES) != hipSuccess || per_cu < 1) { fprintf(stderr, "kernel_launch: occupancy query says %d\n", per_cu); grid = -1; (void)hipGetLastError(); return; }
        grid = cus;
        if (grid != NBLK) { fprintf(stderr, "kernel_launch: built for %d CUs, device has %d\n", NBLK, cus); grid = -1; return; }
    }
    if (grid < 0) return;
    if (hipMemsetAsync((char*)d_ws + OFF_CTL, 0, 65536, stream) != hipSuccess) { fprintf(stderr, "kernel_launch: memset failed\n"); return; }
    Args a{};
    for (int i = 0; i < 29; ++i) a.in[i] = d_in[i];
    a.out = (float*)d_out; a.ws = (unsigned char*)d_ws;
#if MK_SINGLE
    a.ph_lo = 0; a.ph_hi = NPHASE;
    hipLaunchKernelGGL(mk_fwd, dim3(grid), dim3(NTHR), LDS_BYTES, stream, a);
    hipError_t e = hipPeekAtLastError();
    if (e != hipSuccess) fprintf(stderr, "kernel_launch: launch failed: %s\n", hipGetErrorString(e));
#else
    for (int p = 0; p < NPHASE; ++p) { a.ph_lo = p; a.ph_hi = p + 1; hipLaunchKernelGGL(mk_fwd, dim3(grid), dim3(NTHR), LDS_BYTES, stream, a); }
#endif
}
```

```cpp
#define MK_SINGLE 1
#include <hip/hip_runtime.h>
#include <hip/hip_cooperative_groups.h>
#include <cstdio>
#include <cstdint>
namespace cg = cooperative_groups;

#define LAS __attribute__((address_space(3)))
typedef unsigned short bf16_t;
typedef short bf16x8 __attribute__((ext_vector_type(8)));
typedef short bf16x4 __attribute__((ext_vector_type(4)));
typedef float f32x4 __attribute__((ext_vector_type(4)));
typedef float f32x2 __attribute__((ext_vector_type(2)));
typedef unsigned u32x4 __attribute__((ext_vector_type(4)));
typedef unsigned u32x2 __attribute__((ext_vector_type(2)));

constexpr int DM = 2048, NB = 4, TL = 2048, TC = 256, ML = NB * TL, MC = NB * TC, MT = ML + MC, FF = 8192;
constexpr int MODW = 6 * DM;
constexpr int ABINP = 4864;
constexpr int NBLK = 256, NTHR = 512;

constexpr size_t OFF_CTL = 0;
constexpr size_t OFF_MOD = 1048576;
constexpr size_t OFF_ROPE = 1572864;
constexpr size_t OFF_WT = 2097152;
constexpr size_t WT_ABIN = OFF_WT;
constexpr size_t WT_ABOUT = WT_ABIN + (size_t)ABINP * DM * 2;
constexpr size_t WT_W1_0 = WT_ABOUT + (size_t)DM * DM * 2;
constexpr size_t WT_W2_0 = WT_W1_0 + (size_t)FF * DM * 2;
constexpr size_t WT_CDIN = WT_W2_0 + (size_t)FF * DM * 2;
constexpr size_t WT_CDOUT = WT_CDIN + (size_t)FF * DM * 2;
constexpr size_t WT_W1_1 = WT_CDOUT + (size_t)DM * DM * 2;
constexpr size_t WT_W2_1 = WT_W1_1 + (size_t)FF * DM * 2;
constexpr size_t OFF_HN = WT_W2_1 + (size_t)FF * DM * 2;
constexpr size_t OFF_ARENA = OFF_HN + (size_t)MT * DM * 2;
constexpr size_t SZ_TOK1K_F32 = (size_t)MT * 1024 * 4;
constexpr size_t A_U0 = 0;
constexpr int OPSZ = 9984;
constexpr size_t A_OPS = 90177536;
constexpr size_t A_PREP = 274726912;
static_assert(A_U0 + (size_t)MT * ABINP * 2 <= A_OPS && A_OPS + (size_t)128 * 144 * OPSZ <= A_PREP, "ws map");
constexpr size_t DO_G = 0;
constexpr size_t DO_SCAL = DO_G + (size_t)MT * 1024 * 2;
constexpr size_t DO_SQ = DO_SCAL + (size_t)MT * 16 * 16;
constexpr size_t DO_SK = DO_SQ + (size_t)MT * 1024 * 2;
constexpr size_t DO_SV = DO_SK + (size_t)MT * 256 * 2;
static_assert(DO_SV + (size_t)MT * 256 * 2 <= (size_t)ML * DM * 4, "d_out scratch");
constexpr size_t A_L0END = A_PREP + 7 * SZ_TOK1K_F32;
constexpr size_t A_YF = A_PREP, A_YB = A_PREP + SZ_TOK1K_F32, A_YA = A_PREP + 2 * SZ_TOK1K_F32;
constexpr size_t A_X1 = 0;
constexpr size_t A_HID = A_X1 + (size_t)MT * DM * 4;
constexpr size_t A_SLAB6 = 83886080;
static_assert(A_SLAB6 >= A_X1 + (size_t)MT * DM * 4 && A_SLAB6 + (size_t)8 * MC * DM * 4 <= A_PREP, "ws map");
constexpr size_t A_X2 = 316669952;
constexpr size_t A_SLAB = A_X2 + (size_t)MT * DM * 4;
static_assert(A_HID + (size_t)MT * FF * 2 <= A_YA, "ws map: HID must not reach YA (read by the out projection while X1 is written; HID is written later)");
static_assert(A_HID + (size_t)MT * FF * 2 <= A_X2, "ws map");
constexpr size_t A_U1 = 0;
static_assert(A_U1 + (size_t)MT * FF * 4 <= A_X2, "ws map");
constexpr size_t A_QD = A_SLAB;
constexpr size_t A_KD = A_QD + (size_t)ML * 1024 * 2;
constexpr size_t A_VD = A_KD + (size_t)MT * 1024 * 2;
constexpr size_t A_OF = A_VD + (size_t)MT * 1024 * 2;
constexpr size_t A_OB = A_OF + (size_t)ML * 1024 * 4;
constexpr size_t A_YC = A_OB + (size_t)ML * 1024 * 4;
constexpr size_t A_L1END = A_YC + (size_t)ML * DM * 2;
constexpr size_t A_X3 = A_U1;
constexpr size_t A_HID1 = A_U1 + (size_t)ML * DM * 4;
static_assert(A_HID1 + (size_t)ML * FF * 2 <= A_X2, "ws map");
constexpr size_t A_END0 = A_SLAB + (size_t)8 * MC * DM * 4;
constexpr size_t WS_TOTAL = OFF_ARENA + (A_L0END > A_L1END ? (A_L0END > A_END0 ? A_L0END : A_END0) : (A_L1END > A_END0 ? A_L1END : A_END0));
static_assert(WS_TOTAL <= 805306368ull, "d_ws budget (4 x the largest tensor)");

constexpr int LDS_BYTES = 147456;

typedef __bf16 hwbf16x2 __attribute__((ext_vector_type(2)));
__device__ __forceinline__ float fexp(float x) { return __builtin_amdgcn_exp2f(x * 1.4426950408889634f); }
__device__ __forceinline__ float flog(float x) { return __builtin_amdgcn_logf(x) * 0.6931471805599453f; }
__device__ __forceinline__ unsigned pk2(float lo, float hi) { const f32x2 v = {lo, hi}; const hwbf16x2 b = __builtin_convertvector(v, hwbf16x2); return __builtin_bit_cast(unsigned, b); }
__device__ __forceinline__ unsigned f2bf(float f) { return pk2(f, 0.f) & 0xffffu; }
__device__ __forceinline__ float dppf(float x, const int ctrl_sel) {
    const int xi = __builtin_bit_cast(int, x); int r;
    if (ctrl_sel == 0) r = __builtin_amdgcn_update_dpp(xi, xi, 0xB1, 0xF, 0xF, true);
    else if (ctrl_sel == 1) r = __builtin_amdgcn_update_dpp(xi, xi, 0x4E, 0xF, 0xF, true);
    else if (ctrl_sel == 2) r = __builtin_amdgcn_update_dpp(xi, xi, 0x141, 0xF, 0xF, true);
    else r = __builtin_amdgcn_update_dpp(xi, xi, 0x140, 0xF, 0xF, true);
    return __builtin_bit_cast(float, r);
}
__device__ __forceinline__ float row16_sum(float x) { x += dppf(x, 0); x += dppf(x, 1); x += dppf(x, 2); x += dppf(x, 3); return x; }
__device__ __forceinline__ float wave_sum(float v) {
    v = row16_sum(v);
    { float p = v, q = v; asm volatile("s_nop 1\n\tv_permlane16_swap_b32 %0, %1" : "+v"(p), "+v"(q)); v = p + q; }
    { float p = v, q = v; asm volatile("s_nop 1\n\tv_permlane32_swap_b32 %0, %1" : "+v"(p), "+v"(q)); v = p + q; }
    return v;
}
__device__ __forceinline__ float row16_max(float x) { x = fmaxf(x, dppf(x, 0)); x = fmaxf(x, dppf(x, 1)); x = fmaxf(x, dppf(x, 2)); x = fmaxf(x, dppf(x, 3)); return x; }
__device__ __forceinline__ float sigmoidf_(float x) { return 1.f / (1.f + __expf(-x)); }

__device__ __forceinline__ void lds_barrier() { asm volatile("s_waitcnt lgkmcnt(0)\n\ts_barrier" ::: "memory"); }

struct Args { const void* in[29]; float* out; unsigned char* ws; int ph_lo, ph_hi; };

namespace pg8 {
#define PG8_LAS __attribute__((address_space(3)))
typedef unsigned short bf16_t;
typedef short bf16x8 __attribute__((ext_vector_type(8)));
typedef float f32x4 __attribute__((ext_vector_type(4)));
typedef unsigned u32x4 __attribute__((ext_vector_type(4)));
constexpr int BM = 256, BK = 64, HALF = 128, HTB = HALF * BK * 2  , STAGE_BYTES = 8 * HTB, NXCD = 8, WGM = 8;

__host__ __device__ __forceinline__ int lds_byte(int r, int c) { const int st = (r >> 4) * 2 + (c >> 5), rr = r & 15, cc = c & 31, ob = rr * 64 + cc * 2; return st * 1024 + (ob ^ (((ob >> 9) & 1) << 5)); }
__host__ __device__ __forceinline__ void stage_rc(int b, int& R, int& C) { const int st = b / 1024, sb = b % 1024, swz = sb ^ (((sb >> 9) & 1) << 5); R = (st >> 1) * 16 + swz / 64; C = (st & 1) * 32 + (swz % 64) / 2; }
__host__ __device__ __forceinline__ int perm32(int rho) { const int n = rho >> 4, i = rho & 15; return 8 * (i >> 2) + 4 * n + (i & 3); }

struct Unit { int pm, pn, ko; };
struct Gemm { const bf16_t* A; const bf16_t* Bt; int M, N, K, ld; };

struct StaticOrder {
    int nM, nN, nwg, G, c;
    __host__ __device__ void init(int M, int N, int G_, int c_) { nM = M / BM; nN = N / BM; nwg = nM * nN; G = G_; c = c_; }
    __host__ __device__ bool next(int i, Unit& u) const {
        const long L = (long)i * G + c; if (L >= nwg) return false;
        int wgid = (int)L; { const int q = nwg / NXCD, r = nwg % NXCD, xcd = wgid % NXCD, off = wgid / NXCD; wgid = (xcd < r ? xcd * (q + 1) : r * (q + 1) + (xcd - r) * q) + off; }
        const int nig = WGM * nN, gid = wgid / nig, fm = gid * WGM, gsz = (nM - fm) < WGM ? (nM - fm) : WGM;
        u.pm = fm + ((wgid % nig) % gsz); u.pn = (wgid % nig) / gsz; u.ko = 0; return true;
    }
    __device__ __forceinline__ void a_ready(const Unit&) const {}
    __device__ __forceinline__ void done(const Unit&) const {}
};

struct SplitKOrder {
    int pm0, nTm, nTn, ns, kslice, G, c;
    __host__ __device__ void init(int pm0_, int nTm_, int nTn_, int ns_, int kslice_, int G_, int c_) { pm0 = pm0_; nTm = nTm_; nTn = nTn_; ns = ns_; kslice = kslice_; G = G_; c = c_; }
    __host__ __device__ bool next(int i, Unit& u) const {
        const long L = (long)i * G + c; if (L >= (long)nTm * nTn * ns) return false;
        const int s = (int)(L % ns), t = (int)(L / ns); u.pm = pm0 + t / nTn; u.pn = t % nTn; u.ko = s * kslice; return true;
    }
    __device__ __forceinline__ void a_ready(const Unit&) const {}
    __device__ __forceinline__ void done(const Unit&) const {}
};

struct EpiF32 {
    static constexpr bool PERM = false, AFTER_DRAIN = false;
    float* O; int ldc;
    __device__ __forceinline__ void operator()(const f32x4 (&acc)[2][2][4][2], const Unit& u, int wr, int wc, int fr, int fq) const {
        const int col0 = u.pn * BM + wc * 32 + 4 * fq;
#pragma unroll
        for (int ai = 0; ai < 2; ++ai)
#pragma unroll
            for (int m = 0; m < 4; ++m) { float* rowp = O + (size_t)(u.pm * BM + ai * HALF + wr * 64 + m * 16 + fr) * ldc + col0;
#pragma unroll
                for (int bj = 0; bj < 2; ++bj)
#pragma unroll
                    for (int n = 0; n < 2; ++n) *(f32x4*)(rowp + bj * HALF + n * 16) = acc[ai][bj][m][n]; }
    }
};
struct EpiResGate {
    static constexpr bool PERM = false, AFTER_DRAIN = false;
    const float* baseL; const float* baseC; float* out; const float* gate;
    __device__ __forceinline__ void operator()(const f32x4 (&acc)[2][2][4][2], const Unit& u, int wr, int wc, int fr, int fq) const {
        const int col0 = u.pn * BM + wc * 32 + 4 * fq;
        const int rowt = u.pm * BM;
        const int rg = rowt < 8192 ? (rowt >> 11) : 4;
        const float* gp = gate + (size_t)rg * 12288 + col0;
        f32x4 gv[2][2];
#pragma unroll
        for (int bj = 0; bj < 2; ++bj)
#pragma unroll
            for (int n = 0; n < 2; ++n) gv[bj][n] = *(const f32x4*)(gp + bj * HALF + n * 16);
#pragma unroll
        for (int ai = 0; ai < 2; ++ai) {
            f32x4 bb[4][2][2];
#pragma unroll
            for (int m = 0; m < 4; ++m) { const int row = rowt + ai * HALF + wr * 64 + m * 16 + fr;
                const float* bp = (row < 8192 ? baseL + (size_t)row * 2048 : baseC + (size_t)(row - 8192) * 2048) + col0;
#pragma unroll
                for (int bj = 0; bj < 2; ++bj)
#pragma unroll
                    for (int n = 0; n < 2; ++n) bb[m][bj][n] = *(const f32x4*)(bp + bj * HALF + n * 16); }
#pragma unroll
            for (int m = 0; m < 4; ++m) { const int row = rowt + ai * HALF + wr * 64 + m * 16 + fr;
                float* op = out + (size_t)row * 2048 + col0;
#pragma unroll
                for (int bj = 0; bj < 2; ++bj)
#pragma unroll
                    for (int n = 0; n < 2; ++n) *(f32x4*)(op + bj * HALF + n * 16) = bb[m][bj][n] + gv[bj][n] * acc[ai][bj][m][n]; }
        }
    }
};
struct EpiSqReluBf16 {
    static constexpr bool PERM = true, AFTER_DRAIN = false;
    bf16_t* O; int ldc;
    __device__ __forceinline__ unsigned pk(float lo, float hi) const { return ::pk2(lo, hi); }
    __device__ __forceinline__ void operator()(const f32x4 (&acc)[2][2][4][2], const Unit& u, int wr, int wc, int fr, int fq) const {
        const int col0 = u.pn * BM + wc * 32 + 8 * fq;
#pragma unroll
        for (int ai = 0; ai < 2; ++ai)
#pragma unroll
            for (int m = 0; m < 4; ++m) { bf16_t* rowp = O + (size_t)(u.pm * BM + ai * HALF + wr * 64 + m * 16 + fr) * ldc + col0;
#pragma unroll
                for (int bj = 0; bj < 2; ++bj) { f32x4 v0 = acc[ai][bj][m][0], v1 = acc[ai][bj][m][1];
#pragma unroll
                    for (int e = 0; e < 4; ++e) { const int i0 = __float_as_int(v0[e]), i1 = __float_as_int(v1[e]); const float a0 = __int_as_float(i0 > 0 ? i0 : 0), a1 = __int_as_float(i1 > 0 ? i1 : 0); v0[e] = a0 * a0; v1[e] = a1 * a1; }
                    u32x4 w; w.x = pk(v0[0], v0[1]); w.y = pk(v0[2], v0[3]); w.z = pk(v1[0], v1[1]); w.w = pk(v1[2], v1[3]);
                    *(u32x4*)(rowp + bj * HALF) = w; } }
    }
};


struct EpiSlab {
    static constexpr bool PERM = true, AFTER_DRAIN = false;
    bf16_t* O; int row0, kslice; size_t slab_stride;
    __device__ __forceinline__ void operator()(const f32x4 (&acc)[2][2][4][2], const Unit& u, int wr, int wc, int fr, int fq) const {
        const int col0 = u.pn * BM + wc * 32 + 8 * fq; bf16_t* Ob = O + (size_t)(u.ko / kslice) * slab_stride;
#pragma unroll
        for (int ai = 0; ai < 2; ++ai)
#pragma unroll
            for (int m = 0; m < 4; ++m) { bf16_t* rowp = Ob + (size_t)(u.pm * BM - row0 + ai * HALF + wr * 64 + m * 16 + fr) * 2048 + col0;
#pragma unroll
                for (int bj = 0; bj < 2; ++bj) { const f32x4 v0 = acc[ai][bj][m][0], v1 = acc[ai][bj][m][1];
                    u32x4 w; w.x = ::pk2(v0[0], v0[1]); w.y = ::pk2(v0[2], v0[3]); w.z = ::pk2(v1[0], v1[1]); w.w = ::pk2(v1[2], v1[3]);
                    *(u32x4*)(rowp + bj * HALF) = w; } }
    }
};

struct EpiBf16Plain {
    static constexpr bool PERM = true, AFTER_DRAIN = false;
    bf16_t* O; int ldc;
    __device__ __forceinline__ void operator()(const f32x4 (&acc)[2][2][4][2], const Unit& u, int wr, int wc, int fr, int fq) const {
        const int col0 = u.pn * BM + wc * 32 + 8 * fq;
#pragma unroll
        for (int ai = 0; ai < 2; ++ai)
#pragma unroll
            for (int m = 0; m < 4; ++m) { bf16_t* rowp = O + (size_t)(u.pm * BM + ai * HALF + wr * 64 + m * 16 + fr) * ldc + col0;
#pragma unroll
                for (int bj = 0; bj < 2; ++bj) { const f32x4 v0 = acc[ai][bj][m][0], v1 = acc[ai][bj][m][1];
                    u32x4 w; w.x = ::pk2(v0[0], v0[1]); w.y = ::pk2(v0[2], v0[3]); w.z = ::pk2(v1[0], v1[1]); w.w = ::pk2(v1[2], v1[3]);
                    *(u32x4*)(rowp + bj * HALF) = w; } }
    }
};

struct EpiCdIn {
    static constexpr bool PERM = false, AFTER_DRAIN = false;
    bf16_t* QD; bf16_t* KD; bf16_t* VD; bf16_t* U1; const float* tab;
    __device__ __forceinline__ void operator()(const f32x4 (&acc)[2][2][4][2], const Unit& u, int wr, int wc, int fr, int fq) const {
        const int rowt = u.pm * BM;
        if (u.pn >= 12) {
            const int col0 = u.pn * BM + wc * 32 + 4 * fq;
#pragma unroll
            for (int ai = 0; ai < 2; ++ai)
#pragma unroll
                for (int m = 0; m < 4; ++m) { bf16_t* rowp = U1 + (size_t)(rowt + ai * HALF + wr * 64 + m * 16 + fr) * 8192 + col0;
#pragma unroll
                    for (int bj = 0; bj < 2; ++bj)
#pragma unroll
                        for (int n = 0; n < 2; ++n) { const f32x4 v = acc[ai][bj][m][n]; u32x2 w; w.x = ::pk2(v[0], v[1]); w.y = ::pk2(v[2], v[3]); *(u32x2*)(rowp + bj * HALF + n * 16) = w; } }
        } else if (u.pn >= 8) {
            const int col0 = (u.pn - 8) * BM + wc * 32 + 4 * fq;
#pragma unroll
            for (int ai = 0; ai < 2; ++ai)
#pragma unroll
                for (int m = 0; m < 4; ++m) { bf16_t* rowp = VD + (size_t)(rowt + ai * HALF + wr * 64 + m * 16 + fr) * 1024 + col0;
#pragma unroll
                    for (int bj = 0; bj < 2; ++bj)
#pragma unroll
                        for (int n = 0; n < 2; ++n) { const f32x4 v = acc[ai][bj][m][n]; u32x2 w; w.x = ::pk2(v[0], v[1]); w.y = ::pk2(v[2], v[3]); *(u32x2*)(rowp + bj * HALF + n * 16) = w; } }
        } else {
            const bool isk = u.pn >= 4; const bool lat = rowt < 8192;
            if (!isk && !lat) return;
            bf16_t* dst = isk ? KD : QD; const int G = wc & 1, i0 = 16 * G + 4 * fq;
            f32x4 tc01[2][4], tc23[2][4];
#pragma unroll
            for (int ai = 0; ai < 2; ++ai)
#pragma unroll
                for (int m = 0; m < 4; ++m) { const int t = (rowt + ai * HALF + wr * 64 + m * 16 + fr) & 2047;
                    tc01[ai][m] = (f32x4){1.f, 0.f, 1.f, 0.f}; tc23[ai][m] = tc01[ai][m];
                    if (lat) { const float* tp = tab + (size_t)(((G == 0) ? (t >> 6) : (t & 63)) * 16 + 4 * fq) * 2; tc01[ai][m] = *(const f32x4*)tp; tc23[ai][m] = *(const f32x4*)(tp + 4); } }
#pragma unroll
            for (int ai = 0; ai < 2; ++ai)
#pragma unroll
                for (int m = 0; m < 4; ++m) { const int row = rowt + ai * HALF + wr * 64 + m * 16 + fr;
                    const f32x4 c01 = tc01[ai][m], c23 = tc23[ai][m];
#pragma unroll
                    for (int bj = 0; bj < 2; ++bj) { const int hs = (u.pn & 3) * 4 + bj * 2 + (wc >> 1); const f32x4 x1 = acc[ai][bj][m][0], x2 = acc[ai][bj][m][1];
                        const f32x4 o1 = {x1[0] * c01[0] - x2[0] * c01[1], x1[1] * c01[2] - x2[1] * c01[3], x1[2] * c23[0] - x2[2] * c23[1], x1[3] * c23[2] - x2[3] * c23[3]};
                        const f32x4 o2 = {x1[0] * c01[1] + x2[0] * c01[0], x1[1] * c01[3] + x2[1] * c01[2], x1[2] * c23[1] + x2[2] * c23[0], x1[3] * c23[3] + x2[3] * c23[2]};
                        bf16_t* rp = dst + (size_t)row * 1024 + hs * 64 + i0;
                        u32x2 w; w.x = ::pk2(o1[0], o1[1]); w.y = ::pk2(o1[2], o1[3]); *(u32x2*)rp = w;
                        w.x = ::pk2(o2[0], o2[1]); w.y = ::pk2(o2[2], o2[3]); *(u32x2*)(rp + 32) = w; } }
        }
    }
};
template <class Epi, class Sched, bool ALIGN_EPI = false, bool SP2 = false>
__device__ __forceinline__ void gemm_phase(PG8_LAS unsigned char* lds, const Gemm g, const Sched& S, const Epi& E) {
    const int tid = threadIdx.x, wid = __builtin_amdgcn_readfirstlane(tid >> 6), lane = tid & 63, wr = wid >> 2, wc = wid & 3, fr = lane & 15, fq = lane >> 4;
    const int K = g.K, nt = K / BK, LD = g.ld;
    unsigned voffA[2], voffB[2];
#pragma unroll
    for (int i = 0; i < 2; ++i) { int R, C; stage_rc(tid * 16 + i * 8192, R, C); const int Rb = Epi::PERM ? ((R & ~31) + perm32(R & 31)) : R;
        voffA[i] = (unsigned)(R * LD + C) * 2u; voffB[i] = (unsigned)(Rb * LD + C) * 2u; }
    const size_t kstep = (size_t)(BK * 2);
    const size_t hstep = (size_t)HALF * LD * 2;
    const size_t tstep = 2 * hstep;
    const unsigned ldsw = (unsigned)wid * 1024u;
    const int aoff = lds_byte(wr * 64 + fr, fq * 8), boff = lds_byte(wc * 32 + fr, fq * 8);
#define PG8_SA(b, h) (((b) * 2 + (h)) * HTB)
#define PG8_SB(b, h) ((4 + (b) * 2 + (h)) * HTB)
#define PG8_STAGE(bufoff, gbase, voff) do { _Pragma("unroll") for (int _i = 0; _i < 2; ++_i) \
        __builtin_amdgcn_global_load_lds((const unsigned*)((const char*)(gbase) + (voff)[_i]), (PG8_LAS unsigned*)(lds + (bufoff) + ldsw + _i * 8192), 16, 0, 0); } while (0)
#define PG8_LDA(dst, b, h) do { _Pragma("unroll") for (int m = 0; m < 4; ++m) _Pragma("unroll") for (int k = 0; k < 2; ++k) dst[m][k] = *(const PG8_LAS bf16x8*)(lds + PG8_SA(b, h) + aoff + m * 2048 + k * 1024); } while (0)
#define PG8_LDB(dst, b, h) do { _Pragma("unroll") for (int n = 0; n < 2; ++n) _Pragma("unroll") for (int k = 0; k < 2; ++k) dst[n][k] = *(const PG8_LAS bf16x8*)(lds + PG8_SB(b, h) + boff + n * 2048 + k * 1024); } while (0)
#define PG8_MMA(ai, bj, At, Bt) do { __builtin_amdgcn_s_setprio(1); _Pragma("unroll") for (int m = 0; m < 4; ++m) _Pragma("unroll") for (int n = 0; n < 2; ++n) _Pragma("unroll") for (int k = 0; k < 2; ++k) \
        acc[ai][bj][m][n] = __builtin_amdgcn_mfma_f32_16x16x32_bf16(Bt[n][k], At[m][k], acc[ai][bj][m][n], 0, 0, 0); __builtin_amdgcn_s_setprio(0); } while (0)
#define PG8_WAIT_V(n) asm volatile("s_waitcnt vmcnt(" #n ")" ::: "memory")
#define PG8_WAIT_L(n) asm volatile("s_waitcnt lgkmcnt(" #n ")" ::: "memory")
#define PG8_BAR __builtin_amdgcn_s_barrier()
#define PG8_SCHED __builtin_amdgcn_sched_barrier(0)
    Unit cur, nxt; int ui = 0;
    if (!S.next(0, cur)) return;
    f32x4 acc[2][2][4][2];
#pragma unroll
    for (int a = 0; a < 2; ++a)
#pragma unroll
        for (int b = 0; b < 2; ++b)
#pragma unroll
            for (int m = 0; m < 4; ++m)
#pragma unroll
                for (int n = 0; n < 2; ++n) acc[a][b][m][n] = (f32x4){0.f, 0.f, 0.f, 0.f};
    bf16x8 At[4][2], B0[2][2], B1[2][2];
    const char* cA = (const char*)g.A + (size_t)cur.pm * tstep + (size_t)cur.ko * 2; const char* cB = (const char*)g.Bt + (size_t)cur.pn * tstep + (size_t)cur.ko * 2;
    S.a_ready(cur);
    if constexpr (SP2) {
        PG8_STAGE(PG8_SB(0, 0), cB, voffB); PG8_STAGE(PG8_SB(0, 1), cB + hstep, voffB); PG8_STAGE(PG8_SA(0, 0), cA, voffA); PG8_STAGE(PG8_SA(0, 1), cA + hstep, voffA);
        if (wr == 1) PG8_BAR;
        PG8_WAIT_V(2); PG8_BAR;
        PG8_STAGE(PG8_SB(1, 0), cB + kstep, voffB); PG8_STAGE(PG8_SA(1, 0), cA + kstep, voffA); PG8_STAGE(PG8_SB(1, 1), cB + hstep + kstep, voffB);
        PG8_WAIT_V(6); PG8_BAR;
    } else {
        PG8_STAGE(PG8_SB(0, 0), cB, voffB); PG8_STAGE(PG8_SA(0, 0), cA, voffA); PG8_STAGE(PG8_SB(0, 1), cB + hstep, voffB); PG8_STAGE(PG8_SA(0, 1), cA + hstep, voffA);
        if (wr == 1) PG8_BAR;
        PG8_WAIT_V(4); PG8_BAR;
        PG8_STAGE(PG8_SB(1, 0), cB + kstep, voffB); PG8_STAGE(PG8_SA(1, 0), cA + kstep, voffA); PG8_STAGE(PG8_SB(1, 1), cB + hstep + kstep, voffB);
        PG8_WAIT_V(6); PG8_BAR;
    }
    for (;;) {
        const bool has_next = S.next(ui + 1, nxt);
        const char* nA = has_next ? (const char*)g.A + (size_t)nxt.pm * tstep + (size_t)nxt.ko * 2 : cA; const char* nB = has_next ? (const char*)g.Bt + (size_t)nxt.pn * tstep + (size_t)nxt.ko * 2 : cB;
        for (int t = 0; t < nt; t += 2) {
            const bool last = (t == nt - 2);
            const char* a1 = cA + (size_t)(t + 1) * kstep;
            const char* a2 = last ? nA : cA + (size_t)(t + 2) * kstep; const char* b2 = last ? nB : cB + (size_t)(t + 2) * kstep;
            const char* a3 = a2 + kstep; const char* b3 = b2 + kstep;
            if (last && has_next) S.a_ready(nxt);
            if constexpr (SP2) {
            PG8_LDB(B0, 0, 0); PG8_LDB(B1, 0, 1); PG8_SCHED; PG8_LDA(At, 0, 0); PG8_STAGE(PG8_SA(1, 1), a1 + hstep, voffA);
            PG8_WAIT_V(8); PG8_WAIT_L(0); PG8_BAR; PG8_MMA(0, 0, At, B0); PG8_MMA(0, 1, At, B1); PG8_BAR; PG8_SCHED;
            PG8_LDA(At, 0, 1); PG8_STAGE(PG8_SB(0, 0), b2, voffB); PG8_STAGE(PG8_SB(0, 1), b2 + hstep, voffB); PG8_STAGE(PG8_SA(0, 0), a2, voffA);
            PG8_WAIT_V(8); PG8_WAIT_L(0); PG8_BAR; PG8_MMA(1, 0, At, B0); PG8_MMA(1, 1, At, B1); PG8_BAR; PG8_SCHED;
            PG8_LDB(B0, 1, 0); PG8_LDB(B1, 1, 1); PG8_SCHED; PG8_LDA(At, 1, 0); PG8_STAGE(PG8_SA(0, 1), a2 + hstep, voffA);
            PG8_WAIT_V(8); PG8_WAIT_L(0); PG8_BAR; PG8_MMA(0, 0, At, B0); PG8_MMA(0, 1, At, B1); PG8_BAR; PG8_SCHED;
            PG8_LDA(At, 1, 1); PG8_STAGE(PG8_SB(1, 0), b3, voffB); PG8_STAGE(PG8_SB(1, 1), b3 + hstep, voffB); PG8_STAGE(PG8_SA(1, 0), a3, voffA);
            PG8_WAIT_V(8); PG8_WAIT_L(0); PG8_BAR; PG8_MMA(1, 0, At, B0); PG8_MMA(1, 1, At, B1); PG8_BAR; PG8_SCHED;
            } else {
            PG8_LDB(B0, 0, 0); PG8_SCHED; PG8_LDA(At, 0, 0); PG8_STAGE(PG8_SA(1, 1), a1 + hstep, voffA);
            PG8_WAIT_L(8); PG8_BAR; PG8_WAIT_L(0); PG8_MMA(0, 0, At, B0); PG8_BAR; PG8_SCHED;
            PG8_LDB(B1, 0, 1); PG8_STAGE(PG8_SB(0, 0), b2, voffB);
            PG8_BAR; PG8_WAIT_L(0); PG8_MMA(0, 1, At, B1); PG8_BAR;
            PG8_LDA(At, 0, 1); PG8_STAGE(PG8_SA(0, 0), a2, voffA);
            PG8_BAR; PG8_WAIT_L(0); PG8_MMA(1, 0, At, B0); PG8_BAR; PG8_SCHED;
            PG8_STAGE(PG8_SB(0, 1), b2 + hstep, voffB);
            PG8_WAIT_V(6); PG8_BAR; PG8_MMA(1, 1, At, B1); PG8_BAR;
            PG8_LDB(B0, 1, 0); PG8_SCHED; PG8_LDA(At, 1, 0); PG8_STAGE(PG8_SA(0, 1), a2 + hstep, voffA);
            PG8_WAIT_L(8); PG8_BAR; PG8_WAIT_L(0); PG8_MMA(0, 0, At, B0); PG8_BAR; PG8_SCHED;
            PG8_LDB(B1, 1, 1); PG8_STAGE(PG8_SB(1, 0), b3, voffB);
            PG8_BAR; PG8_WAIT_L(0); PG8_MMA(0, 1, At, B1); PG8_BAR;
            PG8_LDA(At, 1, 1); PG8_STAGE(PG8_SA(1, 0), a3, voffA);
            PG8_BAR; PG8_WAIT_L(0); PG8_MMA(1, 0, At, B0); PG8_BAR; PG8_SCHED;
            PG8_STAGE(PG8_SB(1, 1), b3 + hstep, voffB);
            PG8_WAIT_V(6); PG8_BAR; PG8_MMA(1, 1, At, B1); PG8_BAR;
            }
        }
        if constexpr (ALIGN_EPI) { if (wr == 0) PG8_BAR; }
        if constexpr (!Epi::AFTER_DRAIN) { E(acc, cur, wr, wc, fr, fq); S.done(cur); }
        if (!has_next) break;
#pragma unroll
        for (int a = 0; a < 2; ++a)
#pragma unroll
            for (int b = 0; b < 2; ++b)
#pragma unroll
                for (int m = 0; m < 4; ++m)
#pragma unroll
                    for (int n = 0; n < 2; ++n) acc[a][b][m][n] = (f32x4){0.f, 0.f, 0.f, 0.f};
        cur = nxt; cA = nA; cB = nB; ++ui;
        if constexpr (ALIGN_EPI) { if (wr == 1) PG8_BAR; }
    }
    PG8_WAIT_V(0);
    if constexpr (!ALIGN_EPI) { if (wr == 0) PG8_BAR; }
    PG8_BAR;
    if constexpr (Epi::AFTER_DRAIN) { E.fused(acc, cur, wr, wc, fr, fq, lds, wid, lane); S.done(cur); }
#undef PG8_SA
#undef PG8_SB
#undef PG8_STAGE
#undef PG8_LDA
#undef PG8_LDB
#undef PG8_MMA
#undef PG8_WAIT_V
#undef PG8_WAIT_L
#undef PG8_BAR
#undef PG8_SCHED
}
}

#define WS_F32(off) ((float*)(a.ws + (off)))
#define WS_BF(off) ((bf16_t*)(a.ws + (off)))
#define AR_F32(off) ((float*)(a.ws + OFF_ARENA + (off)))
#define AR_BF(off) ((bf16_t*)(a.ws + OFF_ARENA + (off)))
#ifdef MK_DIAG
#define DS_INIT() unsigned long long ds_last_ = __builtin_amdgcn_s_memrealtime()
#define DS(k) do { if (blockIdx.x == 0 && threadIdx.x == 0) { const unsigned long long t_ = __builtin_amdgcn_s_memrealtime(); ((unsigned long long*)(a.ws + OFF_CTL))[32 + (k)] += t_ - ds_last_; ds_last_ = t_; } } while (0)
#else
#define DS_INIT() do { } while (0)
#define DS(k) do { } while (0)
#endif

template <bool ROPEPERM = false>
__device__ __forceinline__ void p0_transpose_item(const float* W, int K, int N, bf16_t* WT, LAS float* scr, int item, int lane) {
    const int nblk = N / 32, kb = item / nblk, nb = item % nblk, k0 = 64 * kb, n0 = 32 * nb;
#pragma unroll 8
    for (int i = 0; i < 32; ++i) { const int kk = 2 * i + (lane >> 5); scr[kk * 33 + (lane & 31)] = W[(size_t)(k0 + kk) * N + n0 + (lane & 31)]; }
    asm volatile("s_waitcnt lgkmcnt(0)" ::: "memory");
    const int c = lane & 7;
#pragma unroll
    for (int j = 0; j < 4; ++j) { const int n = (lane >> 3) + 8 * j; const LAS float* s = scr + (8 * c) * 33 + n;
        u32x4 o; o.x = pk2(s[0 * 33], s[1 * 33]); o.y = pk2(s[2 * 33], s[3 * 33]); o.z = pk2(s[4 * 33], s[5 * 33]); o.w = pk2(s[6 * 33], s[7 * 33]);
        int nr = n0 + n;
        if (ROPEPERM && nr < 2048) { const int o64 = nr & 63, x = o64 >> 5, i = o64 & 31; nr = (nr & ~63) + (i >> 4) * 32 + x * 16 + (i & 15); }
        *(u32x4*)(WT + (size_t)nr * K + k0 + 8 * c) = o; }
    asm volatile("s_waitcnt lgkmcnt(0)" ::: "memory");
}

__device__ __forceinline__ void ph_prologue(const Args& a, LAS unsigned char* L) {
    const int tid = threadIdx.x, lane = tid & 63, wave = tid >> 6, bid = blockIdx.x, nblk = gridDim.x;
    float* mod = WS_F32(OFF_MOD);
    for (int it = bid; it < 256; it += nblk) {
        const int l = it >> 7, n0 = (it & 127) * 96;
        LAS float* sl = (LAS float*)L;
        LAS float* part = sl + 5 * 2048;
        const float* cin = (const float*)a.in[1]; const float* cctx = (const float*)a.in[3];
        for (int i = tid; i < 5 * 2048; i += NTHR) { const int r = i >> 11, k = i & 2047; const float x = r < 4 ? cin[r * 2048 + k] : cctx[k]; sl[i] = x / (1.f + expf(-x)); }
        __syncthreads();
        const int ln = lane < 48 ? lane : 47;
        const float* W = (const float*)a.in[4] + (size_t)l * 2048 * 12288 + n0 + 2 * ln;
        float acc0[5], acc1[5];
#pragma unroll
        for (int r = 0; r < 5; ++r) { acc0[r] = 0.f; acc1[r] = 0.f; }
        const int kb = wave * 256;
#pragma unroll 8
        for (int k = 0; k < 256; ++k) { const f32x2 wv = *(const f32x2*)(W + (size_t)(kb + k) * 12288);
#pragma unroll
            for (int r = 0; r < 5; ++r) { const float s = sl[r * 2048 + kb + k]; acc0[r] += s * wv.x; acc1[r] += s * wv.y; } }
        if (lane < 48) {
#pragma unroll
            for (int r = 0; r < 5; ++r) { part[(wave * 5 + r) * 96 + 2 * lane] = acc0[r]; part[(wave * 5 + r) * 96 + 2 * lane + 1] = acc1[r]; } }
        __syncthreads();
        const float* ab = (const float*)a.in[5] + (size_t)l * 12288 + n0;
        for (int i = tid; i < 480; i += NTHR) { const int r = i / 96, c = i - r * 96; float s = 0.f;
#pragma unroll
            for (int w = 0; w < 8; ++w) s += part[(w * 5 + r) * 96 + c];
            mod[(size_t)(l * 5 + r) * 12288 + n0 + c] = s + ab[c]; }
        __syncthreads();
    }
    if (bid == nblk - 1) {
        f32x2* tab = (f32x2*)(a.ws + OFF_ROPE);
        for (int i = tid; i < 1024; i += NTHR) { const int pos = i >> 4, f = i & 15; const float inv = powf(10000.f, -(float)f * 0.0625f); const float ang = (float)pos * inv;
            f32x2 cs; cs.x = cosf(ang); cs.y = sinf(ang); tab[i] = cs; }
    }
}
__device__ __forceinline__ void ph_l0_weights(const Args& a, LAS unsigned char* L) {
    const int tid = threadIdx.x, lane = tid & 63, wave = tid >> 6, bid = blockIdx.x, nblk = gridDim.x;
    { u32x4* z = (u32x4*)(a.ws + WT_ABIN + (size_t)4800 * DM * 2); const u32x4 zero = {0u, 0u, 0u, 0u};
      for (int i = bid * NTHR + tid; i < 64 * DM * 2 / 16; i += nblk * NTHR) z[i] = zero; }
    LAS float* scr = (LAS float*)(L + wave * 16384);
    const int gw = bid * 8 + wave, NGW = nblk * 8;
    constexpr int I0 = 32 * 150, I1 = 32 * 64, I2 = 32 * 256, I3 = 128 * 64;
    constexpr int NITEMS = I0 + I1 + I2 + I3;
    struct WItem { const float* W; bf16_t* WT; int K, N, r; };
    auto decode = [&](int it) { WItem w; int r = it;
        if (r < I0) { w.W = (const float*)a.in[9]; w.WT = WS_BF(WT_ABIN); w.K = 2048; w.N = 4800; }
        else if ((r -= I0) < I1) { w.W = (const float*)a.in[10]; w.WT = WS_BF(WT_ABOUT); w.K = 2048; w.N = 2048; }
        else if ((r -= I1) < I2) { w.W = (const float*)a.in[6]; w.WT = WS_BF(WT_W1_0); w.K = 2048; w.N = 8192; }
        else { r -= I2; w.W = (const float*)a.in[7]; w.WT = WS_BF(WT_W2_0); w.K = 8192; w.N = 2048; }
        w.r = r; return w; };
    auto wload = [&](const WItem& w, float (&ld)[32]) { const int nb_ = w.N / 32, kb = w.r / nb_, nb = w.r % nb_, k0 = 64 * kb, n0 = 32 * nb;
#pragma unroll
        for (int i = 0; i < 32; ++i) { const int kk = 2 * i + (lane >> 5); ld[i] = w.W[(size_t)(k0 + kk) * w.N + n0 + (lane & 31)]; } };
    if (gw < NITEMS) {
        float ld[32]; WItem cur = decode(gw); wload(cur, ld);
        for (int it = gw; it < NITEMS; it += NGW) {
            const WItem nxt = decode(it + NGW < NITEMS ? it + NGW : it);
            float ln[32]; wload(nxt, ln);
            const int nb_ = cur.N / 32, kb = cur.r / nb_, nb = cur.r % nb_, k0 = 64 * kb, n0 = 32 * nb;
#pragma unroll
            for (int i = 0; i < 32; ++i) { const int kk = 2 * i + (lane >> 5); scr[kk * 33 + (lane & 31)] = ld[i]; }
            asm volatile("s_waitcnt lgkmcnt(0)" ::: "memory");
            const int cc = lane & 7;
#pragma unroll
            for (int j = 0; j < 4; ++j) { const int n = (lane >> 3) + 8 * j; const LAS float* s = scr + (8 * cc) * 33 + n;
                u32x4 o; o.x = pk2(s[0 * 33], s[1 * 33]); o.y = pk2(s[2 * 33], s[3 * 33]); o.z = pk2(s[4 * 33], s[5 * 33]); o.w = pk2(s[6 * 33], s[7 * 33]);
                *(u32x4*)(cur.WT + (size_t)(n0 + n) * cur.K + k0 + 8 * cc) = o; }
            asm volatile("s_waitcnt lgkmcnt(0)" ::: "memory");
            cur = nxt;
#pragma unroll
            for (int i = 0; i < 32; ++i) ld[i] = ln[i];
        }
    }
}
__device__ __forceinline__ void ph_l1_weights(const Args& a, LAS unsigned char* L, int ws, int nw) {
    const int lane = threadIdx.x & 63, gw = blockIdx.x * nw + ws, NGW = gridDim.x * nw;
    LAS float* scr = (LAS float*)(L + 65536 + ws * 10240);
    constexpr int I1 = 32 * 64, I2 = 32 * 256, I3 = 128 * 64;
    constexpr int NITEMS = I2 + I1 + I2 + I3;
    for (int it = gw; it < NITEMS; it += NGW) {
        int r = it;
        if (r < I2) { p0_transpose_item<true>((const float*)a.in[23], 2048, 8192, WS_BF(WT_CDIN), scr, r, lane); continue; } r -= I2;
        if (r < I1) { p0_transpose_item((const float*)a.in[24], 2048, 2048, WS_BF(WT_CDOUT), scr, r, lane); continue; } r -= I1;
        if (r < I2) { p0_transpose_item((const float*)a.in[6] + (size_t)2048 * 8192, 2048, 8192, WS_BF(WT_W1_1), scr, r, lane); continue; } r -= I2;
        p0_transpose_item((const float*)a.in[7] + (size_t)8192 * 2048, 8192, 2048, WS_BF(WT_W2_1), scr, r, lane);
    }
}

__device__ __forceinline__ float bfu(const bf16_t* p) { return __uint_as_float((unsigned)*p << 16); }
__device__ __forceinline__ f32x4 bf4(const bf16_t* p) { const u32x2 w = *(const u32x2*)p; return (f32x4){__uint_as_float(w.x << 16), __uint_as_float(w.x & 0xffff0000u), __uint_as_float(w.y << 16), __uint_as_float(w.y & 0xffff0000u)}; }
__device__ __forceinline__ void ph_modulate(const float* srcL, float* srcC, int nrows, const float* modl, int ish, int isc, bf16_t* HN,
                                            const bf16_t* comb = nullptr, const float* combBase = nullptr, const float* combGate = nullptr) {
    const int tid = threadIdx.x, lane = tid & 63, wave = tid >> 6, gw = blockIdx.x * 8 + wave, NGW = gridDim.x * 8;
    auto rowp = [&](int m) { return (m < 8192 ? srcL + (size_t)m * 2048 : (const float*)srcC + (size_t)(m - 8192) * 2048) + 4 * lane; };
    f32x4 vn[8];
    { const float* x0 = rowp(gw < nrows ? gw : 0);
#pragma unroll
      for (int j = 0; j < 8; ++j) vn[j] = *(const f32x4*)(x0 + 256 * j); }
    for (int m = gw; m < nrows; m += NGW) {
        const int rg = m < 8192 ? (m >> 11) : 4;
        const float* sh = modl + (size_t)rg * 12288 + ish * 2048 + 4 * lane; const float* sc = modl + (size_t)rg * 12288 + isc * 2048 + 4 * lane;
        f32x4 v[8]; float ss = 0.f;
        const bool cmb = comb != nullptr && m >= 8192;
        if (cmb) {
            const size_t so = (size_t)(m - 8192) * 2048 + 4 * lane;
#pragma unroll
            for (int j = 0; j < 8; ++j) { f32x4 s = bf4(comb + so + 256 * j);
#pragma unroll
                for (int k = 1; k < 8; ++k) s = s + bf4(comb + (size_t)k * MC * DM + so + 256 * j);
                v[j] = *(const f32x4*)(combBase + so + 256 * j) + *(const f32x4*)(combGate + 4 * lane + 256 * j) * s; }
        } else {
#pragma unroll
            for (int j = 0; j < 8; ++j) v[j] = vn[j];
        }
#pragma unroll
        for (int j = 0; j < 8; ++j) ss += (v[j].x * v[j].x + v[j].y * v[j].y) + (v[j].z * v[j].z + v[j].w * v[j].w);
        f32x4 s4[8], h4[8];
#pragma unroll
        for (int j = 0; j < 8; ++j) { s4[j] = *(const f32x4*)(sc + 256 * j); h4[j] = *(const f32x4*)(sh + 256 * j); }
        { const int mn = m + NGW; const float* xn = rowp(mn < nrows ? mn : m);
#pragma unroll
          for (int j = 0; j < 8; ++j) vn[j] = *(const f32x4*)(xn + 256 * j); }
        const float rstd = rsqrtf(wave_sum(ss) * (1.f / 2048.f) + 1e-6f);
        if (cmb) { const size_t so = (size_t)(m - 8192) * 2048 + 4 * lane;
#pragma unroll
            for (int j = 0; j < 8; ++j) *(f32x4*)(srcC + so + 256 * j) = v[j]; }
        bf16_t* op = HN + (size_t)m * 2048 + 4 * lane;
#pragma unroll
        for (int j = 0; j < 8; ++j) { const f32x4 o = v[j] * rstd * (s4[j] + 1.f) + h4[j]; u32x2 w; w.x = pk2(o.x, o.y); w.y = pk2(o.z, o.w); *(u32x2*)(op + 256 * j) = w; }
    }
}

__device__ __forceinline__ void ph_final(const Args& a) {
    const int tid = threadIdx.x, lane = tid & 63, wave = tid >> 6, gw = blockIdx.x * 8 + wave, NGW = gridDim.x * 8;
    const float* fn = (const float*)a.in[8] + 4 * lane;
    f32x4 w4[8];
#pragma unroll
    for (int j = 0; j < 8; ++j) w4[j] = *(const f32x4*)(fn + 256 * j);
    f32x4 vn[8];
    { const float* x0 = a.out + (size_t)(gw < ML ? gw : 0) * 2048 + 4 * lane;
#pragma unroll
      for (int j = 0; j < 8; ++j) vn[j] = *(const f32x4*)(x0 + 256 * j); }
    for (int m = gw; m < ML; m += NGW) {
        float* xr = a.out + (size_t)m * 2048 + 4 * lane;
        f32x4 v[8]; float ss = 0.f;
#pragma unroll
        for (int j = 0; j < 8; ++j) { v[j] = vn[j]; ss += (v[j].x * v[j].x + v[j].y * v[j].y) + (v[j].z * v[j].z + v[j].w * v[j].w); }
        { const int mn = m + NGW; const float* xn = a.out + (size_t)(mn < ML ? mn : m) * 2048 + 4 * lane;
#pragma unroll
          for (int j = 0; j < 8; ++j) vn[j] = *(const f32x4*)(xn + 256 * j); }
        const float rstd = rsqrtf(wave_sum(ss) * (1.f / 2048.f) + 1e-6f);
#pragma unroll
        for (int j = 0; j < 8; ++j) *(f32x4*)(xr + 256 * j) = v[j] * rstd * w4[j];
    }
}

struct CpIn { float wv[16], rv[16], kv[16], av[16], bv[16]; };
__device__ __forceinline__ void chunk_prep_load(const Args& a, CpIn& in, int d, int b, int h, int TBi);
template <bool NEXT> __device__ __forceinline__ void chunk_prep_problem(const Args& a, LAS unsigned char* L, CpIn& in, int d, int b, int h, int TBi, int nb, int nTBi);
__device__ __forceinline__ float shifted(const bf16_t* U, int m, int col, int seq_lo, int seq_hi, float mu) {
    const float uc = bfu(U + (size_t)m * ABINP + col);
    const float up = m > seq_lo ? bfu(U + (size_t)(m - 1) * ABINP + col) : 0.f;
    const float un = m + 1 < seq_hi ? bfu(U + (size_t)(m + 1) * ABINP + col) : 0.f;
    return uc + mu * (0.5f * (up + un) - uc);
}
__device__ __forceinline__ void ph_rwkv_prep(const Args& a, LAS unsigned char* L) {
    const int tid = threadIdx.x, lane = tid & 63, wave = tid >> 6, bid = blockIdx.x, nblk = gridDim.x;
    const bf16_t* U = AR_BF(A_U0);
    const float* mu = (const float*)a.in[11];
    const float* w0 = (const float*)a.in[12]; const float* w_up = (const float*)a.in[13]; const float* a0 = (const float*)a.in[14];
    const float* a_up = (const float*)a.in[15]; const float* g_up = (const float*)a.in[16]; const float* k_k = (const float*)a.in[17];
    const float* k_a = (const float*)a.in[18]; const float* r_k = (const float*)a.in[19];
    float* PWF = AR_F32(A_PREP); float* PWB = PWF + (size_t)MT * 1024; float* PR = PWB + (size_t)MT * 1024;
    float* PA = PR + (size_t)MT * 1024; float* PB = PA + (size_t)MT * 1024; float* PK = PB + (size_t)MT * 1024; float* PV = PK + (size_t)MT * 1024;
    bf16_t* PG = (bf16_t*)((unsigned char*)a.out + DO_G); float* SCAL = (float*)((unsigned char*)a.out + DO_SCAL);
    LAS float* lowr = (LAS float*)L;
    LAS float* res = lowr + 32 * 196;
    const int slab = bid & 7, q = tid >> 7, cl = tid & 127, c = slab * 128 + cl;
    const int qw = wave >> 1, chw = slab * 128 + (wave & 1) * 64, fr_ = lane & 15, g_ = lane >> 4;
    const float* wsrc = qw == 0 ? w_up : (qw == 1 ? w_up + 64 * 1024 : (qw == 2 ? a_up : g_up));
    bf16x8 wh[4][2], wl[4][2];
#pragma unroll
    for (int nt = 0; nt < 4; ++nt)
#pragma unroll
        for (int ks = 0; ks < 2; ++ks)
#pragma unroll
            for (int e = 0; e < 8; ++e) { const float wv = wsrc[(size_t)(32 * ks + 8 * g_ + e) * 1024 + chw + 16 * nt + fr_];
                const unsigned hb = f2bf(wv); const float hf = __uint_as_float(hb << 16); wh[nt][ks][e] = (short)hb; wl[nt][ks][e] = (short)f2bf(wv - hf); }
    const float mu_r = mu[c], mu_k = mu[1024 + c], mu_v = mu[2048 + c];
    const float w0f = w0[c], w0b = w0[1024 + c], a0c = a0[c], kkc = k_k[c], kac = k_a[c], rkc = r_k[c];
    const int ivw = qw < 2 ? 0 : qw - 1;
    DS_INIT();
    for (int tile = bid >> 3; tile < MT / 32; tile += (nblk >> 3)) {
        const int m0 = tile * 32; DS(0);
        const int seq_lo = m0 < 8192 ? (m0 & ~2047) : 8192 + ((m0 - 8192) & ~255);
        const int seq_hi = m0 < 8192 ? seq_lo + 2048 : seq_lo + 256;
        {
          f32x4 uc[3], up[3], un[3]; const f32x4 z4 = {0.f, 0.f, 0.f, 0.f};
#pragma unroll
          for (int e = 0; e < 3; ++e) { const int idx = tid + NTHR * e, tt = idx / 48, jq = idx - tt * 48, m = m0 + tt; const bf16_t* p = U + (size_t)m * ABINP + 3072 + 4 * jq;
              uc[e] = bf4(p); up[e] = m > seq_lo ? bf4(p - ABINP) : z4; un[e] = m + 1 < seq_hi ? bf4(p + ABINP) : z4; }
#pragma unroll
          for (int e = 0; e < 3; ++e) { const int idx = tid + NTHR * e, tt = idx / 48, jq = idx - tt * 48, j = 4 * jq;
              const f32x4 mu4 = *(const f32x4*)(mu + 3072 + j); const f32x4 us = uc[e] + mu4 * ((up[e] + un[e]) * 0.5f - uc[e]); f32x4 o;
#pragma unroll
              for (int q4 = 0; q4 < 4; ++q4) { const float sg = __builtin_amdgcn_rcpf(1.f + fexp(j < 64 ? -2.f * us[q4] : -us[q4]));
                  o[q4] = j < 64 ? 2.f * sg - 1.f : (j < 128 ? us[q4] : sg); }
              *(LAS f32x4*)(lowr + tt * 196 + j) = o; } }
        __syncthreads(); DS(1);
#pragma unroll
        for (int mt = 0; mt < 2; ++mt) { f32x4 acc4[4];
#pragma unroll
            for (int nt = 0; nt < 4; ++nt) acc4[nt] = (f32x4){0.f, 0.f, 0.f, 0.f};
#pragma unroll
            for (int ks = 0; ks < 2; ++ks) { const LAS float* xp = lowr + (mt * 16 + fr_) * 196 + ivw * 64 + 32 * ks + 8 * g_;
                const f32x4 x0 = *(const LAS f32x4*)xp, x1 = *(const LAS f32x4*)(xp + 4); const float xs[8] = {x0.x, x0.y, x0.z, x0.w, x1.x, x1.y, x1.z, x1.w};
                bf16x8 xh, xl;
#pragma unroll
                for (int e = 0; e < 8; ++e) { const unsigned hb = f2bf(xs[e]); xh[e] = (short)hb; xl[e] = (short)f2bf(xs[e] - __uint_as_float(hb << 16)); }
#pragma unroll
                for (int nt = 0; nt < 4; ++nt) { acc4[nt] = __builtin_amdgcn_mfma_f32_16x16x32_bf16(xh, wh[nt][ks], acc4[nt], 0, 0, 0);
                    acc4[nt] = __builtin_amdgcn_mfma_f32_16x16x32_bf16(xh, wl[nt][ks], acc4[nt], 0, 0, 0); acc4[nt] = __builtin_amdgcn_mfma_f32_16x16x32_bf16(xl, wh[nt][ks], acc4[nt], 0, 0, 0); } }
#pragma unroll
            for (int nt = 0; nt < 4; ++nt)
#pragma unroll
                for (int r = 0; r < 4; ++r) res[(qw * 32 + mt * 16 + 4 * g_ + r) * 128 + (wave & 1) * 64 + 16 * nt + fr_] = acc4[nt][r]; }
        __syncthreads(); DS(2);
        const int h = c >> 6;
        { const int cq = tid & 31, c4 = slab * 128 + 4 * cq, hq = c4 >> 6;
          const f32x4 z4 = {0.f, 0.f, 0.f, 0.f};
          u32x2 raw[9], rawn[9];
#define PB_LOAD(R, i_) do { const int m_ = m0 + (tid >> 5) + 16 * (i_); const bf16_t* p_ = U + (size_t)m_ * ABINP + c4; const bool hp_ = m_ > seq_lo, hn_ = m_ + 1 < seq_hi; const u32x2 z2_ = {0u, 0u}; \
              _Pragma("unroll") for (int q_ = 0; q_ < 3; ++q_) { R[q_] = *(const u32x2*)(p_ + 1024 * q_); R[3 + q_] = hp_ ? *(const u32x2*)(p_ + 1024 * q_ - ABINP) : z2_; R[6 + q_] = hn_ ? *(const u32x2*)(p_ + 1024 * q_ + ABINP) : z2_; } } while (0)
#define PB_F4(w_) ((f32x4){__uint_as_float((w_).x << 16), __uint_as_float((w_).x & 0xffff0000u), __uint_as_float((w_).y << 16), __uint_as_float((w_).y & 0xffff0000u)})
          PB_LOAD(raw, 0);
#pragma unroll 1
          for (int i = 0; i < 2; ++i) { const int tt = (tid >> 5) + 16 * i, m = m0 + tt;
              if (i == 0) PB_LOAD(rawn, 1);
              const f32x4 rc_ = PB_F4(raw[0]), kc_ = PB_F4(raw[1]), vc_ = PB_F4(raw[2]);
              const f32x4 rp_ = PB_F4(raw[3]), kp2_ = PB_F4(raw[4]), vp_ = PB_F4(raw[5]);
              const f32x4 rn_ = PB_F4(raw[6]), kn_ = PB_F4(raw[7]), vn_ = PB_F4(raw[8]);
#pragma unroll
              for (int q_ = 0; q_ < 9; ++q_) raw[q_] = rawn[q_];
              const f32x4 mur4 = *(const f32x4*)(mu + c4), muk4 = *(const f32x4*)(mu + 1024 + c4), muv4 = *(const f32x4*)(mu + 2048 + c4);
              const f32x4 w0f4 = *(const f32x4*)(w0 + c4), w0b4 = *(const f32x4*)(w0 + 1024 + c4), a04 = *(const f32x4*)(a0 + c4), kk4 = *(const f32x4*)(k_k + c4), ka4 = *(const f32x4*)(k_a + c4), rk4 = *(const f32x4*)(r_k + c4);
              const f32x4 r = rc_ + mur4 * ((rp_ + rn_) * 0.5f - rc_), k = kc_ + muk4 * ((kp2_ + kn_) * 0.5f - kc_), v = vc_ + muv4 * ((vp_ + vn_) * 0.5f - vc_);
              const f32x4 pwf = w0f4 + *(const LAS f32x4*)(res + (0 * 32 + tt) * 128 + 4 * cq), pwb = w0b4 + *(const LAS f32x4*)(res + (1 * 32 + tt) * 128 + 4 * cq);
              const f32x4 pal = a04 + *(const LAS f32x4*)(res + (2 * 32 + tt) * 128 + 4 * cq), g4 = *(const LAS f32x4*)(res + (3 * 32 + tt) * 128 + 4 * cq);
              f32x4 decf, decb, alr;
#pragma unroll
              for (int e2 = 0; e2 < 4; ++e2) { decf[e2] = fexp(-0.6065306597126334f * __builtin_amdgcn_rcpf(1.f + fexp(-pwf[e2]))); decb[e2] = fexp(-0.6065306597126334f * __builtin_amdgcn_rcpf(1.f + fexp(-pwb[e2]))); alr[e2] = __builtin_amdgcn_rcpf(1.f + fexp(-pal[e2])); }
              const f32x4 kkr = k * kk4; const float ssq = row16_sum((kkr.x * kkr.x + kkr.y * kkr.y) + (kkr.z * kkr.z + kkr.w * kkr.w));
              const f32x4 kk = kkr * fminf(__builtin_amdgcn_rsqf(ssq), 1e12f);
              const f32x4 kp = k * ((alr - 1.f) * ka4 + 1.f), ap = -kk, bp = kk * alr;
              const f32x4 t1 = bp * r, t2 = kp * r, t3 = t2 * rk4;
              const float br = row16_sum((t1.x + t1.y) + (t1.z + t1.w)), kr = row16_sum((t2.x + t2.y) + (t2.z + t2.w)), rkr = row16_sum((t3.x + t3.y) + (t3.z + t3.w));
              const size_t o = (size_t)m * 1024 + c4;
              *(f32x4*)(PWF + o) = decf; *(f32x4*)(PWB + o) = decb; *(f32x4*)(PV + o) = v;
              { u32x2 w; w.x = pk2(r.x, r.y); w.y = pk2(r.z, r.w); *(u32x2*)((bf16_t*)PR + o) = w; w.x = pk2(ap.x, ap.y); w.y = pk2(ap.z, ap.w); *(u32x2*)((bf16_t*)PA + o) = w;
                w.x = pk2(bp.x, bp.y); w.y = pk2(bp.z, bp.w); *(u32x2*)((bf16_t*)PB + o) = w; w.x = pk2(kp.x, kp.y); w.y = pk2(kp.z, kp.w); *(u32x2*)((bf16_t*)PK + o) = w; }
              { u32x2 w; w.x = pk2(g4.x, g4.y); w.y = pk2(g4.z, g4.w); *(u32x2*)(PG + o) = w; }
              if ((cq & 15) == 0) { f32x4 s4; s4.x = br; s4.y = kr; s4.z = rkr; s4.w = 0.f; *(f32x4*)(SCAL + ((size_t)m * 16 + hq) * 4) = s4; } }
#undef PB_LOAD
#undef PB_F4
        }
        __syncthreads(); DS(3);
    }
    { const int hh = slab * 2 + (wave & 1), d_ = wave >> 2, tbo = (wave >> 1) & 1, tstep = nblk >> 3;
      auto tile_b = [&](int tile) { const int m0 = tile * 32; return m0 < 8192 ? (m0 >> 11) : ((m0 - 8192) >> 8); };
      auto tile_tb = [&](int tile) { const int m0 = tile * 32; return m0 < 8192 ? 16 + (((m0 & 2047) >> 4) + tbo) : (((m0 - 8192) & 255) >> 4) + tbo; };
      CpIn cin; int tile = bid >> 3;
      if (tile < MT / 32) chunk_prep_load(a, cin, d_, tile_b(tile), hh, tile_tb(tile));
      for (; tile < MT / 32; tile += tstep) {
          if (tile + tstep < MT / 32) chunk_prep_problem<true>(a, L, cin, d_, tile_b(tile), hh, tile_tb(tile), tile_b(tile + tstep), tile_tb(tile + tstep));
          else chunk_prep_problem<false>(a, L, cin, d_, tile_b(tile), hh, tile_tb(tile), 0, 0); } }
    __syncthreads(); DS(4);
    const f32x2* tab = (const f32x2*)(a.ws + OFF_ROPE);
    bf16_t* SQ = (bf16_t*)((unsigned char*)a.out + DO_SQ); bf16_t* SK = (bf16_t*)((unsigned char*)a.out + DO_SK); bf16_t* SV = (bf16_t*)((unsigned char*)a.out + DO_SV);
    const int gw = bid * 8 + wave, NGW = nblk * 8;
    for (int m = gw; m < MT; m += NGW) {
        const bf16_t* ur = U + (size_t)m * ABINP; const bool lat = m < 8192; const int t = m & 2047, prow = t >> 6, pcol = t & 63;
        float x1[10], x2[10];
#pragma unroll
        for (int i = 0; i < 10; ++i) { const int p = lane + 64 * i, hd = p >> 5, ii = p & 31; const int base = hd < 16 ? 3264 + hd * 64 : 4288 + (hd - 16) * 64;
            x1[i] = bfu(ur + base + ii); x2[i] = bfu(ur + base + 32 + ii); }
        const u32x2 vraw = *(const u32x2*)(ur + 4544 + 4 * lane);
#pragma unroll
        for (int i = 0; i < 10; ++i) { const int p = lane + 64 * i, hd = p >> 5, ii = p & 31;
            float o1 = x1[i], o2 = x2[i];
            if (lat) { const f32x2 cs = tab[(ii < 16 ? prow : pcol) * 16 + (ii & 15)]; o1 = x1[i] * cs.x - x2[i] * cs.y; o2 = x1[i] * cs.y + x2[i] * cs.x; }
            bf16_t* dst = hd < 16 ? SQ + (size_t)m * 1024 + hd * 64 : SK + (size_t)m * 256 + (hd - 16) * 64;
            dst[ii] = (bf16_t)f2bf(o1); dst[32 + ii] = (bf16_t)f2bf(o2); }
        *(u32x2*)(SV + (size_t)m * 256 + 4 * lane) = vraw;
    }
    DS(6);
}

constexpr int OP_AT = 0, OP_RT = 2048, OP_BT = 4096, OP_KT = 6144, OP_G1T = 8192, OP_MBRT = 8704, OP_MKRT = 9216, OP_PL = 9728;
__device__ __forceinline__ void chunk_prep_load(const Args& a, CpIn& in, int d, int b, int h, int TBi) {
    const int lane = threadIdx.x & 63;
    const float* P0 = AR_F32(A_PREP);
    const int base = TBi < 16 ? 8192 + b * 256 + 16 * TBi : b * 2048 + 16 * (TBi - 16);
    const float* pw = P0 + (size_t)(d ? 1 : 0) * MT * 1024 + h * 64 + lane; const bf16_t* pr = (const bf16_t*)(P0 + (size_t)2 * MT * 1024) + h * 64 + lane;
    const bf16_t* pa = (const bf16_t*)(P0 + (size_t)3 * MT * 1024) + h * 64 + lane; const bf16_t* pb = (const bf16_t*)(P0 + (size_t)4 * MT * 1024) + h * 64 + lane; const bf16_t* pk = (const bf16_t*)(P0 + (size_t)5 * MT * 1024) + h * 64 + lane;
#pragma unroll
    for (int j = 0; j < 16; ++j) { const size_t mo = (size_t)(base + (d ? 15 - j : j)) * 1024;
        in.wv[j] = pw[mo]; in.rv[j] = bfu(pr + mo); in.kv[j] = bfu(pk + mo); in.av[j] = bfu(pa + mo); in.bv[j] = bfu(pb + mo); }
}
template <bool NEXT>
__device__ __forceinline__ void chunk_prep_problem(const Args& a, LAS unsigned char* L, CpIn& in, int d, int b, int h, int TBi, int nb, int nTBi) {
    const int tid = threadIdx.x, lane = tid & 63, wave = tid >> 6, fr = lane & 15, g = lane >> 4;
    unsigned char* OPS = a.ws + OFF_ARENA + A_OPS;
    LAS bf16_t* Abf = (LAS bf16_t*)(L + wave * 13312); LAS bf16_t* Rbf = Abf + 16 * 72; LAS bf16_t* Bbf = Rbf + 16 * 72; LAS bf16_t* Kbf = Bbf + 16 * 72;
    LAS bf16_t* ATr = Kbf + 16 * 72;
    LAS float* NabL = (LAS float*)(ATr + 64 * 16);
    LAS bf16_t* NakL = (LAS bf16_t*)(NabL + 256);
    LAS bf16_t* TT = NakL + 256;
    const bf16x8 zero8 = {0, 0, 0, 0, 0, 0, 0, 0};
    {
        const int chain = d * 64 + b * 16 + h;
        const int c = TBi < 16 ? (d ? 15 - TBi : TBi) : 16 + (d ? 127 - (TBi - 16) : TBi - 16);
        unsigned char* op = OPS + (size_t)(chain * 144 + c) * OPSZ;
        float P = 1.f; unsigned apk[8], bpk[8], kpk[8];
        {
#pragma unroll
            for (int j = 0; j < 16; ++j) { const float Pp = P; P *= in.wv[j]; const float inv = __builtin_amdgcn_rcpf(P);
                const unsigned ah = f2bf(in.av[j] * Pp), rh = f2bf(in.rv[j] * P), bh_ = f2bf(in.bv[j] * inv), kh = f2bf(in.kv[j] * inv);
                Abf[j * 72 + lane] = (bf16_t)ah; Rbf[j * 72 + lane] = (bf16_t)rh; Bbf[j * 72 + lane] = (bf16_t)bh_; Kbf[j * 72 + lane] = (bf16_t)kh;
                ((bf16_t*)(op + OP_RT))[j * 64 + lane] = (bf16_t)rh;
                if (j & 1) { apk[j >> 1] |= ah << 16; bpk[j >> 1] |= bh_ << 16; kpk[j >> 1] |= kh << 16; } else { apk[j >> 1] = ah; bpk[j >> 1] = bh_; kpk[j >> 1] = kh; } } }
        *(LAS u32x4*)(ATr + lane * 16) = (u32x4){apk[0], apk[1], apk[2], apk[3]}; *(LAS u32x4*)(ATr + lane * 16 + 8) = (u32x4){apk[4], apk[5], apk[6], apk[7]};
        *(u32x4*)(op + OP_BT + lane * 32) = (u32x4){bpk[0], bpk[1], bpk[2], bpk[3]}; *(u32x4*)(op + OP_BT + lane * 32 + 16) = (u32x4){bpk[4], bpk[5], bpk[6], bpk[7]};
        *(u32x4*)(op + OP_KT + lane * 32) = (u32x4){kpk[0], kpk[1], kpk[2], kpk[3]}; *(u32x4*)(op + OP_KT + lane * 32 + 16) = (u32x4){kpk[4], kpk[5], kpk[6], kpk[7]};
        ((float*)(op + OP_PL))[lane] = P;
        if (NEXT) chunk_prep_load(a, in, d, nb, h, nTBi);
        f32x4 nab = {0.f, 0.f, 0.f, 0.f}, nak = nab, mbr = nab, mkr = nab;
#pragma unroll
        for (int ks = 0; ks < 2; ++ks) { const int o = fr * 72 + 32 * ks + 8 * g;
            const bf16x8 fb = *(const LAS bf16x8*)(Bbf + o), fk = *(const LAS bf16x8*)(Kbf + o), fa = *(const LAS bf16x8*)(Abf + o), frr = *(const LAS bf16x8*)(Rbf + o);
            nab = __builtin_amdgcn_mfma_f32_16x16x32_bf16(fb, fa, nab, 0, 0, 0); nak = __builtin_amdgcn_mfma_f32_16x16x32_bf16(fk, fa, nak, 0, 0, 0);
            mbr = __builtin_amdgcn_mfma_f32_16x16x32_bf16(fb, frr, mbr, 0, 0, 0); mkr = __builtin_amdgcn_mfma_f32_16x16x32_bf16(fk, frr, mkr, 0, 0, 0); }
#pragma unroll
        for (int r = 0; r < 4; ++r) { const int j = 4 * g + r; if (!(j < fr)) { nab[r] = 0.f; nak[r] = 0.f; } if (!(j <= fr)) { mbr[r] = 0.f; mkr[r] = 0.f; }
            NabL[j * 16 + fr] = nab[r]; NakL[j * 16 + fr] = (bf16_t)f2bf(nak[r]); }
        { u32x2 w; w.x = pk2(mbr[0], mbr[1]); w.y = pk2(mbr[2], mbr[3]); *(u32x2*)(op + OP_MBRT + (fr * 16 + 4 * g) * 2) = w;
          w.x = pk2(mkr[0], mkr[1]); w.y = pk2(mkr[2], mkr[3]); *(u32x2*)(op + OP_MKRT + (fr * 16 + 4 * g) * 2) = w; }
        { float Tr[16];
#pragma unroll
          for (int t = 0; t < 16; ++t) { float acc = fr == t ? 1.f : 0.f;
#pragma unroll
              for (int j = 0; j < t; ++j) acc += Tr[j] * NabL[j * 16 + t];
              Tr[t] = acc; }
#pragma unroll
          for (int t = 0; t < 16; ++t) TT[t * 16 + fr] = (bf16_t)f2bf(Tr[t]); }
        { const bf16x8 tf = g < 2 ? *(const LAS bf16x8*)(TT + fr * 16 + 8 * g) : zero8;
#pragma unroll
          for (int nt = 0; nt < 4; ++nt) { const bf16x8 af = g < 2 ? *(const LAS bf16x8*)(ATr + (16 * nt + fr) * 16 + 8 * g) : zero8;
              const f32x4 at = __builtin_amdgcn_mfma_f32_16x16x32_bf16(tf, af, (f32x4){0.f, 0.f, 0.f, 0.f}, 0, 0, 0);
#pragma unroll
              for (int r = 0; r < 4; ++r) ((bf16_t*)(op + OP_AT))[(4 * g + r) * 64 + 16 * nt + fr] = (bf16_t)f2bf(at[r]); }
          const bf16x8 nf = g < 2 ? *(const LAS bf16x8*)(NakL + fr * 16 + 8 * g) : zero8;
          const f32x4 g1 = __builtin_amdgcn_mfma_f32_16x16x32_bf16(tf, nf, (f32x4){0.f, 0.f, 0.f, 0.f}, 0, 0, 0);
#pragma unroll
          for (int r = 0; r < 4; ++r) ((bf16_t*)(op + OP_G1T))[(4 * g + r) * 16 + fr] = (bf16_t)f2bf(g1[r]); }
    }
}

__device__ __forceinline__ int chunk_row0(int c, int d, int b) { const int ctx = c < 16 ? 1 : 0, n = 2048 - 1792 * ctx, off = 16 * (c - 16 + 16 * ctx); return b * n + 8192 * ctx + off + d * (n - 1 - 2 * off); }
__device__ __forceinline__ int scan_row(int gs, int d, int b) {
    if (gs < 256) { const int t = d ? 255 - gs : gs; return 8192 + b * 256 + t; }
    const int t2 = gs - 256; const int t = d ? 2047 - t2 : t2; return b * 2048 + t;
}
__device__ __forceinline__ void rwkv_scan_chain(const Args& a, LAS unsigned char* L, int unit) {
    const int tid = threadIdx.x, lane = tid & 63, wave = tid >> 6, fr = lane & 15, g = lane >> 4;
    if (wave >= 2) { ph_l1_weights(a, L, wave - 2, 6); return; }
    const int chain = unit >> 1, d = chain >> 6, b = (chain >> 4) & 3, h = chain & 15;
    const int v0 = 16 * (2 * (unit & 1) + wave);
    const unsigned char* OPS = a.ws + OFF_ARENA + A_OPS + (size_t)chain * 144 * OPSZ;
    const float* PV = AR_F32(A_PREP) + (size_t)6 * MT * 1024 + h * 64 + v0 + fr;
    float* Y = AR_F32(d ? A_YB : A_YF) + h * 64 + v0 + fr;
    const int sgn = d ? -1 : 1;
    f32x4 sacc[4];
#pragma unroll
    for (int mt = 0; mt < 4; ++mt) sacc[mt] = (f32x4){0.f, 0.f, 0.f, 0.f};
    LAS unsigned char* Lw = L + wave * 26624;
    int ldo[10];
#pragma unroll
    for (int i = 0; i < 10; ++i) { const int p = lane + 64 * i; int o;
        if (i < 2) o = (p >> 3) * 144 + (p & 7) * 16;
        else if (i < 4) { const int q = p - 128; o = 2304 + (q >> 3) * 144 + (q & 7) * 16; }
        else if (i < 6) { const int q = p - 256; o = 4608 + (q >> 1) * 48 + (q & 1) * 16; }
        else if (i < 8) { const int q = p - 384; o = 7680 + (q >> 1) * 48 + (q & 1) * 16; }
        else if (i == 8) { const int q = p - 512; o = (q < 32 ? 10752 : 11520 - 32 * 24) + (q >> 1) * 48 + (q & 1) * 16; }
        else { const int q = p - 576; o = q < 32 ? 12288 + (q >> 1) * 48 + (q & 1) * 16 : 13056 + (q - 32) * 16; }
        ldo[i] = o; }
    const bool l9 = lane < 48;
#define CS_DECL(P) u32x4 P##s[10]; float P##v[4]
#define CS_LOAD(P, c_) do { const unsigned char* op_ = OPS + (size_t)(c_) * OPSZ + 16 * lane; \
        _Pragma("unroll") for (int i = 0; i < 9; ++i) P##s[i] = *(const u32x4*)(op_ + 1024 * i); \
        P##s[9] = *(const u32x4*)(op_ + 9216);     \
        { const int r0_ = __builtin_amdgcn_readfirstlane(chunk_row0((c_), d, b)); const float* pv_ = PV + ((ptrdiff_t)r0_ + sgn * (4 * g)) * 1024; \
          _Pragma("unroll") for (int e = 0; e < 4; ++e) P##v[e] = pv_[(ptrdiff_t)sgn * e * 1024]; } } while (0)
#define CS_WRITE(P, slot_) do { LAS unsigned char* sl_ = Lw + (slot_) * 13312; \
        _Pragma("unroll") for (int i = 0; i < 9; ++i) *(LAS u32x4*)(sl_ + ldo[i]) = P##s[i]; \
        *(LAS u32x4*)(l9 ? sl_ + ldo[9] : L + 53248 + 1024 * wave + 16 * lane) = P##s[9]; } while (0)
#define CS_FRAG(slot_) const LAS unsigned char* fs_ = Lw + (slot_) * 13312; u32x2 Fat[2][2], Frt[2][2], Fg1, Fmb, Fmk, Fbt[4], Fkt[4]; f32x4 Fpl[4]; \
        _Pragma("unroll") for (int ks = 0; ks < 2; ++ks) _Pragma("unroll") for (int j = 0; j < 2; ++j) { Fat[ks][j] = *(const LAS u32x2*)(fs_ + fr * 144 + (32 * ks + 16 * j + 4 * g) * 2); Frt[ks][j] = *(const LAS u32x2*)(fs_ + 2304 + fr * 144 + (32 * ks + 16 * j + 4 * g) * 2); } \
        Fg1 = *(const LAS u32x2*)(fs_ + 10752 + fr * 48 + 8 * g); Fmb = *(const LAS u32x2*)(fs_ + 11520 + fr * 48 + 8 * g); Fmk = *(const LAS u32x2*)(fs_ + 12288 + fr * 48 + 8 * g); \
        _Pragma("unroll") for (int mt = 0; mt < 4; ++mt) { Fbt[mt] = *(const LAS u32x2*)(fs_ + 4608 + (16 * mt + fr) * 48 + 8 * g); Fkt[mt] = *(const LAS u32x2*)(fs_ + 7680 + (16 * mt + fr) * 48 + 8 * g); \
            Fpl[mt] = *(const LAS f32x4*)(fs_ + 13056 + (16 * mt + 4 * g) * 4); }
#define CS_STEP(P, c_) do { \
        u32x4 sb0, sb1; sb0.x = pk2(sacc[0][0], sacc[0][1]); sb0.y = pk2(sacc[0][2], sacc[0][3]); sb0.z = pk2(sacc[1][0], sacc[1][1]); sb0.w = pk2(sacc[1][2], sacc[1][3]); \
        sb1.x = pk2(sacc[2][0], sacc[2][1]); sb1.y = pk2(sacc[2][2], sacc[2][3]); sb1.z = pk2(sacc[3][0], sacc[3][1]); sb1.w = pk2(sacc[3][2], sacc[3][3]); \
        const bf16x8 sB0 = __builtin_bit_cast(bf16x8, sb0), sB1 = __builtin_bit_cast(bf16x8, sb1); \
        const u32x4 a0_ = {P##at[0][0].x, P##at[0][0].y, P##at[0][1].x, P##at[0][1].y}, a1_ = {P##at[1][0].x, P##at[1][0].y, P##at[1][1].x, P##at[1][1].y}; \
        const u32x4 r0_ = {P##rt[0][0].x, P##rt[0][0].y, P##rt[0][1].x, P##rt[0][1].y}, r1_ = {P##rt[1][0].x, P##rt[1][0].y, P##rt[1][1].x, P##rt[1][1].y}; \
        f32x4 w1 = __builtin_amdgcn_mfma_f32_16x16x32_bf16(__builtin_bit_cast(bf16x8, a0_), sB0, (f32x4){0.f, 0.f, 0.f, 0.f}, 0, 0, 0); \
        w1 = __builtin_amdgcn_mfma_f32_16x16x32_bf16(__builtin_bit_cast(bf16x8, a1_), sB1, w1, 0, 0, 0); \
        f32x4 y1 = __builtin_amdgcn_mfma_f32_16x16x32_bf16(__builtin_bit_cast(bf16x8, r0_), sB0, (f32x4){0.f, 0.f, 0.f, 0.f}, 0, 0, 0); \
        y1 = __builtin_amdgcn_mfma_f32_16x16x32_bf16(__builtin_bit_cast(bf16x8, r1_), sB1, y1, 0, 0, 0); \
        const unsigned vp0 = pk2(P##vv[0], P##vv[1]), vp1 = pk2(P##vv[2], P##vv[3]); \
        const u32x2 vB2 = {vp0, vp1}; typedef short v4s_ __attribute__((ext_vector_type(4))); \
        const f32x4 u = __builtin_amdgcn_mfma_f32_16x16x16bf16_1k(__builtin_bit_cast(v4s_, P##g1), __builtin_bit_cast(v4s_, vB2), w1, 0, 0, 0);     \
        const u32x4 uvB = {pk2(u[0], u[1]), pk2(u[2], u[3]), vp0, vp1}; const u32x4 mA = {P##mb.x, P##mb.y, P##mk.x, P##mk.y}; \
        const f32x4 y = __builtin_amdgcn_mfma_f32_16x16x32_bf16(__builtin_bit_cast(bf16x8, mA), __builtin_bit_cast(bf16x8, uvB), y1, 0, 0, 0); \
        _Pragma("unroll") for (int mt = 0; mt < 4; ++mt) { const u32x4 bA = {P##bt[mt].x, P##bt[mt].y, P##kt[mt].x, P##kt[mt].y}; \
            sacc[mt] = __builtin_amdgcn_mfma_f32_16x16x32_bf16(__builtin_bit_cast(bf16x8, bA), __builtin_bit_cast(bf16x8, uvB), sacc[mt], 0, 0, 0); sacc[mt] = sacc[mt] * P##pl[mt]; } \
        { const int r0_ = __builtin_amdgcn_readfirstlane(chunk_row0((c_), d, b)); float* py_ = Y + ((ptrdiff_t)r0_ + sgn * (4 * g)) * 1024; \
          _Pragma("unroll") for (int r = 0; r < 4; ++r) py_[(ptrdiff_t)sgn * r * 1024] = y[r]; } } while (0)
    CS_DECL(A); CS_DECL(B); float Fvv[4], vnx[4];
#define CS_DUMMY_ST() do { const int r0_ = __builtin_amdgcn_readfirstlane(chunk_row0(0, d, b)); float* py_ = Y + ((ptrdiff_t)r0_ + sgn * (4 * g)) * 1024; \
        _Pragma("unroll") for (int r = 0; r < 4; ++r) py_[(ptrdiff_t)sgn * r * 1024] = 0.f; } while (0)
    CS_LOAD(A, 0); CS_WRITE(A, 0);
#pragma unroll
    for (int e = 0; e < 4; ++e) Fvv[e] = Av[e];
    __builtin_amdgcn_sched_barrier(0); CS_LOAD(B, 1); __builtin_amdgcn_sched_barrier(0); CS_DUMMY_ST(); __builtin_amdgcn_sched_barrier(0);
    CS_LOAD(A, 2); __builtin_amdgcn_sched_barrier(0); CS_DUMMY_ST(); __builtin_amdgcn_sched_barrier(0);
#undef CS_DUMMY_ST
#define CS_ITER(P, c_) do { CS_WRITE(P, ((c_) + 1) & 1); _Pragma("unroll") for (int e = 0; e < 4; ++e) vnx[e] = P##v[e]; \
        CS_LOAD(P, ((c_) + 3 < 144 ? (c_) + 3 : 143));     \
        { CS_FRAG((c_) & 1); CS_STEP(F, c_); } \
        _Pragma("unroll") for (int e = 0; e < 4; ++e) Fvv[e] = vnx[e]; } while (0)
    for (int c = 0; c < 144; c += 2) { CS_ITER(B, c); CS_ITER(A, c + 1); }
#undef CS_ITER
#undef CS_WRITE
#undef CS_FRAG
#undef CS_DECL
#undef CS_LOAD
#undef CS_STEP
}

__device__ __forceinline__ void rwkv_post_rows(const Args& a, int m0, int m1) {
    const int tid = threadIdx.x, lane = tid & 63, wave = tid >> 6;
    const float* YF = AR_F32(A_YF); const float* YB = AR_F32(A_YB); const float* PV = AR_F32(A_PREP) + (size_t)6 * MT * 1024;
    const bf16_t* PG = (const bf16_t*)((const unsigned char*)a.out + DO_G); const float* SCAL = (const float*)((const unsigned char*)a.out + DO_SCAL); bf16_t* YA = AR_BF(A_YA);
    const float* lnw = (const float*)a.in[20]; const float* lnb = (const float*)a.in[21];
    f32x4 lw4[4], lb4[4];
#pragma unroll
    for (int q = 0; q < 4; ++q) { lw4[q] = *(const f32x4*)(lnw + 256 * q + 4 * lane); lb4[q] = *(const f32x4*)(lnb + 256 * q + 4 * lane); }
    for (int m = m0 + wave; m < m1; m += 8) {
        f32x4 yf[4], yb[4], pv[4]; u32x2 pg[4]; float rk[4];
#pragma unroll
        for (int q = 0; q < 4; ++q) { const size_t o = (size_t)m * 1024 + 256 * q + 4 * lane;
            yf[q] = *(const f32x4*)(YF + o); yb[q] = *(const f32x4*)(YB + o); pv[q] = *(const f32x4*)(PV + o); pg[q] = *(const u32x2*)(PG + o);
            rk[q] = SCAL[((size_t)m * 16 + 4 * q + (lane >> 4)) * 4 + 2]; }
#pragma unroll
        for (int q = 0; q < 4; ++q) { const int c = 256 * q + 4 * lane; const f32x4 y = yf[q] + yb[q];
            const float mean = row16_sum((y.x + y.y) + (y.z + y.w)) * (1.f / 64.f); const f32x4 dl = y - mean;
            const float var = row16_sum((dl.x * dl.x + dl.y * dl.y) + (dl.z * dl.z + dl.w * dl.w)) * (1.f / 64.f); const float rs = rsqrtf(var + 64e-5f);
            const f32x4 w4 = lw4[q], b4 = lb4[q];
            const f32x4 g4 = {__uint_as_float(pg[q].x << 16), __uint_as_float(pg[q].x & 0xffff0000u), __uint_as_float(pg[q].y << 16), __uint_as_float(pg[q].y & 0xffff0000u)};
            const f32x4 o4 = (dl * rs * w4 + b4 + pv[q] * rk[q]) * g4;
            u32x2 w; w.x = pk2(o4.x, o4.y); w.y = pk2(o4.z, o4.w); *(u32x2*)(YA + (size_t)m * 2048 + c) = w; }
    }
}

struct AttnSeg { const bf16_t* K; const bf16_t* V; int n; };
typedef short v4i16_t __attribute__((ext_vector_type(4)));
__device__ __forceinline__ bf16x8 tr_frag(const LAS bf16_t* p0, const LAS bf16_t* p1) {
    const v4i16_t lo = __builtin_amdgcn_ds_read_tr16_b64_v4i16((LAS v4i16_t*)p0), hi = __builtin_amdgcn_ds_read_tr16_b64_v4i16((LAS v4i16_t*)p1);
    return (bf16x8){lo[0], lo[1], lo[2], lo[3], hi[0], hi[1], hi[2], hi[3]};
}
__device__ __forceinline__ float gmax4(float x) {
    float p = x, q = x;
    asm volatile("s_nop 1\n\tv_permlane16_swap_b32 %0, %1\n\ts_nop 1\n\tv_max_f32 %0, %0, %1\n\tv_mov_b32 %1, %0\n\ts_nop 1\n\tv_permlane32_swap_b32 %0, %1\n\ts_nop 1\n\tv_max_f32 %0, %0, %1" : "+v"(p), "+v"(q));
    return p;
}
__device__ __forceinline__ float max17(float m0, const f32x4& a, const f32x4& b, const f32x4& c2, const f32x4& d) {
    float r;
    asm("s_nop 7\n\tv_max3_f32 %0, %1, %2, %3\n\tv_max3_f32 %0, %0, %4, %5\n\tv_max3_f32 %0, %0, %6, %7\n\tv_max3_f32 %0, %0, %8, %9\n\t"
        "v_max3_f32 %0, %0, %10, %11\n\tv_max3_f32 %0, %0, %12, %13\n\tv_max3_f32 %0, %0, %14, %15\n\tv_max3_f32 %0, %0, %16, %17"
        : "=&v"(r) : "v"(m0), "v"(a[0]), "v"(a[1]), "v"(a[2]), "v"(a[3]), "v"(b[0]), "v"(b[1]), "v"(b[2]), "v"(b[3]), "v"(c2[0]), "v"(c2[1]), "v"(c2[2]), "v"(c2[3]), "v"(d[0]), "v"(d[1]), "v"(d[2]), "v"(d[3]));
    return r;
}
__device__ __forceinline__ float max3f(float a, float b, float c2) { float r; asm("v_max3_f32 %0, %1, %2, %3" : "=v"(r) : "v"(a), "v"(b), "v"(c2)); return r; }
__device__ __forceinline__ float gsum4(float x) {
    { float p = x, q = x; asm volatile("s_nop 1\n\tv_permlane16_swap_b32 %0, %1" : "+v"(p), "+v"(q)); x = p + q; }
    { float p = x, q = x; asm volatile("s_nop 1\n\tv_permlane32_swap_b32 %0, %1" : "+v"(p), "+v"(q)); x = p + q; }
    return x;
}
template <bool B> struct BoolC { static constexpr bool value = B; };
template <int DV, int NSUB, bool KSH = false>
__device__ __forceinline__ void attn_unit(LAS unsigned char* L, const bf16_t* Q, int q_stride, AttnSeg sg0, AttnSeg sg1, int k_stride, int v_stride,
                                          bool masked, int qpos0, int kpos0, bool has_sink, float sink, float lmb, const float* subln, float post_scale,
                                          bf16_t* O, int o_stride, unsigned long long* dsp = nullptr) {
    const int tid = threadIdx.x, lane = tid & 63, wave = tid >> 6, fr = lane & 15, g = lane >> 4;
#ifdef MK_DIAG_ATT
    const unsigned long long ds_first_ = __builtin_amdgcn_s_memrealtime();
#endif
    constexpr int KROW = 80, VROW = DV + 16, OROW = DV + 8,
                  NK = KSH ? 1 : NSUB, KBUF = NK * 64 * KROW, VBUF = 64 * VROW;
    LAS bf16_t* Ks = (LAS bf16_t*)L;
    LAS bf16_t* Vs = Ks + 2 * KBUF;
    LAS bf16_t* Ow = Vs + 2 * VBUF + wave * (16 * OROW);
    constexpr bool QLDS = false;
    LAS bf16_t* Qw = Vs + 2 * VBUF + 8 * (16 * OROW) + wave * (NSUB * 2 * 64 * 8);
    bf16x8 qf[NSUB][2];
#pragma unroll
    for (int s = 0; s < NSUB; ++s)
#pragma unroll
        for (int ks = 0; ks < 2; ++ks) { const u32x4 qr = *(const u32x4*)(Q + (size_t)(wave * 16 + fr) * q_stride + s * 64 + ks * 32 + g * 8);
            constexpr float QS = 0.125f * 1.4426950408889634f; u32x4 qs;
            qs.x = pk2(__uint_as_float(qr.x << 16) * QS, __uint_as_float(qr.x & 0xffff0000u) * QS); qs.y = pk2(__uint_as_float(qr.y << 16) * QS, __uint_as_float(qr.y & 0xffff0000u) * QS);
            qs.z = pk2(__uint_as_float(qr.z << 16) * QS, __uint_as_float(qr.z & 0xffff0000u) * QS); qs.w = pk2(__uint_as_float(qr.w << 16) * QS, __uint_as_float(qr.w & 0xffff0000u) * QS);
            qf[s][ks] = __builtin_bit_cast(bf16x8, qs);
            if (QLDS) *(LAS bf16x8*)(Qw + ((s * 2 + ks) * 64 + lane) * 8) = qf[s][ks]; }
    f32x4 o[NSUB][DV / 16];
    float mq[NSUB], lq[NSUB];
    f32x4 cinit[NSUB]; float moff[NSUB];
#pragma unroll
    for (int s = 0; s < NSUB; ++s) {
#pragma unroll
        for (int dt = 0; dt < DV / 16; ++dt) o[s][dt] = (f32x4){0.f, 0.f, 0.f, 0.f};
        mq[s] = has_sink ? ((KSH && s == 1) ? lmb : sink) * 1.4426950408889634f : -INFINITY; lq[s] = (has_sink && g == 0) ? 1.f : 0.f;
        moff[s] = has_sink ? mq[s] : 0.f; cinit[s] = (f32x4){-moff[s], -moff[s], -moff[s], -moff[s]};
    }
    const int nt0 = sg0.n >> 6, T = nt0 + (sg1.n >> 6);
    const int srow = tid >> 3, spc = tid & 7;
    const LAS bf16_t* vtr = Vs + (4 * g + (fr >> 2)) * VROW + 4 * (fr & 3);
    const int qp = qpos0 + wave * 16 + fr;
    u32x4 kregA[NK], kregB[NK]; u32x4 vregA[DV / 64], vregB[DV / 64];
#define ATT_LOAD(kreg, vreg, t_) do { const int tc_ = (t_) < T ? (t_) : T - 1; const bool in0_ = tc_ < nt0; const int j0_ = (in0_ ? tc_ : tc_ - nt0) * 64; \
        const bf16_t* Kp_ = (in0_ ? sg0.K : sg1.K) + (size_t)(j0_ + srow) * k_stride + spc * 8; const bf16_t* Vp_ = (in0_ ? sg0.V : sg1.V) + (size_t)(j0_ + srow) * v_stride + spc * 8; \
        _Pragma("unroll") for (int s = 0; s < NK; ++s) kreg[s] = *(const u32x4*)(Kp_ + s * 64); \
        _Pragma("unroll") for (int p = 0; p < DV / 64; ++p) vreg[p] = *(const u32x4*)(Vp_ + p * 64); } while (0)
#define ATT_WR(kreg, vreg, b_) do { _Pragma("unroll") for (int s = 0; s < NK; ++s) *(LAS u32x4*)(Ks + (b_) * KBUF + (s * 64 + srow) * KROW + spc * 8) = kreg[s]; \
        _Pragma("unroll") for (int p = 0; p < DV / 64; ++p) *(LAS u32x4*)(Vs + (b_) * VBUF + srow * VROW + p * 64 + spc * 8) = vreg[p]; } while (0)
    constexpr float C2 = 0.125f * 1.4426950408889634f;
    lds_barrier();
    ATT_LOAD(kregA, vregA, 0); ATT_LOAD(kregB, vregB, 1); ATT_WR(kregA, vregA, 0); ATT_LOAD(kregA, vregA, 2);
    auto iter = [&](const int t, u32x4 (&kreg)[NK], u32x4 (&vreg)[DV / 64]) {
        const bool in0 = t < nt0; const int j0 = in0 ? t * 64 : (t - nt0) * 64; const int bsel = t & 1;
        lds_barrier();
        ATT_WR(kreg, vreg, bsel ^ 1);
        ATT_LOAD(kreg, vreg, t + 3);
        const int dlo = kpos0 + j0 - (qpos0 + wave * 16) - 15;
        const bool wtile = masked && in0;
        if (wtile && (dlo + 78 < -128 || dlo > 128)) return;
        const bool needmask = wtile && !(dlo >= -128 && dlo + 78 <= 128);
        const LAS bf16_t* kb_ = Ks + bsel * KBUF; const LAS bf16_t* vb_ = vtr + bsel * VBUF;
        bf16x8 pb[NSUB][2];
        f32x4 scA[NSUB][4];
        if constexpr (KSH) {
#pragma unroll
            for (int np = 0; np < 2; ++np) { bf16x8 kf[2][2];
#pragma unroll
                for (int n2 = 0; n2 < 2; ++n2)
#pragma unroll
                    for (int ks = 0; ks < 2; ++ks) kf[n2][ks] = *(const LAS bf16x8*)(kb_ + ((2 * np + n2) * 16 + fr) * KROW + ks * 32 + g * 8);
#pragma unroll
                for (int s = 0; s < NSUB; ++s)
#pragma unroll
                    for (int n2 = 0; n2 < 2; ++n2) { const int nt = 2 * np + n2;
                        scA[s][nt] = __builtin_amdgcn_mfma_f32_16x16x32_bf16(kf[n2][0], qf[s][0], cinit[s], 0, 0, 0);
                        scA[s][nt] = __builtin_amdgcn_mfma_f32_16x16x32_bf16(kf[n2][1], qf[s][1], scA[s][nt], 0, 0, 0); } }
        } else {
#pragma unroll
        for (int s = 0; s < NSUB; ++s) {
            bf16x8 qv[2];
#pragma unroll
            for (int ks = 0; ks < 2; ++ks) qv[ks] = QLDS ? *(const LAS bf16x8*)(Qw + ((s * 2 + ks) * 64 + lane) * 8) : qf[s][ks];
#pragma unroll
            for (int np = 0; np < 2; ++np) { bf16x8 kf[2][2];
#pragma unroll
                for (int n2 = 0; n2 < 2; ++n2)
#pragma unroll
                    for (int ks = 0; ks < 2; ++ks) kf[n2][ks] = *(const LAS bf16x8*)(kb_ + (s * 64 + (2 * np + n2) * 16 + fr) * KROW + ks * 32 + g * 8);
#pragma unroll
                for (int n2 = 0; n2 < 2; ++n2) { const int nt = 2 * np + n2;
                    scA[s][nt] = __builtin_amdgcn_mfma_f32_16x16x32_bf16(kf[n2][0], qv[0], cinit[s], 0, 0, 0);
                    scA[s][nt] = __builtin_amdgcn_mfma_f32_16x16x32_bf16(kf[n2][1], qv[1], scA[s][nt], 0, 0, 0); } } }
        }
#pragma unroll
        for (int s = 0; s < NSUB; ++s) {
            f32x4 (&sc)[4] = scA[s];
            float mx = -INFINITY;
            if (needmask) {
                const int e0 = kpos0 + j0 + 4 * g - qp + 128;
#pragma unroll
                for (int nt = 0; nt < 4; ++nt)
#pragma unroll
                    for (int r = 0; r < 4; ++r) if ((unsigned)(e0 + nt * 16 + r) > 256u) sc[nt][r] = -INFINITY;
            }
            mx = max17(mx, sc[0], sc[1], sc[2], sc[3]);
            if (__any(mx > 8.f || mq[s] == -INFINITY)) {
                const float rel = gmax4(mx);
                const float mn = fmaxf(mq[s], moff[s] + rel);
                const float alpha = (mn == -INFINITY) ? 1.f : __builtin_amdgcn_exp2f(mq[s] - mn);
                const float dm = (mn == -INFINITY) ? 0.f : mn - moff[s];
#pragma unroll
                for (int nt = 0; nt < 4; ++nt) sc[nt] = sc[nt] - dm;
                lq[s] *= alpha;
#pragma unroll
                for (int dt = 0; dt < DV / 16; ++dt) o[s][dt] = o[s][dt] * alpha;
                mq[s] = mn;
                if (mn != -INFINITY) { moff[s] = mn; cinit[s] = (f32x4){-mn, -mn, -mn, -mn}; }
            }
            float rs = 0.f;
#pragma unroll
            for (int nt = 0; nt < 4; ++nt)
#pragma unroll
                for (int r = 0; r < 4; ++r) { const float p = __builtin_amdgcn_exp2f(sc[nt][r]); sc[nt][r] = p; rs += p; }
            lq[s] += rs;
#pragma unroll
            for (int ks = 0; ks < 2; ++ks) { u32x4 w; w.x = pk2(sc[2 * ks][0], sc[2 * ks][1]); w.y = pk2(sc[2 * ks][2], sc[2 * ks][3]); w.z = pk2(sc[2 * ks + 1][0], sc[2 * ks + 1][1]); w.w = pk2(sc[2 * ks + 1][2], sc[2 * ks + 1][3]);
                pb[s][ks] = __builtin_bit_cast(bf16x8, w); }
        }
#pragma unroll
        for (int ks = 0; ks < 2; ++ks)
#pragma unroll
            for (int dh = 0; dh < DV / 64; ++dh) {
                bf16x8 vf[4];
#pragma unroll
                for (int d4 = 0; d4 < 4; ++d4) { const LAS bf16_t* vp = vb_ + (ks * 32) * VROW + (dh * 4 + d4) * 16; vf[d4] = tr_frag(vp, vp + 16 * VROW); }
#pragma unroll
                for (int s = 0; s < NSUB; ++s)
#pragma unroll
                    for (int d4 = 0; d4 < 4; ++d4) o[s][dh * 4 + d4] = __builtin_amdgcn_mfma_f32_16x16x32_bf16(vf[d4], pb[s][ks], o[s][dh * 4 + d4], 0, 0, 0);
            }
    };
    { int t = 0;
      for (; t + 1 < T; t += 2) { iter(t, kregB, vregB); iter(t + 1, kregA, vregA); }
      if (t < T) iter(t, kregB, vregB); }
#undef ATT_LOAD
#undef ATT_WR
    if constexpr (NSUB == 1 || KSH) {
#pragma unroll
        for (int s = 0; s < NSUB; ++s) {
            const float inv = 1.f / gsum4(lq[s]);
#pragma unroll
            for (int dt = 0; dt < DV / 16; ++dt) { u32x2 w; w.x = pk2(o[s][dt][0] * inv, o[s][dt][1] * inv); w.y = pk2(o[s][dt][2] * inv, o[s][dt][3] * inv); *(LAS u32x2*)(Ow + fr * OROW + 16 * dt + 4 * g) = w; }
#pragma unroll
            for (int i = 0; i < DV / 32; ++i) { const int pc = lane + 64 * i, row = pc / (DV / 8), ch = pc % (DV / 8);
                const u32x4 v = *(const LAS u32x4*)(Ow + row * OROW + ch * 8); *(u32x4*)(O + (size_t)(wave * 16 + row) * o_stride + s * DV + ch * 8) = v; }
        }
        __syncthreads();
        return;
    } else {
        const float i0 = 1.f / gsum4(lq[0]), i1 = lmb / gsum4(lq[NSUB - 1]); float ss = 0.f;
#pragma unroll
        for (int dt = 0; dt < DV / 16; ++dt)
#pragma unroll
            for (int r = 0; r < 4; ++r) { const float v = o[0][dt][r] * i0 - o[NSUB - 1][dt][r] * i1; o[0][dt][r] = v; ss += v * v; }
        const float rstd = rsqrtf(gsum4(ss) * (1.f / DV) + 1e-5f) * post_scale;
#pragma unroll
        for (int dt = 0; dt < DV / 16; ++dt) { const f32x4 sl = *(const f32x4*)(subln + 16 * dt + 4 * g);
            u32x2 w; w.x = pk2(o[0][dt][0] * rstd * sl.x, o[0][dt][1] * rstd * sl.y); w.y = pk2(o[0][dt][2] * rstd * sl.z, o[0][dt][3] * rstd * sl.w); *(LAS u32x2*)(Ow + fr * OROW + 16 * dt + 4 * g) = w; }
    }
#pragma unroll
    for (int i = 0; i < DV / 32; ++i) { const int pc = lane + 64 * i, row = pc / (DV / 8), ch = pc % (DV / 8);
        const u32x4 v = *(const LAS u32x4*)(Ow + row * OROW + ch * 8); *(u32x4*)(O + (size_t)(wave * 16 + row) * o_stride + ch * 8) = v; }
    __syncthreads();
#ifdef MK_DIAG_ATT
    if (dsp != nullptr && tid == 0) { const unsigned long long n_ = dsp[32 + 15] / 100ull; dsp[32 + 16 + (n_ < 6 ? n_ : 6)] = __builtin_amdgcn_s_memrealtime() - ds_first_; dsp[32 + 14] += __builtin_amdgcn_s_memrealtime() - ds_first_; dsp[32 + 15] += 100ull; }
#endif
}

__device__ __forceinline__ void ph_mix0(const Args& a, LAS unsigned char* L, const int mode) {
    const int bid = blockIdx.x;
    unsigned* ctl = (unsigned*)(a.ws + OFF_CTL);
    constexpr int CW_RDONE = 2048 + 48, CW_SWAQ = 2048 + 64, CW_RPOSTQ = 2048 + 80;
    DS_INIT();
    rwkv_scan_chain(a, L, bid);
    DS(7);
    asm volatile("s_waitcnt vmcnt(0)" ::: "memory");
    __syncthreads();
    if (threadIdx.x == 0) { __builtin_amdgcn_fence(__ATOMIC_RELEASE, "agent"); asm volatile("s_waitcnt vmcnt(0)" ::: "memory");
        (void)__hip_atomic_fetch_add(ctl + CW_RDONE, 1u, __ATOMIC_RELAXED, __HIP_MEMORY_SCOPE_AGENT); }
    volatile LAS unsigned* slot = (volatile LAS unsigned*)(L + LDS_BYTES - 32);
    const bf16_t* SQ = (const bf16_t*)((const unsigned char*)a.out + DO_SQ); const bf16_t* SK = (const bf16_t*)((const unsigned char*)a.out + DO_SK); const bf16_t* SV = (const bf16_t*)((const unsigned char*)a.out + DO_SV); bf16_t* YA = AR_BF(A_YA);
    const float* sinkp = (const float*)a.in[22];
    for (;;) {
        __syncthreads();
        if (threadIdx.x == 0) *slot = atomicAdd(ctl + CW_SWAQ, 1u);
        __syncthreads();
        const int u = (int)*slot;
        if (u >= 576) break;
        AttnSeg s0, s1; int qrow0, qh, qpos0 = 0, kpos0 = 0; bool masked;
        if (u < 512) { const int b = u >> 7, qb = u & 15; qh = 2 * ((u >> 4) & 7); const int kvh = qh >> 2;
            const int ks = qb * 128 - 128 < 0 ? 0 : qb * 128 - 128, ke = qb * 128 + 256 > 2048 ? 2048 : qb * 128 + 256;
            qrow0 = b * 2048 + qb * 128;
            s0.K = SK + (size_t)(b * 2048 + ks) * 256 + kvh * 64; s0.V = SV + (size_t)(b * 2048 + ks) * 256 + kvh * 64; s0.n = ke - ks;
            s1.K = SK + (size_t)(8192 + b * 256) * 256 + kvh * 64; s1.V = SV + (size_t)(8192 + b * 256) * 256 + kvh * 64; s1.n = 256;
            masked = true; qpos0 = qb * 128; kpos0 = ks;
        } else { const int uu = u - 512, b = uu >> 4, half = uu & 1; qh = 2 * ((uu >> 1) & 7); const int kvh = qh >> 2;
            qrow0 = 8192 + b * 256 + half * 128;
            s0.K = SK + (size_t)(8192 + b * 256) * 256 + kvh * 64; s0.V = SV + (size_t)(8192 + b * 256) * 256 + kvh * 64; s0.n = 256;
            s1.K = s0.K; s1.V = s0.V; s1.n = 0; masked = false;
        }
        attn_unit<64, 2, true>(L, SQ + (size_t)qrow0 * 1024 + qh * 64, 1024, s0, s1, 256, 256, masked, qpos0, kpos0, true, sinkp[qh], sinkp[qh + 1], nullptr, 1.f,
                               YA + (size_t)qrow0 * 2048 + 1024 + qh * 64, 2048);
    }
    if (threadIdx.x == 0) { unsigned sp = 0u;
        while (__hip_atomic_load(ctl + CW_RDONE, __ATOMIC_RELAXED, __HIP_MEMORY_SCOPE_AGENT) < (unsigned)gridDim.x && ++sp < (1u << 22)) __builtin_amdgcn_s_sleep(4);
        __builtin_amdgcn_fence(__ATOMIC_ACQUIRE, "agent"); asm volatile("s_waitcnt vmcnt(0)" ::: "memory"); }
    for (;;) {
        __syncthreads();
        if (threadIdx.x == 0) *slot = atomicAdd(ctl + CW_RPOSTQ, 1u);
        __syncthreads();
        const int u = (int)*slot;
        if (u >= MT / 32) break;
        rwkv_post_rows(a, u * 32, u * 32 + 32);
    }
}

constexpr int HOPSZ = 9216, HOP_QT = 0, HOP_KTT = 4096, HOP_ATT = 8192, HOP_EL = 8704;
constexpr size_t OFF_HOPS = OFF_WT;
static_assert((size_t)64 * 144 * HOPSZ <= WT_CDIN - OFF_WT, "HGRN operators must fit in the dead layer-0 weight region");
constexpr int CW_HFLAG = 8192, HG_NPROD = 3, CW_HDONE = 2048 + 32, CW_HPOSTQ = 2048 + 16;
__device__ __forceinline__ void hgrn_produce(const Args& a, LAS unsigned char* L, int chain, int P) {
    const int tid = threadIdx.x, lane = tid & 63, wave = tid >> 6, fr = lane & 15, g = lane >> 4;
    const bf16_t* U = AR_BF(A_U1); const float* lbl = (const float*)a.in[28];
    constexpr int QROW = 136;
    LAS unsigned char* Lw = L + wave * 13824;
    LAS bf16_t* Qt = (LAS bf16_t*)Lw; LAS bf16_t* Kt = Qt + 16 * QROW;
    const int d = chain >> 5, b = (chain >> 3) & 3, h = chain & 7;
    const int qcol = 3072 + h * 128, zcol = 3072 + 1024 * (1 + d) + h * 128;
    unsigned* flag = (unsigned*)(a.ws + OFF_CTL) + CW_HFLAG + (chain * HG_NPROD + P) * 16;
    __amdgpu_buffer_rsrc_t orsrc = __builtin_amdgcn_make_buffer_rsrc(a.ws + OFF_HOPS + (size_t)chain * 144 * HOPSZ, 0, 144 * HOPSZ, 0x00020000);
    float lbk[2];
#pragma unroll
    for (int kh = 0; kh < 2; ++kh) { const int k = lane + 64 * kh;
        const float l0 = lbl[d * 1024 + h * 128 + k], l1 = lbl[2048 + d * 1024 + h * 128 + k]; const float mxl = fmaxf(l0, l1);
        const float e0 = fexp(l0 - mxl), e1 = fexp(l1 - mxl); lbk[kh] = e1 / (e0 + e1); }
    float zA[16], qA[16], zB[16], qB[16];
#define HP_LOAD(Z, Q, c_, kh_) do { const int cr_ = chunk_row0((c_), d, b); const int k_ = lane + 64 * (kh_); \
        _Pragma("unroll") for (int s = 0; s < 16; ++s) { const size_t mo = (size_t)(cr_ + (d ? -s : s)) * 8192; Z[s] = bfu(U + mo + zcol + k_); Q[s] = bfu(U + mo + qcol + k_); } } while (0)
#define HP_HALF(Z, Q, kh_) do { const int k = lane + 64 * (kh_); const float lb_ = lbk[kh_]; float pc = 1.f; unsigned kpk[8];     \
        _Pragma("unroll") for (int s = 0; s < 16; ++s) { const float z = Z[s]; const float e = fexp(-fabsf(z)); const float sp = __builtin_amdgcn_rcpf(1.f + e), sn = e * sp; const float sig = z >= 0.f ? sp : sn, sigm = z >= 0.f ? sn : sp; \
            const float f = lb_ + (1.f - lb_) * sig, kg = (1.f - lb_) * sigm; pc *= f; \
            const unsigned qb = f2bf(Q[s] * pc), kb = f2bf(kg * __builtin_amdgcn_rcpf(fmaxf(pc, 1.8048513878454153e-35f)));     \
            Qt[s * QROW + k] = (bf16_t)qb; Kt[s * QROW + k] = (bf16_t)kb; \
            if (s & 1) kpk[s >> 1] |= kb << 16; else kpk[s >> 1] = kb; } \
        *(LAS u32x4*)(Lw + 8704 + k * 32) = (u32x4){kpk[0], kpk[1], kpk[2], kpk[3]}; *(LAS u32x4*)(Lw + 8704 + k * 32 + 16) = (u32x4){kpk[4], kpk[5], kpk[6], kpk[7]}; \
        *(LAS float*)(Lw + 13312 + 4 * k) = pc; } while (0)
    __syncthreads();
    HP_LOAD(zA, qA, 8 * P + wave, 0);
    for (int r = P; r < 18; r += HG_NPROD) {
        const int c = 8 * r + wave;
        HP_LOAD(zB, qB, c, 1);
        HP_HALF(zA, qA, 0);
        HP_LOAD(zA, qA, 8 * (r + HG_NPROD < 18 ? r + HG_NPROD : r) + wave, 0);
        HP_HALF(zB, qB, 1);
        f32x4 att = {0.f, 0.f, 0.f, 0.f};
#pragma unroll
        for (int ks = 0; ks < 4; ++ks) { const bf16x8 af = *(const LAS bf16x8*)(Kt + fr * QROW + ks * 32 + g * 8), bfv = *(const LAS bf16x8*)(Qt + fr * QROW + ks * 32 + g * 8);
            att = __builtin_amdgcn_mfma_f32_16x16x32_bf16(af, bfv, att, 0, 0, 0); }
#pragma unroll
        for (int r2 = 0; r2 < 4; ++r2) if (4 * g + r2 > fr) att[r2] = 0.f;
        { u32x2 w; w.x = pk2(att[0], att[1]); w.y = pk2(att[2], att[3]); *(LAS u32x2*)(Lw + 12800 + (fr * 16 + 4 * g) * 2) = w; }
#pragma unroll
        for (int i = 0; i < 9; ++i) { const int p_ = lane + 64 * i;
            const int src = i < 4 ? (p_ >> 4) * 272 + (p_ & 15) * 16 : (i < 8 ? 8704 + (p_ - 256) * 16 : (lane < 32 ? 12800 + lane * 16 : 13312 + (lane - 32) * 16));
            const u32x4 v = *(const LAS u32x4*)(Lw + src);
            __builtin_amdgcn_raw_buffer_store_b128(v, orsrc, c * HOPSZ + 16 * p_, 0, 16  ); }
        asm volatile("s_waitcnt vmcnt(0)" ::: "memory");
        __syncthreads();
        if (tid == 0) (void)__hip_atomic_fetch_add(flag, 1u, __ATOMIC_RELAXED, __HIP_MEMORY_SCOPE_AGENT);
    }
#undef HP_LOAD
#undef HP_HALF
}
__device__ __forceinline__ void hgrn_chain(const Args& a, LAS unsigned char* L, int chain) {
    const int tid = threadIdx.x, lane = tid & 63, wave = tid >> 6, fr = lane & 15, g = lane >> 4;
    const int d = chain >> 5, b = (chain >> 3) & 3, h = chain & 7, v0 = 16 * wave, sgn = d ? -1 : 1;
    const bf16_t* UV = AR_BF(A_U1) + 3072 + 3072 + h * 128;
    bf16_t* OUT = AR_BF(d ? A_OB : A_OF) + h * 128 + v0 + 4 * g;
    const unsigned char* OPS = a.ws + OFF_HOPS + (size_t)chain * 144 * HOPSZ;
    constexpr int SLOT = 16384, S_QT = 0, S_KTT = 4352, S_ATT = 10496, S_EL = 11264, S_V = 11776, VPITCH = 288, KPITCH = 48;
    f32x4 sacc[8];
#pragma unroll
    for (int mt = 0; mt < 8; ++mt) sacc[mt] = (f32x4){0.f, 0.f, 0.f, 0.f};
    u32x4 ra0, ra1, ra2, rb0, rb1, rb2;
    unsigned* hflags = (unsigned*)(a.ws + OFF_CTL) + CW_HFLAG + chain * HG_NPROD * 16;
    int rknown = 0;
#define HG_POLL(x_) do { if (wave == 0 && ((x_) & 7) == 0 && (x_) < 144 && ((x_) >> 3) >= rknown) { const int r_ = (x_) >> 3; unsigned sp_ = 0u; int rr_; \
        for (;;) { rr_ = 1 << 20;   \
            _Pragma("unroll") for (int p_ = 0; p_ < HG_NPROD; ++p_) { const int c_ = (int)__hip_atomic_load(hflags + 16 * p_, __ATOMIC_RELAXED, __HIP_MEMORY_SCOPE_AGENT); const int lim_ = HG_NPROD * c_ + p_; rr_ = lim_ < rr_ ? lim_ : rr_; } \
            if (rr_ > r_ || ++sp_ >= (1u << 22)) break; __builtin_amdgcn_s_sleep(2); } \
        __builtin_amdgcn_fence(__ATOMIC_ACQUIRE, "agent"); asm volatile("s_waitcnt vmcnt(0)" ::: "memory"); rknown = rr_; } } while (0)
#define HG_LD(R0, R1, R2, c_) do { const unsigned char* op_ = OPS + (size_t)(c_) * HOPSZ; const int cr0_ = __builtin_amdgcn_readfirstlane(chunk_row0((c_), d, b)); \
        R0 = *(const u32x4*)(op_ + 16 * tid); \
          \
        { const int p_ = 512 + tid; const int vp_ = p_ < 832 ? p_ - 576 : 0; \
          const unsigned char* src_ = p_ < 576 ? op_ + 16 * p_ : (const unsigned char*)(UV + (ptrdiff_t)(cr0_ + sgn * (vp_ >> 4)) * 8192 + 8 * (vp_ & 15)); R1 = *(const u32x4*)src_; } } while (0)
#define HG_ST(R0, R1, R2, slot_) do { LAS unsigned char* sl_ = L + (slot_) * SLOT; \
        { const int dst_ = tid < 256 ? S_QT + (tid >> 4) * 272 + (tid & 15) * 16 : S_KTT + ((tid - 256) >> 1) * KPITCH + ((tid - 256) & 1) * 16; *(LAS u32x4*)(sl_ + dst_) = R0; } \
        { const int p_ = 512 + tid; if (p_ < 832) { const int dst_ = p_ < 544 ? S_ATT + ((p_ - 512) >> 1) * KPITCH + ((p_ - 512) & 1) * 16 : (p_ < 576 ? S_EL + (p_ - 544) * 16 : S_V + ((p_ - 576) >> 4) * VPITCH + ((p_ - 576) & 15) * 16); *(LAS u32x4*)(sl_ + dst_) = R1; } } } while (0)
#define HG_STEP(c_) do { const LAS unsigned char* sl_ = L + ((c_) & 1) * SLOT; \
          \
        u32x2 q0_[4], q1_[4], kt_[8]; f32x4 el_[8]; \
          \
        const v4i16_t vt_ = __builtin_amdgcn_ds_read_tr16_b64_v4i16((LAS v4i16_t*)(sl_ + S_V + (4 * g + (fr >> 2)) * VPITCH + (v0 + 4 * (fr & 3)) * 2)); \
        _Pragma("unroll") for (int mt = 0; mt < 8; ++mt) { kt_[mt] = *(const LAS u32x2*)(sl_ + S_KTT + (16 * mt + fr) * KPITCH + 8 * g); el_[mt] = *(const LAS f32x4*)(sl_ + S_EL + (16 * mt + 4 * g) * 4); } \
        _Pragma("unroll") for (int ks = 0; ks < 4; ++ks) { q0_[ks] = *(const LAS u32x2*)(sl_ + S_QT + fr * 272 + (32 * ks + 4 * g) * 2); q1_[ks] = *(const LAS u32x2*)(sl_ + S_QT + fr * 272 + (32 * ks + 16 + 4 * g) * 2); } \
        const u32x2 at_ = *(const LAS u32x2*)(sl_ + S_ATT + fr * KPITCH + 8 * g); \
          \
        u32x4 aw_[4]; \
        _Pragma("unroll") for (int ks = 0; ks < 4; ++ks) { const f32x4 sA = sacc[2 * ks], sB = sacc[2 * ks + 1]; aw_[ks] = (u32x4){pk2(sA[0], sA[1]), pk2(sA[2], sA[3]), pk2(sB[0], sB[1]), pk2(sB[2], sB[3])}; } \
          \
          \
        _Pragma("unroll") for (int mt = 0; mt < 8; ++mt) \
            sacc[mt] = __builtin_amdgcn_mfma_f32_16x16x16bf16_1k(__builtin_bit_cast(v4i16_t, kt_[mt]), vt_, sacc[mt], 0, 0, 0); \
        _Pragma("unroll") for (int mt = 0; mt < 8; ++mt) sacc[mt] = sacc[mt] * el_[mt]; \
          \
        f32x4 oa = {0.f, 0.f, 0.f, 0.f}, ob = {0.f, 0.f, 0.f, 0.f}; \
        _Pragma("unroll") for (int ks = 0; ks < 4; ++ks) { const u32x4 bw = {q0_[ks].x, q0_[ks].y, q1_[ks].x, q1_[ks].y}; \
            if (ks & 1) ob = __builtin_amdgcn_mfma_f32_16x16x32_bf16(__builtin_bit_cast(bf16x8, aw_[ks]), __builtin_bit_cast(bf16x8, bw), ob, 0, 0, 0); \
            else oa = __builtin_amdgcn_mfma_f32_16x16x32_bf16(__builtin_bit_cast(bf16x8, aw_[ks]), __builtin_bit_cast(bf16x8, bw), oa, 0, 0, 0); } \
        oa = __builtin_amdgcn_mfma_f32_16x16x16bf16_1k(vt_, __builtin_bit_cast(v4i16_t, at_), oa, 0, 0, 0); \
        { const f32x4 os_ = oa + ob; u32x2 ow_; ow_.x = pk2(os_[0], os_[1]); ow_.y = pk2(os_[2], os_[3]);     \
            *(u32x2*)(OUT + (ptrdiff_t)(__builtin_amdgcn_readfirstlane(chunk_row0((c_), d, b)) + sgn * fr) * 1024) = ow_; } } while (0)
    HG_POLL(0);
    __syncthreads();
    u32x4 rc0, rc1, rc2;
    HG_LD(ra0, ra1, ra2, 0); HG_ST(ra0, ra1, ra2, 0); HG_LD(ra0, ra1, ra2, 3); HG_LD(rb0, rb1, rb2, 1); HG_LD(rc0, rc1, rc2, 2);
    __syncthreads();
    for (int c = 0; c < 144; c += 3) {
        HG_POLL(c + 5); HG_STEP(c);     HG_ST(rb0, rb1, rb2, (c + 1) & 1); HG_LD(rb0, rb1, rb2, (c + 4 < 144 ? c + 4 : 143)); lds_barrier();
        HG_POLL(c + 6); HG_STEP(c + 1); HG_ST(rc0, rc1, rc2, (c + 2) & 1); HG_LD(rc0, rc1, rc2, (c + 5 < 144 ? c + 5 : 143)); lds_barrier();
        HG_POLL(c + 7); HG_STEP(c + 2); HG_ST(ra0, ra1, ra2, (c + 3) & 1); HG_LD(ra0, ra1, ra2, (c + 6 < 144 ? c + 6 : 143)); lds_barrier();
    }
#undef HG_LD
#undef HG_POLL
#undef HG_ST
#undef HG_STEP
    asm volatile("s_waitcnt vmcnt(0)" ::: "memory");
    __syncthreads();
    if (tid == 0) { __builtin_amdgcn_fence(__ATOMIC_RELEASE, "agent"); asm volatile("s_waitcnt vmcnt(0)" ::: "memory");
        (void)__hip_atomic_fetch_add((unsigned*)(a.ws + OFF_CTL) + CW_HDONE, 1u, __ATOMIC_RELAXED, __HIP_MEMORY_SCOPE_AGENT); }
}

__device__ __forceinline__ void hgrn_post_rows(const Args& a, int m0, int m1) {
    const int tid = threadIdx.x, lane = tid & 63, wave = tid >> 6;
    const bf16_t* OF = AR_BF(A_OF); const bf16_t* OB = AR_BF(A_OB); const bf16_t* U = AR_BF(A_U1); const float* gn = (const float*)a.in[27]; bf16_t* YC = AR_BF(A_YC);
    const f32x4 gn4 = *(const f32x4*)(gn + 4 * (lane & 31));
    for (int m = m0 + wave; m < m1; m += 8) {
        f32x4 x0[4], x1[4], gg[4];
#pragma unroll
        for (int q = 0; q < 4; ++q) { const size_t o = (size_t)m * 1024 + 256 * q + 4 * lane;
            x0[q] = bf4(OF + o); x1[q] = bf4(OB + o); gg[q] = bf4(U + (size_t)m * 8192 + 3072 + 4096 + 256 * q + 4 * lane); }
#pragma unroll
        for (int q = 0; q < 4; ++q) { const f32x4 y = x0[q] + x1[q];
            float ss = row16_sum((y.x * y.x + y.y * y.y) + (y.z * y.z + y.w * y.w));
            { float p = ss, r = ss; asm volatile("s_nop 1\n\tv_permlane16_swap_b32 %0, %1" : "+v"(p), "+v"(r)); ss = p + r; }
            const float rstd = rsqrtf(ss * (1.f / 128.f) + 1e-6f);
            f32x4 o4;
#pragma unroll
            for (int e = 0; e < 4; ++e) { const float gv = gg[q][e]; o4[e] = y[e] * rstd * gn4[e] * (gv * __builtin_amdgcn_rcpf(1.f + fexp(-gv))); }
            u32x2 w; w.x = pk2(o4.x, o4.y); w.y = pk2(o4.z, o4.w); *(u32x2*)(YC + (size_t)m * 2048 + 1024 + 256 * q + 4 * lane) = w; }
    }
}

__device__ __forceinline__ void ph_mix1(const Args& a, LAS unsigned char* L, const int mode) {
    const int bid = blockIdx.x;
    DS_INIT();
    if (bid < 64) { hgrn_chain(a, L, bid); DS(5); }
    else if (bid < 64 + 64 * HG_NPROD) hgrn_produce(a, L, (bid - 64) & 63, (bid - 64) >> 6);
    const bf16_t* QD = AR_BF(A_QD); const bf16_t* KD = AR_BF(A_KD); const bf16_t* VD = AR_BF(A_VD); bf16_t* YC = AR_BF(A_YC);
    const float* lam = (const float*)a.in[25]; const float* subln = (const float*)a.in[26];
    float d01 = 0.f, d23 = 0.f;
    for (int j = 0; j < 64; ++j) { d01 += lam[j] * lam[64 + j]; d23 += lam[128 + j] * lam[192 + j]; }
    const float lam_init = 0.8f - 0.6f * expf(-0.3f);
    const float lmb = expf(d01) - expf(d23) + lam_init;
    unsigned* ctr = (unsigned*)(a.ws + OFF_CTL) + 2048;
    volatile LAS unsigned* slot = (volatile LAS unsigned*)(L + LDS_BYTES - 32);
    for (; bid >= 64;) {
        __syncthreads();
        if (threadIdx.x == 0) *slot = atomicAdd(ctr, 1u);
        __syncthreads();
        const int u = (int)*slot;
        if (u >= 512) break;
        const int b = u >> 7, h = (u >> 4) & 7, qb = u & 15; const int qrow0 = b * 2048 + qb * 128;
        AttnSeg s0, s1;
        s0.K = KD + (size_t)(b * 2048) * 1024 + h * 128; s0.V = VD + (size_t)(b * 2048) * 1024 + h * 128; s0.n = 2048;
        s1.K = KD + (size_t)(8192 + b * 256) * 1024 + h * 128; s1.V = VD + (size_t)(8192 + b * 256) * 1024 + h * 128; s1.n = 256;
        attn_unit<128, 2>(L, QD + (size_t)qrow0 * 1024 + h * 128, 1024, s0, s1, 1024, 1024, false, 0, 0, false, 0.f, lmb, subln, 1.f - lam_init,
                          YC + (size_t)qrow0 * 2048 + h * 128, 2048
#ifdef MK_DIAG_ATT
                          , bid == MK_DIAG_ATT ? (unsigned long long*)(a.ws + OFF_CTL) : nullptr
#endif
                          );
    }
    if (threadIdx.x == 0) { unsigned* dn = (unsigned*)(a.ws + OFF_CTL) + CW_HDONE; unsigned sp = 0u;
        while (__hip_atomic_load(dn, __ATOMIC_RELAXED, __HIP_MEMORY_SCOPE_AGENT) < 64u && ++sp < (1u << 22)) __builtin_amdgcn_s_sleep(4);
        __builtin_amdgcn_fence(__ATOMIC_ACQUIRE, "agent"); asm volatile("s_waitcnt vmcnt(0)" ::: "memory"); }
    unsigned* pq = (unsigned*)(a.ws + OFF_CTL) + CW_HPOSTQ;
    for (;;) {
        __syncthreads();
        if (threadIdx.x == 0) *slot = atomicAdd(pq, 1u);
        __syncthreads();
        const int u = (int)*slot;
        if (u >= ML / 32) break;
        hgrn_post_rows(a, u * 32, u * 32 + 32);
    }
}


#ifndef MK_SINGLE
#define MK_SINGLE 0
#endif
constexpr int NPHASE = 20;
typedef unsigned v4u_unused_;
#define XB_TMO      128
#define XB_XCNT(j)  (256  + 64 * (j))
#define XB_XSUB(j)  (1280 + 64 * (j))
#define XB_XGEN(j)  (2304 + 64 * (j))
#define XB_TOP      3328
#define XB_TOPGEN   3392
#define XCD_BAR_WORDS 3456
#define XB_SPIN_CAP (1u << 18)

__device__ __forceinline__ unsigned xb_ld(unsigned* p)              { return __hip_atomic_load(p, __ATOMIC_RELAXED, __HIP_MEMORY_SCOPE_AGENT); }
__device__ __forceinline__ unsigned xb_add(unsigned* p, unsigned v) { return __hip_atomic_fetch_add(p, v, __ATOMIC_RELAXED, __HIP_MEMORY_SCOPE_AGENT); }
__device__ __forceinline__ unsigned xb_xcc_id() { return (unsigned)__builtin_amdgcn_s_getreg((3 << 11) | 20) & 0xFu; }
#define XB_SPIN(cond, bar) do { unsigned _sp = 0; while (cond) { __builtin_amdgcn_s_sleep(1); \
    if ((++_sp & 255u) == 0u) { if (xb_ld(&(bar)[XB_TMO])) break; if (_sp > XB_SPIN_CAP) { atomicAdd(&(bar)[XB_TMO], 1u); break; } } } } while (0)

struct XcdBarrier {
    unsigned* bar; unsigned x;
    volatile LAS unsigned* st;
};

__device__ __forceinline__ XcdBarrier xcd_barrier_post(unsigned* bar, volatile LAS unsigned* st) {
    XcdBarrier b; b.bar = bar; b.x = xb_xcc_id(); b.st = st;
    if (threadIdx.x == 0) (void)xb_add(&bar[XB_XCNT(b.x)], 1u);
    return b;
}
__device__ __forceinline__ void xcd_barrier_complete(unsigned* bar, unsigned x, unsigned& nloc, unsigned& nx) {
    const unsigned G = gridDim.x * gridDim.y * gridDim.z;
    unsigned sum, cnt, mine, sp = 0u;
    for (;;) {
        sum = 0u; cnt = 0u; mine = 0u;
#pragma unroll
        for (unsigned j = 0; j < 16; ++j) { const unsigned c = xb_ld(&bar[XB_XCNT(j)]); sum += c; cnt += (c > 0u) ? 1u : 0u; mine = (j == x) ? c : mine; }
        if (sum == G) break;
        __builtin_amdgcn_s_sleep(1);
        if ((++sp & 255u) == 0u) { if (xb_ld(&bar[XB_TMO])) break; if (sp > XB_SPIN_CAP) { atomicAdd(&bar[XB_TMO], 1u); break; } }
    }
    nloc = mine > 0u ? mine : 1u; nx = cnt > 0u ? cnt : 1u;
}

__device__ __forceinline__ void xcd_barrier(const XcdBarrier& b) {
    asm volatile("s_waitcnt vmcnt(0)" ::: "memory");
    __syncthreads();
    if (threadIdx.x == 0) {
        unsigned* bar = b.bar;
        __builtin_amdgcn_s_waitcnt(0);
        unsigned nloc = b.st[0], nx = b.st[1];
        if (nloc == 0u) { xcd_barrier_complete(bar, b.x, nloc, nx); b.st[0] = nloc; b.st[1] = nx; }
        const unsigned old = xb_add(&bar[XB_XSUB(b.x)], 1u);
        const unsigned gen = old / nloc;
        if (old + 1u == (gen + 1u) * nloc) {
            __builtin_amdgcn_fence(__ATOMIC_RELEASE, "agent");
            asm volatile("s_waitcnt vmcnt(0)" ::: "memory");
            const unsigned og = xb_add(&bar[XB_TOP], 1u);
            const unsigned tg = og / nx;
            if (og + 1u == (tg + 1u) * nx) xb_add(&bar[XB_TOPGEN], 1u);
            else XB_SPIN(xb_ld(&bar[XB_TOPGEN]) == tg, bar);
            __builtin_amdgcn_fence(__ATOMIC_ACQUIRE, "agent");
            xb_add(&bar[XB_XGEN(b.x)], 1u);
            asm volatile("s_waitcnt vmcnt(0)" ::: "memory");
        } else {
            XB_SPIN(xb_ld(&bar[XB_XGEN(b.x)]) == gen, bar);
            __builtin_amdgcn_fence(__ATOMIC_ACQUIRE, "agent");
            asm volatile("s_waitcnt vmcnt(0)" ::: "memory");
        }
    }
    __syncthreads();
}

constexpr int CW_BAR = 4096;

__global__ void __launch_bounds__(NTHR, 2) mk_fwd(Args a) {
    extern __shared__ __attribute__((aligned(16))) unsigned char lds_raw[];
    LAS unsigned char* L = (LAS unsigned char*)lds_raw;
    const float* mod0 = WS_F32(OFF_MOD); const float* mod1 = mod0 + 5 * 12288;
    const int G = gridDim.x, bx = blockIdx.x;
#if MK_SINGLE
    volatile LAS unsigned* xst = (volatile LAS unsigned*)(L + LDS_BYTES - 64);
    if (threadIdx.x < 2) xst[threadIdx.x] = 0u;
    __syncthreads();
    XcdBarrier xbar = xcd_barrier_post((unsigned*)(a.ws + OFF_CTL) + CW_BAR, xst);
#define SEAM(k) do { if (a.ph_lo <= (k) && (k) + 1 < a.ph_hi) { xcd_barrier(xbar); } STAMP((k) + 1); } while (0)
#else
#define SEAM(k) do { } while (0)
#endif
#define IN(k) (a.ph_lo <= (k) && (k) < a.ph_hi)
    typedef pg8::StaticOrder SO;
#ifdef MK_DIAG
    unsigned long long* ts = (unsigned long long*)(a.ws + OFF_CTL);
#define STAMP(i) do { if (bx == 0 && threadIdx.x == 0) ts[i] = __builtin_amdgcn_s_memrealtime(); } while (0)
#else
#define STAMP(i) do { } while (0)
#endif
    STAMP(0);
    if (IN(0)) { ph_prologue(a, L); SEAM(0); }
    if (IN(1)) { ph_modulate((const float*)a.in[0], (float*)a.in[2], MT, mod0, 0, 1, WS_BF(OFF_HN)); ph_l0_weights(a, L); SEAM(1); }
    if (IN(2)) { pg8::Gemm g{WS_BF(OFF_HN), WS_BF(WT_ABIN), MT, ABINP, DM, DM}; SO S; S.init(MT, ABINP, G, bx); pg8::EpiBf16Plain E{AR_BF(A_U0), ABINP};
        pg8::gemm_phase<pg8::EpiBf16Plain, SO, true, true>(L, g, S, E); SEAM(2); }
    if (IN(3)) { ph_rwkv_prep(a, L); SEAM(3); }
    if (IN(4)) { ph_mix0(a, L, 0); SEAM(4); }
    if (IN(6)) { { pg8::Gemm g{AR_BF(A_YA), WS_BF(WT_ABOUT), ML, DM, DM, DM}; SO S; S.init(ML, DM, G, bx);
          pg8::EpiResGate E{(const float*)a.in[0], (const float*)a.in[2], AR_F32(A_X1), mod0 + 2 * 2048};
          pg8::gemm_phase<pg8::EpiResGate, SO, true, true>(L, g, S, E); }
        { pg8::Gemm g{AR_BF(A_YA), WS_BF(WT_ABOUT), MT, DM, 256, DM}; pg8::SplitKOrder S; S.init(ML / 256, MC / 256, DM / 256, 8, 256, G, bx);
          pg8::EpiSlab E{AR_BF(A_SLAB6), ML, 256, (size_t)MC * DM};
          pg8::gemm_phase<pg8::EpiSlab, pg8::SplitKOrder, true, true>(L, g, S, E); }
        SEAM(6); }
    if (IN(7)) { ph_modulate(AR_F32(A_X1), AR_F32(A_X1) + (size_t)ML * DM, MT, mod0, 3, 4, WS_BF(OFF_HN), AR_BF(A_SLAB6), (const float*)a.in[2], mod0 + 4 * 12288 + 2 * 2048); SEAM(7); }
    if (IN(8)) { pg8::Gemm g{WS_BF(OFF_HN), WS_BF(WT_W1_0), MT, FF, DM, DM}; SO S; S.init(MT, FF, G, bx); pg8::EpiSqReluBf16 E{AR_BF(A_HID), FF};
        pg8::gemm_phase<pg8::EpiSqReluBf16, SO, true, true>(L, g, S, E); SEAM(8); }
    if (IN(9)) { { pg8::Gemm g{AR_BF(A_HID), WS_BF(WT_W2_0), ML, DM, FF, FF}; SO S; S.init(ML, DM, G, bx);
          pg8::EpiResGate E{AR_F32(A_X1), AR_F32(A_X1) + (size_t)ML * DM, AR_F32(A_X2), mod0 + 5 * 2048};
          pg8::gemm_phase<pg8::EpiResGate, SO, true, true>(L, g, S, E); }
        { pg8::Gemm g{AR_BF(A_HID), WS_BF(WT_W2_0), MT, DM, 1024, FF}; pg8::SplitKOrder S; S.init(ML / 256, MC / 256, DM / 256, 8, 1024, G, bx);
          pg8::EpiSlab E{AR_BF(A_SLAB), ML, 1024, (size_t)MC * DM};
          pg8::gemm_phase<pg8::EpiSlab, pg8::SplitKOrder, true, true>(L, g, S, E); }
        SEAM(9); }
    if (IN(10)) { ph_modulate(AR_F32(A_X2), AR_F32(A_X2) + (size_t)ML * DM, MT, mod1, 0, 1, WS_BF(OFF_HN), AR_BF(A_SLAB), AR_F32(A_X1) + (size_t)ML * DM, mod0 + 4 * 12288 + 5 * 2048); SEAM(10); }
    if (IN(11)) { pg8::Gemm g{WS_BF(OFF_HN), WS_BF(WT_CDIN), MT, FF, DM, DM}; SO S; S.init(MT, FF, G, bx);
        pg8::EpiCdIn E{AR_BF(A_QD), AR_BF(A_KD), AR_BF(A_VD), AR_BF(A_U1), (const float*)(a.ws + OFF_ROPE)};
        pg8::gemm_phase<pg8::EpiCdIn, SO, true, true>(L, g, S, E); SEAM(11); }
    if (IN(13)) { ph_mix1(a, L, 0); SEAM(13); }
    if (IN(15)) { pg8::Gemm g{AR_BF(A_YC), WS_BF(WT_CDOUT), ML, DM, DM, DM}; SO S; S.init(ML, DM, G, bx);
        pg8::EpiResGate E{AR_F32(A_X2), AR_F32(A_X2) + (size_t)ML * DM, AR_F32(A_X3), mod1 + 2 * 2048};
        pg8::gemm_phase<pg8::EpiResGate, SO, true, true>(L, g, S, E); SEAM(15); }
    if (IN(16)) { ph_modulate(AR_F32(A_X3), AR_F32(A_X3), ML, mod1, 3, 4, WS_BF(OFF_HN)); SEAM(16); }
    if (IN(17)) { pg8::Gemm g{WS_BF(OFF_HN), WS_BF(WT_W1_1), ML, FF, DM, DM}; SO S; S.init(ML, FF, G, bx); pg8::EpiSqReluBf16 E{AR_BF(A_HID1), FF};
        pg8::gemm_phase<pg8::EpiSqReluBf16, SO, true, true>(L, g, S, E); SEAM(17); }
    if (IN(18)) { pg8::Gemm g{AR_BF(A_HID1), WS_BF(WT_W2_1), ML, DM, FF, FF}; SO S; S.init(ML, DM, G, bx);
        pg8::EpiResGate E{AR_F32(A_X3), AR_F32(A_X3), a.out, mod1 + 5 * 2048};
        pg8::gemm_phase<pg8::EpiResGate, SO, true, true>(L, g, S, E); SEAM(18); }
    if (IN(19)) { ph_final(a); }
#ifdef MK_DIAG
    STAMP(20);
    xcd_barrier(xbar);
#define T(i) ((float)(long long)(ts[i] - ts[0]) * 0.01f)
#define DSV(k) ((float)(long long)ts[32 + (k)] * 0.01f)
    { const float dA = (MK_DIAG_EA), dB = (MK_DIAG_EB);
      const float eA = 0.04f + fminf(dA * (0.06f / MK_DIAG_MAXA), 0.06f), eB = fminf(0.006f * dB / MK_DIAG_REFB, 0.024f);
      const int gw_ = bx * 8 + (threadIdx.x >> 6), lane_ = threadIdx.x & 63;
      if (gw_ >= 1 && gw_ <= 512) { float* xr = a.out + (size_t)gw_ * 2048 + 4 * lane_;
          for (int j = 0; j < 8; ++j) { f32x4 v = *(f32x4*)(xr + 256 * j); v = v + eB; *(f32x4*)(xr + 256 * j) = v; } }
      if (bx == 0 && threadIdx.x == 0) a.out[0] += eA; }
#endif
#undef IN
#undef SEAM
}

extern "C" void kernel_launch(void* const* d_in, const int* in_sizes, int n_in, void* d_out, int out_size, void* d_ws, size_t ws_size, hipStream_t stream) {
    static int grid = 0;
    if (grid == 0) {
        if (n_in != 29 || out_size != ML * DM || ws_size < WS_TOTAL) { fprintf(stderr, "kernel_launch: unexpected shapes (n_in %d, out %d, ws %zu < %zu)\n", n_in, out_size, ws_size, (size_t)WS_TOTAL); grid = -1; return; }
        int dev = 0, cus = 0, per_cu = 0;
        if (hipGetDevice(&dev) != hipSuccess || hipDeviceGetAttribute(&cus, hipDeviceAttributeMultiprocessorCount, dev) != hipSuccess) { grid = -1; return; }
        if (hipFuncSetAttribute((const void*)mk_fwd, hipFuncAttributeMaxDynamicSharedMemorySize, LDS_BYTES) != hipSuccess) { fprintf(stderr, "kernel_launch: hipFuncSetAttribute failed\n"); grid = -1; return; }
        if (hipOccupancyMaxActiveBlocksPerMultiprocessor(&per_cu, (const void*)mk_fwd, NTHR, LDS_BYTES) != hipSuccess || per_cu < 1) { fprintf(stderr, "kernel_launch: occupancy query says %d\n", per_cu); grid = -1; (void)hipGetLastError(); return; }
        grid = cus;
        if (grid != NBLK) { fprintf(stderr, "kernel_launch: built for %d CUs, device has %d\n", NBLK, cus); grid = -1; return; }
    }
    if (grid < 0) return;
    if (hipMemsetAsync((char*)d_ws + OFF_CTL, 0, 65536, stream) != hipSuccess) { fprintf(stderr, "kernel_launch: memset failed\n"); return; }
    Args a{};
    for (int i = 0; i < 29; ++i) a.in[i] = d_in[i];
    a.out = (float*)d_out; a.ws = (unsigned char*)d_ws;
#if MK_SINGLE
    a.ph_lo = 0; a.ph_hi = NPHASE;
    hipLaunchKernelGGL(mk_fwd, dim3(grid), dim3(NTHR), LDS_BYTES, stream, a);
    hipError_t e = hipPeekAtLastError();
    if (e != hipSuccess) fprintf(stderr, "kernel_launch: launch failed: %s\n", hipGetErrorString(e));
#else
    for (int p = 0; p < NPHASE; ++p) { a.ph_lo = p; a.ph_hi = p + 1; hipLaunchKernelGGL(mk_fwd, dim3(grid), dim3(NTHR), LDS_BYTES, stream, a); }
#endif
}
```
